# Optimizing an MI355X kernel written in HIP

```python
import jax, jax.numpy as jnp
from jax import lax
import numpy as np

D_MODEL = 4096
BATCH = 1
SEQ = 16384
DEPTH = 1
DEC_BATCH = 8
DEC_SEQ = 2048
PAST_LEN = 128

HEAD_DIM = 128
N_Q_HEADS = 16
N_KV_HEADS = 4
Q_PER_KV = N_Q_HEADS // N_KV_HEADS
ATTN_W = N_Q_HEADS * HEAD_DIM
KV_W = N_KV_HEADS * HEAD_DIM
WINDOW = 128
BLOCK = 128
D_RNN = D_MODEL
N_RNN_BLOCKS = 16
RNN_BLOCK = D_RNN // N_RNN_BLOCKS
RNN_CONV = 4
LRU_C = 8.0
D_FF = 3 * D_MODEL
FFN_CONV = 3
PLE_DIM = 256
IN_W = ATTN_W + 2 * KV_W + 2 * D_RNN
SPLITS = [ATTN_W, ATTN_W + KV_W, ATTN_W + 2 * KV_W, ATTN_W + 2 * KV_W + D_RNN]
EPS = 1e-6
NEG = -1e30

kernel_name = "hybrid_bidir_local_gqa_rglru_encoder"


def rms_norm(x, g):
    xf = x.astype(jnp.float32)
    y = xf * lax.rsqrt(jnp.mean(xf * xf, axis=-1, keepdims=True) + EPS)
    return (y * g.astype(jnp.float32)).astype(x.dtype)


def dw_conv(x, w, b):
    width = w.shape[0]
    left = (width - 1) // 2
    t = x.shape[1]
    xp = jnp.pad(x, ((0, 0), (left, width - 1 - left), (0, 0)))
    out = xp[:, 0:t] * w[0]
    for k in range(1, width):
        out = out + xp[:, k:k + t] * w[k]
    return out + b


def alibi_slopes():
    return jnp.asarray(2.0 ** (-8.0 * (np.arange(N_Q_HEADS) + 1) / N_Q_HEADS), jnp.float32)


def banded_attention(q, k, v, sink):
    b, t = q.shape[0], q.shape[1]
    nb = t // BLOCK
    qb = q.reshape(b, nb, BLOCK, N_KV_HEADS, Q_PER_KV, HEAD_DIM)

    def windows(z):
        zp = jnp.pad(z, ((0, 0), (BLOCK, BLOCK), (0, 0), (0, 0))).reshape(b, nb + 2, BLOCK, N_KV_HEADS, HEAD_DIM)
        return jnp.concatenate([zp[:, :-2], zp[:, 1:-1], zp[:, 2:]], axis=2)

    kw = windows(k)
    vw = windows(v)
    rel = jnp.arange(3 * BLOCK)[None, :] - BLOCK - jnp.arange(BLOCK)[:, None]
    key_pos = (jnp.arange(nb)[:, None] - 1) * BLOCK + jnp.arange(3 * BLOCK)[None, :]
    valid = (key_pos >= 0) & (key_pos < t)
    mask = (jnp.abs(rel) <= WINDOW)[None] & valid[:, None, :]
    dist = jnp.abs(rel).astype(jnp.float32)
    slopes = alibi_slopes().reshape(N_KV_HEADS, Q_PER_KV)[:, :, None, None]
    s = jnp.einsum('bnqhgd,bnkhd->bnhgqk', qb, kw).astype(jnp.float32) * (HEAD_DIM ** -0.5)
    s = s - slopes * dist
    s = jnp.where(mask[None, :, None, None], s, NEG)
    sk = sink.astype(jnp.float32).reshape(N_KV_HEADS, Q_PER_KV)[:, :, None, None]
    m = jnp.maximum(jnp.max(s, axis=-1, keepdims=True), sk)
    e = jnp.exp(s - m)
    pr = e / (jnp.sum(e, axis=-1, keepdims=True) + jnp.exp(sk - m))
    out = jnp.einsum('bnhgqk,bnkhd->bnqhgd', pr.astype(v.dtype), vw)
    return out.reshape(b, t, ATTN_W)


def linear_scan(a, bterm, reverse):
    def step(h, ab):
        h = ab[0] * h + ab[1]
        return h, h
    init = jnp.zeros((a.shape[0], a.shape[2]), jnp.float32)
    _, hs = lax.scan(step, init, (jnp.swapaxes(a, 0, 1), jnp.swapaxes(bterm, 0, 1)), reverse=reverse)
    return jnp.swapaxes(hs, 0, 1)


def rg_lru_bidir(xc, wa, ba, wx, bx, lam):
    b, t, _ = xc.shape
    xb = xc.reshape(b, t, N_RNN_BLOCKS, RNN_BLOCK)
    xf = xc.astype(jnp.float32)
    total = None
    for d in range(2):
        r = jax.nn.sigmoid(jnp.einsum('btnc,ncd->btnd', xb, wa[d]).reshape(b, t, D_RNN).astype(jnp.float32) + ba[d].astype(jnp.float32))
        ig = jax.nn.sigmoid(jnp.einsum('btnc,ncd->btnd', xb, wx[d]).reshape(b, t, D_RNN).astype(jnp.float32) + bx[d].astype(jnp.float32))
        log_a = -LRU_C * r * jax.nn.softplus(-lam[d].astype(jnp.float32))
        a = jnp.exp(log_a)
        bterm = jnp.sqrt(-jnp.expm1(2.0 * log_a)) * (ig * xf)
        h = linear_scan(a, bterm, reverse=(d == 1))
        total = h if total is None else total + h
    return total


def encoder(x, p, g_mix, w_in, rnn_conv_w, rnn_conv_b, lru_wa, lru_ba, lru_wx, lru_bx, lru_lambda,
            attn_sink, w_o_attn, w_o_rnn, w_merge_gate, w_out, g_ffn, w_up, ffn_conv_w, ffn_conv_b,
            w_down, w_ple_gate, w_ple, g_ple, g_final):
    b, t, _ = x.shape
    for l in range(DEPTH):
        h = rms_norm(x, g_mix[l])
        z = h @ w_in[l]
        q, k, v, xr, yr = jnp.split(z, SPLITS, axis=-1)
        attn = banded_attention(q.reshape(b, t, N_Q_HEADS, HEAD_DIM),
                                k.reshape(b, t, N_KV_HEADS, HEAD_DIM),
                                v.reshape(b, t, N_KV_HEADS, HEAD_DIM), attn_sink[l])
        xc = dw_conv(xr, rnn_conv_w[l], rnn_conv_b[l])
        rec = (rg_lru_bidir(xc, lru_wa[l], lru_ba[l], lru_wx[l], lru_bx[l], lru_lambda[l])
               * jax.nn.gelu(yr.astype(jnp.float32))).astype(x.dtype)
        gates = jax.nn.sigmoid((h @ w_merge_gate[l]).astype(jnp.float32))
        merged = (gates[..., :D_MODEL] * (attn @ w_o_attn[l]).astype(jnp.float32)
                  + gates[..., D_MODEL:] * (rec @ w_o_rnn[l]).astype(jnp.float32))
        x = x + merged.astype(x.dtype) @ w_out[l]
        u = dw_conv(rms_norm(x, g_ffn[l]) @ w_up[l], ffn_conv_w[l], ffn_conv_b[l])
        x = x + (jax.nn.gelu(u[..., D_FF:]) * u[..., :D_FF]) @ w_down[l]
        e = rms_norm(p[l].astype(x.dtype) @ w_ple[l], g_ple[l])
        x = x + jax.nn.sigmoid(x @ w_ple_gate[l]) * e
    return rms_norm(x, g_final)


def setup_inputs(seed: int = 0) -> dict:
    key = jax.random.key(seed)
    ks = jax.random.split(key, 32)

    def nrm(k, shape, fan_in):
        return jax.random.normal(k, shape, jnp.float32) * (fan_in ** -0.5)

    def gain(k, shape):
        return 1.0 + 0.05 * jax.random.normal(k, shape, jnp.float32)

    u = jax.random.uniform(ks[10], (DEPTH, 2, D_RNN), jnp.float32, minval=0.9, maxval=0.999)
    a_base = u ** (1.0 / LRU_C)
    lam = jnp.log(a_base) - jnp.log1p(-a_base)
    return {
        "x_prompt": jax.random.normal(ks[0], (BATCH, SEQ, D_MODEL), jnp.float32),
        "x_sample": jax.random.normal(ks[1], (DEC_BATCH, DEC_SEQ, D_MODEL), jnp.float32),
        "p_prompt": jax.random.normal(ks[2], (DEPTH, BATCH, SEQ, PLE_DIM), jnp.float32),
        "p_sample": jax.random.normal(ks[3], (DEPTH, DEC_BATCH, DEC_SEQ, PLE_DIM), jnp.float32),
        "g_mix": gain(ks[4], (DEPTH, D_MODEL)),
        "w_in": nrm(ks[5], (DEPTH, D_MODEL, IN_W), D_MODEL),
        "rnn_conv_w": nrm(ks[6], (DEPTH, RNN_CONV, D_RNN), RNN_CONV),
        "rnn_conv_b": 0.01 * jax.random.normal(ks[7], (DEPTH, D_RNN), jnp.float32),
        "lru_wa": nrm(ks[8], (DEPTH, 2, N_RNN_BLOCKS, RNN_BLOCK, RNN_BLOCK), RNN_BLOCK),
        "lru_ba": 0.01 * jax.random.normal(ks[9], (DEPTH, 2, D_RNN), jnp.float32),
        "lru_wx": nrm(ks[11], (DEPTH, 2, N_RNN_BLOCKS, RNN_BLOCK, RNN_BLOCK), RNN_BLOCK),
        "lru_bx": 0.01 * jax.random.normal(ks[12], (DEPTH, 2, D_RNN), jnp.float32),
        "lru_lambda": lam,
        "attn_sink": jax.random.normal(ks[13], (DEPTH, N_Q_HEADS), jnp.float32),
        "w_o_attn": nrm(ks[14], (DEPTH, ATTN_W, D_MODEL), ATTN_W),
        "w_o_rnn": nrm(ks[15], (DEPTH, D_RNN, D_MODEL), D_RNN),
        "w_merge_gate": nrm(ks[16], (DEPTH, D_MODEL, 2 * D_MODEL), D_MODEL),
        "w_out": nrm(ks[17], (DEPTH, D_MODEL, D_MODEL), D_MODEL),
        "g_ffn": gain(ks[18], (DEPTH, D_MODEL)),
        "w_up": nrm(ks[19], (DEPTH, D_MODEL, 2 * D_FF), D_MODEL),
        "ffn_conv_w": nrm(ks[20], (DEPTH, FFN_CONV, 2 * D_FF), FFN_CONV),
        "ffn_conv_b": 0.01 * jax.random.normal(ks[21], (DEPTH, 2 * D_FF), jnp.float32),
        "w_down": nrm(ks[22], (DEPTH, D_FF, D_MODEL), D_FF),
        "w_ple_gate": nrm(ks[23], (DEPTH, D_MODEL, D_MODEL), D_MODEL),
        "w_ple": nrm(ks[24], (DEPTH, PLE_DIM, D_MODEL), PLE_DIM),
        "g_ple": gain(ks[25], (DEPTH, D_MODEL)),
        "g_final": gain(ks[26], (D_MODEL,)),
    }


def reference(x_prompt, x_sample, p_prompt, p_sample, g_mix, w_in, rnn_conv_w, rnn_conv_b, lru_wa, lru_ba,
              lru_wx, lru_bx, lru_lambda, attn_sink, w_o_attn, w_o_rnn, w_merge_gate, w_out, g_ffn, w_up,
              ffn_conv_w, ffn_conv_b, w_down, w_ple_gate, w_ple, g_ple, g_final):
    y_prompt = encoder(x_prompt, p_prompt, g_mix, w_in, rnn_conv_w, rnn_conv_b, lru_wa, lru_ba, lru_wx, lru_bx,
                       lru_lambda, attn_sink, w_o_attn, w_o_rnn, w_merge_gate, w_out, g_ffn, w_up, ffn_conv_w,
                       ffn_conv_b, w_down, w_ple_gate, w_ple, g_ple, g_final)
    y_sample = encoder(x_sample, p_sample, g_mix, w_in, rnn_conv_w, rnn_conv_b, lru_wa, lru_ba, lru_wx, lru_bx,
                       lru_lambda, attn_sink, w_o_attn, w_o_rnn, w_merge_gate, w_out, g_ffn, w_up, ffn_conv_w,
                       ffn_conv_b, w_down, w_ple_gate, w_ple, g_ple, g_final)
    return (y_prompt, y_sample)
```

```cpp
#include <hip/hip_runtime.h>
#include <cstdio>
#include <cstdint>
namespace pg8 {
#define PG8_LAS __attribute__((address_space(3)))
typedef unsigned short bf16_t;
typedef short bf16x8 __attribute__((ext_vector_type(8)));
typedef float f32x4 __attribute__((ext_vector_type(4)));
typedef unsigned u32x4 __attribute__((ext_vector_type(4)));
constexpr int BM = 256, BK = 64, HALF = 128, HTB = HALF * BK * 2  , STAGE_BYTES = 8 * HTB, NXCD = 8, WGM = 8;

__host__ __device__ __forceinline__ int lds_byte(int r, int c) { const int st = (r >> 4) * 2 + (c >> 5), rr = r & 15, cc = c & 31, ob = rr * 64 + cc * 2; return st * 1024 + (ob ^ (((ob >> 9) & 1) << 5)); }
__host__ __device__ __forceinline__ void stage_rc(int b, int& R, int& C) { const int st = b / 1024, sb = b % 1024, swz = sb ^ (((sb >> 9) & 1) << 5); R = (st >> 1) * 16 + swz / 64; C = (st & 1) * 32 + (swz % 64) / 2; }
__host__ __device__ __forceinline__ int perm32(int rho) { const int n = rho >> 4, i = rho & 15; return 8 * (i >> 2) + 4 * n + (i & 3); }

struct Unit { int pm, pn; };
struct Gemm { const bf16_t* A; const bf16_t* Bt; int M, N, K; };

struct StaticOrder {
    int nM, nN, nwg, G, c;
    __host__ __device__ void init(int M, int N, int G_, int c_) { nM = M / BM; nN = N / BM; nwg = nM * nN; G = G_; c = c_; }
    __host__ __device__ bool next(int i, Unit& u) const {
        const long L = (long)i * G + c; if (L >= nwg) return false;
        int wgid = (int)L; { const int q = nwg / NXCD, r = nwg % NXCD, xcd = wgid % NXCD, off = wgid / NXCD; wgid = (xcd < r ? xcd * (q + 1) : r * (q + 1) + (xcd - r) * q) + off; }
        const int nig = WGM * nN, gid = wgid / nig, fm = gid * WGM, gsz = (nM - fm) < WGM ? (nM - fm) : WGM;
        u.pm = fm + ((wgid % nig) % gsz); u.pn = (wgid % nig) / gsz; return true;
    }
    __device__ __forceinline__ void a_ready(const Unit&) const {}
    __device__ __forceinline__ void done(const Unit&) const {}
};
__device__ __forceinline__ unsigned cvt_pk_bf16(float lo, float hi) { unsigned r; asm volatile("s_nop 2\n\tv_cvt_pk_bf16_f32 %0, %1, %2" : "=v"(r) : "v"(lo), "v"(hi)); return r; }
typedef float f32x2 __attribute__((ext_vector_type(2)));
__device__ __forceinline__ float fsigmoid(float x) { return __builtin_amdgcn_rcpf(1.0f + __builtin_amdgcn_exp2f(-1.4426950408889634f * x)); }
__device__ __forceinline__ float fgelu(float x) { const float z = x * (1.0f + 0.044715f * x * x); return x * __builtin_amdgcn_rcpf(1.0f + __builtin_amdgcn_exp2f(-2.3022081985f * z)); }
__device__ __forceinline__ float bf_lo(unsigned w) { return __uint_as_float(w << 16); }
__device__ __forceinline__ float bf_hi(unsigned w) { return __uint_as_float(w & 0xffff0000u); }

#define EPI_ROWS(ai, m) (row0 + (ai) * HALF + (m) * 16)
__device__ __forceinline__ u32x4 pack8(const f32x4 v0, const f32x4 v1) { u32x4 w; w.x = cvt_pk_bf16(v0[0], v0[1]); w.y = cvt_pk_bf16(v0[2], v0[3]); w.z = cvt_pk_bf16(v1[0], v1[1]); w.w = cvt_pk_bf16(v1[2], v1[3]); return w; }
__device__ __forceinline__ void unpack8(const u32x4 w, f32x4& v0, f32x4& v1) { v0 = (f32x4){bf_lo(w.x), bf_hi(w.x), bf_lo(w.y), bf_hi(w.y)}; v1 = (f32x4){bf_lo(w.z), bf_hi(w.z), bf_lo(w.w), bf_hi(w.w)}; }

struct EpiZ {
    static constexpr bool PERM = true, AFTER_DRAIN = false;
    bf16_t *Q, *K, *V, *XR, *YR; float qscale;
    __device__ __forceinline__ void operator()(const f32x4 (&acc)[2][2][4][2], const Unit& u, int wr, int wc, int fr, int fq) const {
        const int pn = u.pn; bf16_t* base; int ldc, colt; float sc = 1.f;
        if (pn < 8) { base = Q; ldc = 2048; colt = pn * 256; sc = qscale; }
        else if (pn < 10) { base = K; ldc = 512; colt = (pn - 8) * 256; }
        else if (pn < 12) { base = V; ldc = 512; colt = (pn - 10) * 256; }
        else if (pn < 28) { base = XR; ldc = 4096; colt = (pn - 12) * 256; }
        else { base = YR; ldc = 4096; colt = (pn - 28) * 256; }
        const int row0 = u.pm * BM + wr * 64 + fr, col0 = colt + wc * 32 + 8 * fq;
#pragma unroll
        for (int ai = 0; ai < 2; ++ai)
#pragma unroll
            for (int m = 0; m < 4; ++m) { bf16_t* rowp = base + (size_t)EPI_ROWS(ai, m) * ldc + col0;
#pragma unroll
                for (int bj = 0; bj < 2; ++bj) *(u32x4*)(rowp + bj * HALF) = pack8(acc[ai][bj][m][0] * sc, acc[ai][bj][m][1] * sc); }
    }
};
template <int ACT> struct EpiStore {
    static constexpr bool PERM = true, AFTER_DRAIN = false;
    bf16_t* O; int ldc;
    __device__ __forceinline__ void operator()(const f32x4 (&acc)[2][2][4][2], const Unit& u, int wr, int wc, int fr, int fq) const {
        const int row0 = u.pm * BM + wr * 64 + fr, col0 = u.pn * BM + wc * 32 + 8 * fq;
#pragma unroll
        for (int ai = 0; ai < 2; ++ai)
#pragma unroll
            for (int m = 0; m < 4; ++m) { bf16_t* rowp = O + (size_t)EPI_ROWS(ai, m) * ldc + col0;
#pragma unroll
                for (int bj = 0; bj < 2; ++bj) { f32x4 v0 = acc[ai][bj][m][0], v1 = acc[ai][bj][m][1];
                    if (ACT == 1) {
#pragma unroll
                        for (int j = 0; j < 4; ++j) { v0[j] = fsigmoid(v0[j]); v1[j] = fsigmoid(v1[j]); } }
                    *(u32x4*)(rowp + bj * HALF) = pack8(v0, v1); } }
    }
};
struct EpiMulG {
    static constexpr bool PERM = true, AFTER_DRAIN = false;
    const bf16_t* G; float* MA;
    __device__ __forceinline__ void operator()(const f32x4 (&acc)[2][2][4][2], const Unit& u, int wr, int wc, int fr, int fq) const {
        const int row0 = u.pm * BM + wr * 64 + fr, col0 = u.pn * BM + wc * 32 + 8 * fq;
#pragma unroll
        for (int ai = 0; ai < 2; ++ai)
#pragma unroll
            for (int m = 0; m < 4; ++m) { const size_t off = (size_t)EPI_ROWS(ai, m) * 4096 + col0;
#pragma unroll
                for (int bj = 0; bj < 2; ++bj) { f32x4 g0, g1; unpack8(*(const u32x4*)(G + off + bj * HALF), g0, g1);
                    *(f32x4*)(MA + off + bj * HALF) = acc[ai][bj][m][0] * g0; *(f32x4*)(MA + off + bj * HALF + 4) = acc[ai][bj][m][1] * g1; } }
    }
};
struct EpiMerge {
    static constexpr bool PERM = true, AFTER_DRAIN = false;
    const bf16_t* G; const float* MA; bf16_t* O;
    __device__ __forceinline__ void operator()(const f32x4 (&acc)[2][2][4][2], const Unit& u, int wr, int wc, int fr, int fq) const {
        const int row0 = u.pm * BM + wr * 64 + fr, col0 = u.pn * BM + wc * 32 + 8 * fq;
#pragma unroll
        for (int ai = 0; ai < 2; ++ai)
#pragma unroll
            for (int m = 0; m < 4; ++m) { const size_t off = (size_t)EPI_ROWS(ai, m) * 4096 + col0;
#pragma unroll
                for (int bj = 0; bj < 2; ++bj) { f32x4 g0, g1; unpack8(*(const u32x4*)(G + off + bj * HALF), g0, g1);
                    const f32x4 m0 = *(const f32x4*)(MA + off + bj * HALF), m1 = *(const f32x4*)(MA + off + bj * HALF + 4);
                    *(u32x4*)(O + off + bj * HALF) = pack8(acc[ai][bj][m][0] * g0 + m0, acc[ai][bj][m][1] * g1 + m1); } }
    }
};
struct EpiResid0 {
    static constexpr bool PERM = true, AFTER_DRAIN = false;
    const float *xa, *xb; float* O;
    __device__ __forceinline__ void operator()(const f32x4 (&acc)[2][2][4][2], const Unit& u, int wr, int wc, int fr, int fq) const {
        const int row0 = u.pm * BM + wr * 64 + fr, col0 = u.pn * BM + wc * 32 + 8 * fq;
        const float* X = (u.pm < 64) ? xa : (xb - (size_t)16384 * 4096);
#pragma unroll
        for (int ai = 0; ai < 2; ++ai)
#pragma unroll
            for (int m = 0; m < 4; ++m) { const size_t off = (size_t)EPI_ROWS(ai, m) * 4096 + col0;
#pragma unroll
                for (int bj = 0; bj < 2; ++bj) {
                    const f32x4 x0 = *(const f32x4*)(X + off + bj * HALF), x1 = *(const f32x4*)(X + off + bj * HALF + 4);
                    *(f32x4*)(O + off + bj * HALF) = x0 + acc[ai][bj][m][0]; *(f32x4*)(O + off + bj * HALF + 4) = x1 + acc[ai][bj][m][1]; } }
    }
};
struct EpiResidAcc {
    static constexpr bool PERM = true, AFTER_DRAIN = false;
    float* X; bf16_t* XB;
    __device__ __forceinline__ void operator()(const f32x4 (&acc)[2][2][4][2], const Unit& u, int wr, int wc, int fr, int fq) const {
        const int row0 = u.pm * BM + wr * 64 + fr, col0 = u.pn * BM + wc * 32 + 8 * fq;
#pragma unroll
        for (int ai = 0; ai < 2; ++ai)
#pragma unroll
            for (int m = 0; m < 4; ++m) { const size_t off = (size_t)EPI_ROWS(ai, m) * 4096 + col0;
#pragma unroll
                for (int bj = 0; bj < 2; ++bj) {
                    const f32x4 x0 = *(const f32x4*)(X + off + bj * HALF) + acc[ai][bj][m][0], x1 = *(const f32x4*)(X + off + bj * HALF + 4) + acc[ai][bj][m][1];
                    *(f32x4*)(X + off + bj * HALF) = x0; *(f32x4*)(X + off + bj * HALF + 4) = x1; *(u32x4*)(XB + off + bj * HALF) = pack8(x0, x1); } }
    }
};
struct EpiEU {
    static constexpr bool PERM = true, AFTER_DRAIN = false;
    bf16_t* O; float* SS;
    __device__ __forceinline__ void operator()(const f32x4 (&acc)[2][2][4][2], const Unit& u, int wr, int wc, int fr, int fq) const {
        const int row0 = u.pm * BM + wr * 64 + fr, col0 = u.pn * BM + wc * 32 + 8 * fq;
#pragma unroll
        for (int ai = 0; ai < 2; ++ai)
#pragma unroll
            for (int m = 0; m < 4; ++m) { const size_t off = (size_t)EPI_ROWS(ai, m) * 4096 + col0; float s = 0.f;
#pragma unroll
                for (int bj = 0; bj < 2; ++bj) { const f32x4 v0 = acc[ai][bj][m][0], v1 = acc[ai][bj][m][1];
                    s += (v0[0] * v0[0] + v0[1] * v0[1]) + (v0[2] * v0[2] + v0[3] * v0[3]) + (v1[0] * v1[0] + v1[1] * v1[1]) + (v1[2] * v1[2] + v1[3] * v1[3]);
                    *(u32x4*)(O + off + bj * HALF) = pack8(v0, v1); }
                s += __shfl_xor(s, 16); s += __shfl_xor(s, 32);
                if (fq == 0) SS[(size_t)EPI_ROWS(ai, m) * 64 + u.pn * 4 + wc] = s; }
    }
};
struct EpiPle {
    static constexpr bool PERM = true, AFTER_DRAIN = false;
    float* X; const bf16_t* EU; const float* rstd; const float* g; float* SS;
    __device__ __forceinline__ void operator()(const f32x4 (&acc)[2][2][4][2], const Unit& u, int wr, int wc, int fr, int fq) const {
        const int row0 = u.pm * BM + wr * 64 + fr, col0 = u.pn * BM + wc * 32 + 8 * fq;
        f32x4 gv[2][2];
#pragma unroll
        for (int bj = 0; bj < 2; ++bj) { gv[bj][0] = *(const f32x4*)(g + col0 + bj * HALF); gv[bj][1] = *(const f32x4*)(g + col0 + bj * HALF + 4); }
#pragma unroll
        for (int ai = 0; ai < 2; ++ai)
#pragma unroll
            for (int m = 0; m < 4; ++m) { const int row = EPI_ROWS(ai, m); const size_t off = (size_t)row * 4096 + col0; const float rs = rstd[row]; float s = 0.f;
#pragma unroll
                for (int bj = 0; bj < 2; ++bj) { f32x4 e0, e1; unpack8(*(const u32x4*)(EU + off + bj * HALF), e0, e1);
                    f32x4 x0 = *(const f32x4*)(X + off + bj * HALF), x1 = *(const f32x4*)(X + off + bj * HALF + 4);
                    const f32x4 a0 = acc[ai][bj][m][0], a1 = acc[ai][bj][m][1];
#pragma unroll
                    for (int j = 0; j < 4; ++j) { x0[j] += fsigmoid(a0[j]) * (e0[j] * rs * gv[bj][0][j]); x1[j] += fsigmoid(a1[j]) * (e1[j] * rs * gv[bj][1][j]); }
                    s += (x0[0] * x0[0] + x0[1] * x0[1]) + (x0[2] * x0[2] + x0[3] * x0[3]) + (x1[0] * x1[0] + x1[1] * x1[1]) + (x1[2] * x1[2] + x1[3] * x1[3]);
                    *(f32x4*)(X + off + bj * HALF) = x0; *(f32x4*)(X + off + bj * HALF + 4) = x1; }
                s += __shfl_xor(s, 16); s += __shfl_xor(s, 32);
                if (fq == 0) SS[(size_t)row * 64 + u.pn * 4 + wc] = s; }
    }
};
#undef EPI_ROWS

template <class Epi, class Sched, bool ALIGN_EPI = false, bool SP2 = false>
__device__ __forceinline__ void gemm_phase(PG8_LAS unsigned char* lds, const Gemm g, const Sched& S, const Epi& E, const int tid) {
    const int wid = __builtin_amdgcn_readfirstlane(tid >> 6), lane = tid & 63, wr = wid >> 2, wc = wid & 3, fr = lane & 15, fq = lane >> 4;
    const int K = g.K, nt = K / BK;
    unsigned voffA[2], voffB[2];
#pragma unroll
    for (int i = 0; i < 2; ++i) { int R, C; stage_rc(tid * 16 + i * 8192, R, C); const int Rb = Epi::PERM ? ((R & ~31) + perm32(R & 31)) : R;
        voffA[i] = (unsigned)(R * K + C) * 2u; voffB[i] = (unsigned)(Rb * K + C) * 2u; }
    const size_t kstep = (size_t)(BK * 2);
    const size_t hstep = (size_t)HALF * K * 2;
    const size_t tstep = 2 * hstep;
    const unsigned ldsw = (unsigned)wid * 1024u;
    const int aoff = lds_byte(wr * 64 + fr, fq * 8), boff = lds_byte(wc * 32 + fr, fq * 8);
#define PG8_SA(b, h) (((b) * 2 + (h)) * HTB)
#define PG8_SB(b, h) ((4 + (b) * 2 + (h)) * HTB)
#define PG8_STAGE(bufoff, gbase, voff) do { _Pragma("unroll") for (int _i = 0; _i < 2; ++_i) \
        __builtin_amdgcn_global_load_lds((const unsigned*)((const char*)(gbase) + (voff)[_i]), (PG8_LAS unsigned*)(lds + (bufoff) + ldsw + _i * 8192), 16, 0, 0); } while (0)
#define PG8_LDA(dst, b, h) do { _Pragma("unroll") for (int m = 0; m < 4; ++m) _Pragma("unroll") for (int k = 0; k < 2; ++k) dst[m][k] = *(const PG8_LAS bf16x8*)(lds + PG8_SA(b, h) + aoff + m * 2048 + k * 1024); } while (0)
#define PG8_LDB(dst, b, h) do { _Pragma("unroll") for (int n = 0; n < 2; ++n) _Pragma("unroll") for (int k = 0; k < 2; ++k) dst[n][k] = *(const PG8_LAS bf16x8*)(lds + PG8_SB(b, h) + boff + n * 2048 + k * 1024); } while (0)
#define PG8_MMA(ai, bj, At, Bt) do { __builtin_amdgcn_s_setprio(1); _Pragma("unroll") for (int m = 0; m < 4; ++m) _Pragma("unroll") for (int n = 0; n < 2; ++n) _Pragma("unroll") for (int k = 0; k < 2; ++k) \
        acc[ai][bj][m][n] = __builtin_amdgcn_mfma_f32_16x16x32_bf16(Bt[n][k], At[m][k], acc[ai][bj][m][n], 0, 0, 0); __builtin_amdgcn_s_setprio(0); } while (0)
#define PG8_WAIT_V(n) asm volatile("s_waitcnt vmcnt(" #n ")" ::: "memory")
#define PG8_WAIT_L(n) asm volatile("s_waitcnt lgkmcnt(" #n ")" ::: "memory")
#define PG8_BAR __builtin_amdgcn_s_barrier()
#define PG8_SCHED __builtin_amdgcn_sched_barrier(0)
    Unit cur, nxt; int ui = 0;
    if (!S.next(0, cur)) return;
    f32x4 acc[2][2][4][2];
#pragma unroll
    for (int a = 0; a < 2; ++a)
#pragma unroll
        for (int b = 0; b < 2; ++b)
#pragma unroll
            for (int m = 0; m < 4; ++m)
#pragma unroll
                for (int n = 0; n < 2; ++n) acc[a][b][m][n] = (f32x4){0.f, 0.f, 0.f, 0.f};
    bf16x8 At[4][2], B0[2][2], B1[2][2];
    const char* cA = (const char*)g.A + (size_t)cur.pm * tstep; const char* cB = (const char*)g.Bt + (size_t)cur.pn * tstep;
    S.a_ready(cur);
    if constexpr (SP2) {
        PG8_STAGE(PG8_SB(0, 0), cB, voffB); PG8_STAGE(PG8_SB(0, 1), cB + hstep, voffB); PG8_STAGE(PG8_SA(0, 0), cA, voffA); PG8_STAGE(PG8_SA(0, 1), cA + hstep, voffA);
        if (wr == 1) PG8_BAR;
        PG8_WAIT_V(2); PG8_BAR;
        PG8_STAGE(PG8_SB(1, 0), cB + kstep, voffB); PG8_STAGE(PG8_SA(1, 0), cA + kstep, voffA); PG8_STAGE(PG8_SB(1, 1), cB + hstep + kstep, voffB);
        PG8_WAIT_V(6); PG8_BAR;
    } else {
        PG8_STAGE(PG8_SB(0, 0), cB, voffB); PG8_STAGE(PG8_SA(0, 0), cA, voffA); PG8_STAGE(PG8_SB(0, 1), cB + hstep, voffB); PG8_STAGE(PG8_SA(0, 1), cA + hstep, voffA);
        if (wr == 1) PG8_BAR;
        PG8_WAIT_V(4); PG8_BAR;
        PG8_STAGE(PG8_SB(1, 0), cB + kstep, voffB); PG8_STAGE(PG8_SA(1, 0), cA + kstep, voffA); PG8_STAGE(PG8_SB(1, 1), cB + hstep + kstep, voffB);
        PG8_WAIT_V(6); PG8_BAR;
    }
    for (;;) {
        const bool has_next = S.next(ui + 1, nxt);
        const char* nA = has_next ? (const char*)g.A + (size_t)nxt.pm * tstep : cA; const char* nB = has_next ? (const char*)g.Bt + (size_t)nxt.pn * tstep : cB;
        for (int t = 0; t < nt; t += 2) {
            const bool last = (t == nt - 2);
            const char* a1 = cA + (size_t)(t + 1) * kstep;
            const char* a2 = last ? nA : cA + (size_t)(t + 2) * kstep; const char* b2 = last ? nB : cB + (size_t)(t + 2) * kstep;
            const char* a3 = a2 + kstep; const char* b3 = b2 + kstep;
            if (last && has_next) S.a_ready(nxt);
            if constexpr (SP2) {
            PG8_LDB(B0, 0, 0); PG8_LDB(B1, 0, 1); PG8_SCHED; PG8_LDA(At, 0, 0); PG8_STAGE(PG8_SA(1, 1), a1 + hstep, voffA);
            PG8_WAIT_V(8); PG8_WAIT_L(0); PG8_BAR; PG8_MMA(0, 0, At, B0); PG8_MMA(0, 1, At, B1); PG8_BAR; PG8_SCHED;
            PG8_LDA(At, 0, 1); PG8_STAGE(PG8_SB(0, 0), b2, voffB); PG8_STAGE(PG8_SB(0, 1), b2 + hstep, voffB); PG8_STAGE(PG8_SA(0, 0), a2, voffA);
            PG8_WAIT_V(8); PG8_WAIT_L(0); PG8_BAR; PG8_MMA(1, 0, At, B0); PG8_MMA(1, 1, At, B1); PG8_BAR; PG8_SCHED;
            PG8_LDB(B0, 1, 0); PG8_LDB(B1, 1, 1); PG8_SCHED; PG8_LDA(At, 1, 0); PG8_STAGE(PG8_SA(0, 1), a2 + hstep, voffA);
            PG8_WAIT_V(8); PG8_WAIT_L(0); PG8_BAR; PG8_MMA(0, 0, At, B0); PG8_MMA(0, 1, At, B1); PG8_BAR; PG8_SCHED;
            PG8_LDA(At, 1, 1); PG8_STAGE(PG8_SB(1, 0), b3, voffB); PG8_STAGE(PG8_SB(1, 1), b3 + hstep, voffB); PG8_STAGE(PG8_SA(1, 0), a3, voffA);
            PG8_WAIT_V(8); PG8_WAIT_L(0); PG8_BAR; PG8_MMA(1, 0, At, B0); PG8_MMA(1, 1, At, B1); PG8_BAR; PG8_SCHED;
            } else {
            PG8_LDB(B0, 0, 0); PG8_SCHED; PG8_LDA(At, 0, 0); PG8_STAGE(PG8_SA(1, 1), a1 + hstep, voffA);
            PG8_WAIT_L(8); PG8_BAR; PG8_WAIT_L(0); PG8_MMA(0, 0, At, B0); PG8_BAR; PG8_SCHED;
            PG8_LDB(B1, 0, 1); PG8_STAGE(PG8_SB(0, 0), b2, voffB);
            PG8_BAR; PG8_WAIT_L(0); PG8_MMA(0, 1, At, B1); PG8_BAR;
            PG8_LDA(At, 0, 1); PG8_STAGE(PG8_SA(0, 0), a2, voffA);
            PG8_BAR; PG8_WAIT_L(0); PG8_MMA(1, 0, At, B0); PG8_BAR; PG8_SCHED;
            PG8_STAGE(PG8_SB(0, 1), b2 + hstep, voffB);
            PG8_WAIT_V(6); PG8_BAR; PG8_MMA(1, 1, At, B1); PG8_BAR;
            PG8_LDB(B0, 1, 0); PG8_SCHED; PG8_LDA(At, 1, 0); PG8_STAGE(PG8_SA(0, 1), a2 + hstep, voffA);
            PG8_WAIT_L(8); PG8_BAR; PG8_WAIT_L(0); PG8_MMA(0, 0, At, B0); PG8_BAR; PG8_SCHED;
            PG8_LDB(B1, 1, 1); PG8_STAGE(PG8_SB(1, 0), b3, voffB);
            PG8_BAR; PG8_WAIT_L(0); PG8_MMA(0, 1, At, B1); PG8_BAR;
            PG8_LDA(At, 1, 1); PG8_STAGE(PG8_SA(1, 0), a3, voffA);
            PG8_BAR; PG8_WAIT_L(0); PG8_MMA(1, 0, At, B0); PG8_BAR; PG8_SCHED;
            PG8_STAGE(PG8_SB(1, 1), b3 + hstep, voffB);
            PG8_WAIT_V(6); PG8_BAR; PG8_MMA(1, 1, At, B1); PG8_BAR;
            }
        }
        if constexpr (ALIGN_EPI) { if (wr == 0) PG8_BAR; }
        if constexpr (!Epi::AFTER_DRAIN) { E(acc, cur, wr, wc, fr, fq); S.done(cur); }
        if (!has_next) break;
#pragma unroll
        for (int a = 0; a < 2; ++a)
#pragma unroll
            for (int b = 0; b < 2; ++b)
#pragma unroll
                for (int m = 0; m < 4; ++m)
#pragma unroll
                    for (int n = 0; n < 2; ++n) acc[a][b][m][n] = (f32x4){0.f, 0.f, 0.f, 0.f};
        cur = nxt; cA = nA; cB = nB; ++ui;
        if constexpr (ALIGN_EPI) { if (wr == 1) PG8_BAR; }
    }
    PG8_WAIT_V(0);
    if constexpr (!ALIGN_EPI) { if (wr == 0) PG8_BAR; }
    PG8_BAR;
    if constexpr (Epi::AFTER_DRAIN) { E.fused(acc, cur, wr, wc, fr, fq, lds, wid, lane); S.done(cur); }
#undef PG8_SA
#undef PG8_SB
#undef PG8_STAGE
#undef PG8_LDA
#undef PG8_LDB
#undef PG8_MMA
#undef PG8_WAIT_V
#undef PG8_WAIT_L
#undef PG8_BAR
#undef PG8_SCHED
}
}

constexpr int NWAVES = 8;
constexpr int D = 4096, M = 32768, SEQ_P = 16384, SEQ_S = 2048;
constexpr int ATTN_W = 2048, KV_W = 512, D_RNN = 4096, D_FF = 12288, PLE = 256, IN_W = 11264;
constexpr int MSB = 8192, NSB = M / MSB;
constexpr int NBOUND = SEQ_P / MSB - 1;
constexpr int LCH = 32, NCHUNK = M / LCH;
constexpr float EPS = 1e-6f;
constexpr float LOG2E = 1.4426950408889634f;

constexpr size_t MiB = 1u << 20;
constexpr size_t WS_CTL = 0, CTL_ZERO_BYTES = 1 * MiB;
constexpr size_t WS_H = 1 * MiB;
constexpr size_t WS_Q = WS_H + 256 * MiB;
constexpr size_t WS_K = WS_Q + 128 * MiB;
constexpr size_t WS_V = WS_K + 32 * MiB;
constexpr size_t WS_REC = WS_V + 32 * MiB;
constexpr size_t WS_G = WS_REC + 256 * MiB;
constexpr size_t WS_MRG = WS_G + 256 * MiB;
constexpr size_t WS_AGG = WS_MRG + 256 * MiB;
constexpr size_t WS_CIN = WS_AGG + 64 * MiB;
constexpr size_t WS_W1 = WS_CIN + 32 * MiB;
constexpr size_t WS_WIN = WS_W1;
constexpr size_t WS_WG = WS_WIN + 88 * MiB;
constexpr size_t WS_WOA = WS_WG + 64 * MiB;
constexpr size_t WS_WOR = WS_WOA + 16 * MiB;
constexpr size_t WS_WOUT = WS_WOR + 32 * MiB;
constexpr size_t WS_LWA = WS_WOUT + 32 * MiB;
constexpr size_t WS_LWX = WS_LWA + 4 * MiB;
constexpr size_t WS_END1 = WS_LWX + 4 * MiB;
constexpr size_t WS_HN2 = 1 * MiB;
constexpr size_t WS_WUP = WS_HN2 + 256 * MiB;
constexpr size_t WS_WDN = WS_WUP + 192 * MiB;
constexpr size_t WS_WPG = WS_WDN + 96 * MiB;
constexpr size_t WS_WPL = WS_WPG + 32 * MiB;
constexpr size_t WS_PB = WS_WPL + 2 * MiB;
constexpr size_t WS_HALO = WS_PB + 16 * MiB;
constexpr size_t WS_SS = WS_HALO + 1 * MiB;
constexpr size_t WS_RSE = WS_SS + 8 * MiB;
constexpr size_t WS_X2B = WS_RSE + 1 * MiB;
constexpr size_t WS_Y = WS_X2B + 256 * MiB;
constexpr size_t WS_ACT = WS_Y + 384 * MiB;
constexpr size_t WS_END2 = WS_ACT + 192 * MiB;
constexpr size_t WS_EU = WS_Y;
constexpr size_t WS_NEED = (WS_END1 > WS_END2 ? WS_END1 : WS_END2);
static_assert(WS_NEED <= (size_t)1664 * MiB, "d_ws map exceeds the guaranteed workspace");
constexpr int CW_BAR = 4096;

constexpr int RING_OFF = 0;
#ifndef LRU_PITCH
#define LRU_PITCH 264
#endif
constexpr int LRU_P = LRU_PITCH;
constexpr int L_XCF = 0, L_AS = L_XCF + LCH * LRU_P * 4, L_BS = L_AS + LCH * LRU_P * 4, L_HS = L_BS + LCH * LRU_P * 4, L_XCB = L_HS + LCH * LRU_P * 4, L_END = L_XCB + LCH * LRU_P * 2;
constexpr int VT_PITCH = 816;
constexpr int MISC_OFF = 153600, LDS_BYTES = MISC_OFF + 512;
static_assert(L_END <= MISC_OFF && 128 * VT_PITCH <= MISC_OFF && 131072 <= MISC_OFF, "LDS map");

#define GAS __attribute__((address_space(1)))
#define LAS __attribute__((address_space(3)))
typedef unsigned short bf16;
typedef unsigned v4u __attribute__((ext_vector_type(4)));
typedef unsigned v2u __attribute__((ext_vector_type(2)));
typedef float f32x4 __attribute__((ext_vector_type(4)));
typedef float f32x16 __attribute__((ext_vector_type(16)));
typedef float f32x2 __attribute__((ext_vector_type(2)));
typedef short bf16x8 __attribute__((ext_vector_type(8)));
typedef GAS unsigned gu32;
#define RLX_AGENT __ATOMIC_RELAXED, __HIP_MEMORY_SCOPE_AGENT
#define LDS_WAIT() asm volatile("s_waitcnt lgkmcnt(0)" ::: "memory")
#define VM_WAIT() asm volatile("s_waitcnt vmcnt(0)" ::: "memory")
__device__ __forceinline__ unsigned f2bf(float f) { unsigned u = __builtin_bit_cast(unsigned, f); return (u + 0x7fffu + ((u >> 16) & 1u)) >> 16; }
__device__ __forceinline__ unsigned pk2(float lo, float hi) { return f2bf(lo) | (f2bf(hi) << 16); }
using pg8::fsigmoid; using pg8::fgelu; using pg8::bf_lo; using pg8::bf_hi;

#define XB_TMO      128
#define XB_XCNT(j)  (256  + 64 * (j))
#define XB_XSUB(j)  (1280 + 64 * (j))
#define XB_XGEN(j)  (2304 + 64 * (j))
#define XB_TOP      3328
#define XB_TOPGEN   3392
#define XCD_BAR_WORDS 3456
#define XB_SPIN_CAP (1u << 18)

__device__ __forceinline__ unsigned xb_ld(unsigned* p)              { return __hip_atomic_load(p, __ATOMIC_RELAXED, __HIP_MEMORY_SCOPE_AGENT); }
__device__ __forceinline__ unsigned xb_add(unsigned* p, unsigned v) { return __hip_atomic_fetch_add(p, v, __ATOMIC_RELAXED, __HIP_MEMORY_SCOPE_AGENT); }
__device__ __forceinline__ unsigned xb_xcc_id() { return (unsigned)__builtin_amdgcn_s_getreg((3 << 11) | 20) & 0xFu; }
#define XB_SPIN(cond, bar) do { unsigned _sp = 0; while (cond) { __builtin_amdgcn_s_sleep(1); \
    if ((++_sp & 255u) == 0u) { if (xb_ld(&(bar)[XB_TMO])) break; if (_sp > XB_SPIN_CAP) { atomicAdd(&(bar)[XB_TMO], 1u); break; } } } } while (0)

struct XcdBarrier {
    unsigned* bar; unsigned x;
    volatile LAS unsigned* st;
};

__device__ __forceinline__ XcdBarrier xcd_barrier_post(unsigned* bar, volatile LAS unsigned* st) {
    XcdBarrier b; b.bar = bar; b.x = xb_xcc_id(); b.st = st;
    if (threadIdx.x == 0) (void)xb_add(&bar[XB_XCNT(b.x)], 1u);
    return b;
}
__device__ __forceinline__ void xcd_barrier_complete(unsigned* bar, unsigned x, unsigned& nloc, unsigned& nx) {
    const unsigned G = gridDim.x * gridDim.y * gridDim.z;
    unsigned sum, cnt, mine, sp = 0u;
    for (;;) {
        sum = 0u; cnt = 0u; mine = 0u;
#pragma unroll
        for (unsigned j = 0; j < 16; ++j) { const unsigned c = xb_ld(&bar[XB_XCNT(j)]); sum += c; cnt += (c > 0u) ? 1u : 0u; mine = (j == x) ? c : mine; }
        if (sum == G) break;
        __builtin_amdgcn_s_sleep(1);
        if ((++sp & 255u) == 0u) { if (xb_ld(&bar[XB_TMO])) break; if (sp > XB_SPIN_CAP) { atomicAdd(&bar[XB_TMO], 1u); break; } }
    }
    nloc = mine > 0u ? mine : 1u; nx = cnt > 0u ? cnt : 1u;
}

__device__ __forceinline__ void xcd_barrier(const XcdBarrier& b, const int tid) {
    asm volatile("s_waitcnt vmcnt(0)" ::: "memory");
    __syncthreads();
    if (tid == 0) {
        unsigned* bar = b.bar;
        __builtin_amdgcn_s_waitcnt(0);
        unsigned nloc = b.st[0], nx = b.st[1];
        if (nloc == 0u) { xcd_barrier_complete(bar, b.x, nloc, nx); b.st[0] = nloc; b.st[1] = nx; }
        const unsigned old = xb_add(&bar[XB_XSUB(b.x)], 1u);
        const unsigned gen = old / nloc;
        if (old + 1u == (gen + 1u) * nloc) {
            __builtin_amdgcn_fence(__ATOMIC_RELEASE, "agent");
            asm volatile("s_waitcnt vmcnt(0)" ::: "memory");
            const unsigned og = xb_add(&bar[XB_TOP], 1u);
            const unsigned tg = og / nx;
            if (og + 1u == (tg + 1u) * nx) xb_add(&bar[XB_TOPGEN], 1u);
            else XB_SPIN(xb_ld(&bar[XB_TOPGEN]) == tg, bar);
            __builtin_amdgcn_fence(__ATOMIC_ACQUIRE, "agent");
            xb_add(&bar[XB_XGEN(b.x)], 1u);
            asm volatile("s_waitcnt vmcnt(0)" ::: "memory");
        } else {
            XB_SPIN(xb_ld(&bar[XB_XGEN(b.x)]) == gen, bar);
            __builtin_amdgcn_fence(__ATOMIC_ACQUIRE, "agent");
            asm volatile("s_waitcnt vmcnt(0)" ::: "memory");
        }
    }
    __syncthreads();
}

struct Frame {
    LAS unsigned char* lds;
    volatile LAS unsigned* MISC;
    gu32* ctl;
    int tid, lane, wave;
    int vcu, G;
};
__device__ __forceinline__ float wave_sum(float v) {
#pragma unroll
    for (int o = 1; o < 64; o <<= 1) v += __shfl_xor(v, o);
    return v;
}
__device__ __forceinline__ void seq_bounds(int row, int& s0, int& s1) { if (row < SEQ_P) { s0 = 0; s1 = SEQ_P; } else { s0 = row & ~(SEQ_S - 1); s1 = s0 + SEQ_S; } }

__device__ __forceinline__ void transpose_item(const float* W, int K, int N, bf16* WT, LAS float* scr, int item, int lane) {
    const int nblk = N / 32, kb = item / nblk, nb = item % nblk, k0 = 64 * kb, n0 = 32 * nb;
#pragma unroll 8
    for (int i = 0; i < 32; ++i) { const int kk = 2 * i + (lane >> 5); scr[kk * 33 + (lane & 31)] = W[(size_t)(k0 + kk) * N + n0 + (lane & 31)]; }
    LDS_WAIT(); asm volatile("" ::: "memory");
    const int c = lane & 7;
#pragma unroll
    for (int j = 0; j < 4; ++j) { const int n = (lane >> 3) + 8 * j; const LAS float* s = scr + (8 * c) * 33 + n;
        v4u o; o.x = pk2(s[0 * 33], s[1 * 33]); o.y = pk2(s[2 * 33], s[3 * 33]); o.z = pk2(s[4 * 33], s[5 * 33]); o.w = pk2(s[6 * 33], s[7 * 33]);
        *(GAS v4u*)(WT + (size_t)(n0 + n) * K + k0 + 8 * c) = o; }
    LDS_WAIT(); asm volatile("" ::: "memory");
}
__device__ __forceinline__ void convert_weight(Frame& F, const float* W, int K, int N, int nmat, bf16* WT) {
    LAS float* scr = (LAS float*)(F.lds + RING_OFF + F.wave * 16384);
    const int gw = F.vcu * NWAVES + F.wave, NGW = F.G * NWAVES;
    const int per = (K / 64) * (N / 32), total = per * nmat;
    for (int it = gw; it < total; it += NGW) { const int mi = it / per, r = it - mi * per;
        transpose_item(W + (size_t)mi * K * N, K, N, WT + (size_t)mi * K * N, scr, r, F.lane); }
}
__device__ __forceinline__ void rms_row_to_bf16(const float* xrow, const float* g, bf16* orow, int lane) {
    const GAS f32x4* xr = (const GAS f32x4*)xrow + lane;
    f32x4 v[16]; float s = 0.f;
#pragma unroll
    for (int j = 0; j < 16; ++j) { v[j] = xr[64 * j]; s += (v[j].x * v[j].x + v[j].y * v[j].y) + (v[j].z * v[j].z + v[j].w * v[j].w); }
    const float rstd = 1.0f / sqrtf(wave_sum(s) * (1.f / D) + EPS);
    const GAS f32x4* gr = (const GAS f32x4*)g + lane;
    GAS v2u* o8 = (GAS v2u*)orow + lane;
#pragma unroll
    for (int j = 0; j < 16; ++j) { const f32x4 gv = gr[64 * j]; v2u w; w.x = pk2(v[j].x * rstd * gv.x, v[j].y * rstd * gv.y); w.y = pk2(v[j].z * rstd * gv.z, v[j].w * rstd * gv.w); o8[64 * j] = w; }
}

__device__ __forceinline__ void attn_unit(Frame& F, const bf16* Qb, const bf16* Kb, const bf16* Vb, bf16* Ob, const float* sink, int qblk, int hkv) {
    LAS unsigned char* lds = F.lds;
    const int lane = F.lane, wave = F.wave;
    const int row_blk = qblk * 128; int s0, s1; seq_bounds(row_blk, s0, s1);
    const int kbase = row_blk - 128;
    __syncthreads();
#pragma unroll
    for (int oo = 0; oo < 2; ++oo) { const int o = 2 * wave + oo;
#pragma unroll
        for (int j = 0; j < 4; ++j) { const int kp = lane + 64 * j;
            if (kp < 200) { const int r0 = kbase + 2 * kp;
                v4u a = (v4u){0u, 0u, 0u, 0u}, b = a;
                if (r0 >= s0 && r0 < s1) { a = *(const GAS v4u*)(Vb + (size_t)r0 * KV_W + hkv * 128 + 8 * o); b = *(const GAS v4u*)(Vb + (size_t)(r0 + 1) * KV_W + hkv * 128 + 8 * o); }
                LAS unsigned char* dst = lds + (8 * o) * VT_PITCH + 4 * kp;
                *(LAS unsigned*)(dst + 0 * VT_PITCH) = (a.x & 0xffffu) | (b.x << 16);
                *(LAS unsigned*)(dst + 1 * VT_PITCH) = (a.x >> 16) | (b.x & 0xffff0000u);
                *(LAS unsigned*)(dst + 2 * VT_PITCH) = (a.y & 0xffffu) | (b.y << 16);
                *(LAS unsigned*)(dst + 3 * VT_PITCH) = (a.y >> 16) | (b.y & 0xffff0000u);
                *(LAS unsigned*)(dst + 4 * VT_PITCH) = (a.z & 0xffffu) | (b.z << 16);
                *(LAS unsigned*)(dst + 5 * VT_PITCH) = (a.z >> 16) | (b.z & 0xffff0000u);
                *(LAS unsigned*)(dst + 6 * VT_PITCH) = (a.w & 0xffffu) | (b.w << 16);
                *(LAS unsigned*)(dst + 7 * VT_PITCH) = (a.w >> 16) | (b.w & 0xffff0000u);
            } } }
    __syncthreads();
    const int qn = lane & 15, quad = lane >> 4;
    const int r0q = row_blk + 16 * wave, ks = r0q - 128, tq = r0q + qn;
    for (int g = 0; g < 4; ++g) {
        const int hq = hkv * 4 + g;
        bf16x8 qf[4];
#pragma unroll
        for (int kk = 0; kk < 4; ++kk) qf[kk] = *(const GAS bf16x8*)(Qb + (size_t)tq * ATTN_W + hq * 128 + 32 * kk + 8 * quad);
        f32x4 s[18];
#pragma unroll
        for (int t = 0; t < 18; ++t) { int krow = ks + 16 * t + qn; krow = krow < 0 ? 0 : (krow > M - 1 ? M - 1 : krow);
            const bf16* kp = Kb + (size_t)krow * KV_W + hkv * 128 + 8 * quad;
            f32x4 acc = (f32x4){0.f, 0.f, 0.f, 0.f};
#pragma unroll
            for (int kk = 0; kk < 4; ++kk) acc = __builtin_amdgcn_mfma_f32_16x16x32_bf16(*(const GAS bf16x8*)(kp + 32 * kk), qf[kk], acc, 0, 0, 0);
            s[t] = acc; }
        const float slope2 = exp2f(-0.5f * (float)(hq + 1)) * LOG2E, sink2 = sink[hq] * LOG2E;
        float mx = -3.0e38f;
#pragma unroll
        for (int t = 0; t < 18; ++t)
#pragma unroll
            for (int r = 0; r < 4; ++r) { const int tk = ks + 16 * t + 4 * quad + r; int dist = tq - tk; dist = dist < 0 ? -dist : dist;
                const bool ok = (dist <= 128) && (tk >= s0) && (tk < s1);
                const float v = ok ? s[t][r] - slope2 * (float)dist : -1.0e30f; s[t][r] = v; mx = fmaxf(mx, v); }
        mx = fmaxf(mx, __shfl_xor(mx, 16)); mx = fmaxf(mx, __shfl_xor(mx, 32)); mx = fmaxf(mx, sink2);
        float l = 0.f;
#pragma unroll
        for (int t = 0; t < 18; ++t)
#pragma unroll
            for (int r = 0; r < 4; ++r) { const float p = __builtin_amdgcn_exp2f(s[t][r] - mx); s[t][r] = p; l += p; }
        l += __shfl_xor(l, 16); l += __shfl_xor(l, 32); l += __builtin_amdgcn_exp2f(sink2 - mx);
        const float inv = 1.0f / l;
        f32x4 o[8];
#pragma unroll
        for (int dt = 0; dt < 8; ++dt) o[dt] = (f32x4){0.f, 0.f, 0.f, 0.f};
#pragma unroll
        for (int j = 0; j < 9; ++j) {
            v4u pw; pw.x = pg8::cvt_pk_bf16(s[2 * j][0], s[2 * j][1]); pw.y = pg8::cvt_pk_bf16(s[2 * j][2], s[2 * j][3]); pw.z = pg8::cvt_pk_bf16(s[2 * j + 1][0], s[2 * j + 1][1]); pw.w = pg8::cvt_pk_bf16(s[2 * j + 1][2], s[2 * j + 1][3]);
            const bf16x8 pb = __builtin_bit_cast(bf16x8, pw);
#pragma unroll
            for (int dt = 0; dt < 8; ++dt) {
                const LAS unsigned char* vp = lds + (16 * dt + qn) * VT_PITCH + 2 * (16 * wave + 32 * j + 4 * quad);
                const v2u v0 = *(const LAS v2u*)vp, v1 = *(const LAS v2u*)(vp + 32);
                v4u vw; vw.x = v0.x; vw.y = v0.y; vw.z = v1.x; vw.w = v1.y;
                o[dt] = __builtin_amdgcn_mfma_f32_16x16x32_bf16(__builtin_bit_cast(bf16x8, vw), pb, o[dt], 0, 0, 0); } }
#pragma unroll
        for (int dt = 0; dt < 8; ++dt) { v2u w; w.x = pg8::cvt_pk_bf16(o[dt][0] * inv, o[dt][1] * inv); w.y = pg8::cvt_pk_bf16(o[dt][2] * inv, o[dt][3] * inv);
            *(GAS v2u*)(Ob + (size_t)tq * ATTN_W + hq * 128 + 16 * dt + 4 * quad) = w; }
    }
}

struct LruArgs { const bf16 *XR, *YR; const float *cw, *cb; const bf16 *WA, *WX; const float *ba, *bx, *lam; float* AGG; const float* CIN; bf16* REC; float* DBG; const float *WAF, *WXF; float* DBGX; };
__device__ __forceinline__ void lru_load_b(bf16x8 (&wb)[32], const bf16* WA, const bf16* WX, int dir, int n, int wave, int lane) {
    const size_t rowo = ((size_t)(dir * 16 + n) * 256 + 32 * wave + (lane & 31)) * 256 + 8 * (lane >> 5);
#pragma unroll
    for (int kk = 0; kk < 16; ++kk) { wb[kk] = *(const GAS bf16x8*)(WA + rowo + 16 * kk); wb[16 + kk] = *(const GAS bf16x8*)(WX + rowo + 16 * kk); }
}
template <bool FINAL>
__device__ __forceinline__ void lru_phase(Frame& F, const LruArgs& A) {
    LAS unsigned char* lds = F.lds;
    LAS float* XCF = (LAS float*)(lds + L_XCF); LAS float* AS = (LAS float*)(lds + L_AS); LAS float* BS = (LAS float*)(lds + L_BS); LAS float* HS = (LAS float*)(lds + L_HS);
    LAS unsigned char* XCB = lds + L_XCB;
    const int tid = F.tid, lane = F.lane, wave = F.wave;
    const int o8 = tid & 31, tt0 = tid >> 5;
    const int NU = NCHUNK * 16;
    for (int u = blockIdx.x; u < NU; u += F.G) {
        const int rest = u >> 3, n = 2 * (u & 7) + (rest >> 10), chunk = rest & 1023;
        const int row0 = chunk * LCH; int s0, s1; seq_bounds(row0, s0, s1);
        const int chb = n * 256;
        {   float w[4][8], bias[8];
#pragma unroll
            for (int k = 0; k < 4; ++k) { const f32x4 a = *(const GAS f32x4*)(A.cw + k * D_RNN + chb + 8 * o8), b = *(const GAS f32x4*)(A.cw + k * D_RNN + chb + 8 * o8 + 4);
                w[k][0] = a.x; w[k][1] = a.y; w[k][2] = a.z; w[k][3] = a.w; w[k][4] = b.x; w[k][5] = b.y; w[k][6] = b.z; w[k][7] = b.w; }
            { const f32x4 a = *(const GAS f32x4*)(A.cb + chb + 8 * o8), b = *(const GAS f32x4*)(A.cb + chb + 8 * o8 + 4);
                bias[0] = a.x; bias[1] = a.y; bias[2] = a.z; bias[3] = a.w; bias[4] = b.x; bias[5] = b.y; bias[6] = b.z; bias[7] = b.w; }
#pragma unroll
            for (int h = 0; h < 2; ++h) {
#ifdef CONV_SWAP
                const int tt = tt0 + 16 * (1 - h), t = row0 + tt;
#else
                const int tt = tt0 + 16 * h, t = row0 + tt;
#endif
                float xc[8];
#pragma unroll
                for (int e = 0; e < 8; ++e) xc[e] = bias[e];
#pragma unroll
                for (int k = 0; k < 4; ++k) { const int r = t + k - 1;
                    if (r >= s0 && r < s1) { const v4u x = *(const GAS v4u*)(A.XR + (size_t)r * D_RNN + chb + 8 * o8);
                        xc[0] += w[k][0] * bf_lo(x.x); xc[1] += w[k][1] * bf_hi(x.x); xc[2] += w[k][2] * bf_lo(x.y); xc[3] += w[k][3] * bf_hi(x.y);
                        xc[4] += w[k][4] * bf_lo(x.z); xc[5] += w[k][5] * bf_hi(x.z); xc[6] += w[k][6] * bf_lo(x.w); xc[7] += w[k][7] * bf_hi(x.w); } }
                *(LAS f32x4*)(XCF + tt * LRU_P + 8 * o8) = (f32x4){xc[0], xc[1], xc[2], xc[3]}; *(LAS f32x4*)(XCF + tt * LRU_P + 8 * o8 + 4) = (f32x4){xc[4], xc[5], xc[6], xc[7]};
                v4u pw; pw.x = pk2(xc[0], xc[1]); pw.y = pk2(xc[2], xc[3]); pw.z = pk2(xc[4], xc[5]); pw.w = pk2(xc[6], xc[7]);
                *(LAS v4u*)(XCB + (tt * LRU_P + 8 * o8) * 2) = pw;
#if DIAG == 2
                if (!FINAL && (n == 0 || n == 5)) { float* dx = A.DBGX + ((size_t)(n == 5) * M + t) * 256 + 8 * o8;
#pragma unroll
                    for (int e = 0; e < 8; ++e) dx[e] = xc[e]; }
#endif
            } }
        __syncthreads();
        float hf[LCH];
#pragma unroll
        for (int dir = 0; dir < 2; ++dir) {
#if LRU_VALU
            {
                const int d = tid & 255, th = tid >> 8, ch = chb + d;
                float za[16], zx[16];
#pragma unroll
                for (int j = 0; j < 16; ++j) { za[j] = 0.f; zx[j] = 0.f; }
                const float* wap = A.WAF + ((size_t)(dir * 16 + n) * 256) * 256 + d; const float* wxp = A.WXF + ((size_t)(dir * 16 + n) * 256) * 256 + d;
                for (int c = 0; c < 256; ++c) { const float w_a = wap[(size_t)c * 256], w_x = wxp[(size_t)c * 256];
#pragma unroll
                    for (int j = 0; j < 16; ++j) { const float x = XCF[(16 * th + j) * LRU_P + c]; za[j] += x * w_a; zx[j] += x * w_x; } }
                const float bav = A.ba[dir * D_RNN + ch], bxv = A.bx[dir * D_RNN + ch];
                const float sp = log1pf(expf(-A.lam[dir * D_RNN + ch])), c8 = -8.0f * sp;
                if (dir == 1) __syncthreads();
#pragma unroll
                for (int j = 0; j < 16; ++j) { const int t = 16 * th + j;
                    const float r = 1.0f / (1.0f + expf(-(za[j] + bav))), ig = 1.0f / (1.0f + expf(-(zx[j] + bxv)));
                    const float la = c8 * r, a = expf(la);
                    AS[t * LRU_P + d] = a; BS[t * LRU_P + d] = sqrtf(-expm1f(2.0f * la)) * ig * XCF[t * LRU_P + d]; }
            }
#else
            f32x16 acca, accx; bf16x8 wb[32]; lru_load_b(wb, A.WA, A.WX, dir, n, wave, lane);
#pragma unroll
            for (int i = 0; i < 16; ++i) { acca[i] = 0.f; accx[i] = 0.f; }
#pragma unroll
            for (int kk = 0; kk < 16; ++kk) { const bf16x8 af = *(const LAS bf16x8*)(XCB + ((lane & 31) * LRU_P + 16 * kk + 8 * (lane >> 5)) * 2);
                acca = __builtin_amdgcn_mfma_f32_32x32x16_bf16(af, wb[kk], acca, 0, 0, 0);
                accx = __builtin_amdgcn_mfma_f32_32x32x16_bf16(af, wb[16 + kk], accx, 0, 0, 0); }
            const int d = 32 * wave + (lane & 31), ch = chb + d;
            const float bav = A.ba[dir * D_RNN + ch], bxv = A.bx[dir * D_RNN + ch];
            const float sp = log1pf(expf(-A.lam[dir * D_RNN + ch])), c8 = -8.0f * sp;
            if (dir == 1) __syncthreads();
#pragma unroll
            for (int i = 0; i < 16; ++i) { const int t = (i & 3) + 8 * (i >> 2) + 4 * (lane >> 5);
                const float r = fsigmoid(acca[i] + bav), ig = fsigmoid(accx[i] + bxv);
                const float la = c8 * r, a = __builtin_amdgcn_exp2f(la * LOG2E), y = 2.0f * la;
                const float ser = -y * (1.0f + y * 0.5f * (1.0f + y * (1.0f / 3.0f) * (1.0f + y * 0.25f * (1.0f + y * 0.2f * (1.0f + y * (1.0f / 6.0f))))));
                const float em = (y > -0.5f) ? ser : (1.0f - a * a);
                AS[t * LRU_P + d] = a; BS[t * LRU_P + d] = sqrtf(em) * ig * XCF[t * LRU_P + d]; }
#endif
            __syncthreads();
            if (tid < 256) { const int dd = tid, cc = chb + dd;
                float h = FINAL ? A.CIN[(size_t)(dir * NCHUNK + chunk) * D_RNN + cc] : 0.f, p = 1.f;
#pragma unroll
                for (int b8 = 0; b8 < LCH / 8; ++b8) { float av[8], bv[8];
#pragma unroll
                    for (int i = 0; i < 8; ++i) { const int t = dir ? LCH - 1 - (8 * b8 + i) : 8 * b8 + i; av[i] = AS[t * LRU_P + dd]; bv[i] = BS[t * LRU_P + dd]; }
#pragma unroll
                    for (int i = 0; i < 8; ++i) { const int t = dir ? LCH - 1 - (8 * b8 + i) : 8 * b8 + i; h = av[i] * h + bv[i];
                        if (!FINAL) p *= av[i];
                        else if (dir == 0) hf[t] = h;
                        else { const size_t go = (size_t)(row0 + t) * D_RNN + cc; const float y = bf_lo((unsigned)A.YR[go]);
                            float rv = (hf[t] + h) * fgelu(y);
#ifdef ZERO_TOK_MASK
                            if ((ZERO_TOK_MASK >> t) & 1u) rv = 0.f;
#endif
                            A.REC[go] = (bf16)f2bf(rv); } } }
                if (!FINAL) *(GAS f32x2*)(A.AGG + ((size_t)(dir * NCHUNK + chunk) * D_RNN + cc) * 2) = (f32x2){p, h}; }
        }
    }
    __syncthreads();
}
__device__ __forceinline__ void lru_carry(Frame& F, const float* AGG, float* CIN) {
    const int gt = (F.vcu * NWAVES + F.wave) * 64 + F.lane, NGT = F.G * NWAVES * 64;
    for (int idx = gt; idx < 2 * 9 * D_RNN; idx += NGT) {
        const int ch = idx & (D_RNN - 1), sq = (idx >> 12) % 9, dir = idx / (9 * D_RNN);
        const int c0 = sq == 0 ? 0 : (SEQ_P / LCH) + (sq - 1) * (SEQ_S / LCH), nc = sq == 0 ? SEQ_P / LCH : SEQ_S / LCH;
        float h = 0.f;
#pragma unroll 8
        for (int i = 0; i < nc; ++i) { const int c = dir ? c0 + nc - 1 - i : c0 + i; const size_t o = (size_t)(dir * NCHUNK + c) * D_RNN + ch;
            const f32x2 ab = *(const GAS f32x2*)(AGG + o * 2); CIN[o] = h; h = ab.x * h + ab.y; }
    }
}

__device__ __forceinline__ void halo_phase(Frame& F, const bf16* HN2, const bf16* WUPT, float* HALO) {
    const int gw = F.vcu * NWAVES + F.wave, NGW = F.G * NWAVES, lane = F.lane;
    for (int it = gw; it < NBOUND * 2 * D_FF; it += NGW) { const int kb = it / (2 * D_FF), j = it - kb * 2 * D_FF; const int r1 = (kb + 1) * MSB, r0 = r1 - 1;
        float s0 = 0.f, s1 = 0.f;
#pragma unroll
        for (int i = 0; i < 8; ++i) { const int k = 8 * lane + 512 * i;
            const v4u w = *(const GAS v4u*)(WUPT + (size_t)j * D + k), a = *(const GAS v4u*)(HN2 + (size_t)r0 * D + k), b = *(const GAS v4u*)(HN2 + (size_t)r1 * D + k);
            s0 += bf_lo(w.x) * bf_lo(a.x) + bf_hi(w.x) * bf_hi(a.x) + bf_lo(w.y) * bf_lo(a.y) + bf_hi(w.y) * bf_hi(a.y) + bf_lo(w.z) * bf_lo(a.z) + bf_hi(w.z) * bf_hi(a.z) + bf_lo(w.w) * bf_lo(a.w) + bf_hi(w.w) * bf_hi(a.w);
            s1 += bf_lo(w.x) * bf_lo(b.x) + bf_hi(w.x) * bf_hi(b.x) + bf_lo(w.y) * bf_lo(b.y) + bf_hi(w.y) * bf_hi(b.y) + bf_lo(w.z) * bf_lo(b.z) + bf_hi(w.z) * bf_hi(b.z) + bf_lo(w.w) * bf_lo(b.w) + bf_hi(w.w) * bf_hi(b.w); }
        s0 = wave_sum(s0); s1 = wave_sum(s1);
        if (lane == 0) { HALO[(size_t)(kb * 2 + 0) * 2 * D_FF + j] = s0; HALO[(size_t)(kb * 2 + 1) * 2 * D_FF + j] = s1; } }
}
__device__ __forceinline__ void unpack_row(const v4u x, float (&o)[8]) { o[0] = bf_lo(x.x); o[1] = bf_hi(x.x); o[2] = bf_lo(x.y); o[3] = bf_hi(x.y); o[4] = bf_lo(x.z); o[5] = bf_hi(x.z); o[6] = bf_lo(x.w); o[7] = bf_hi(x.w); }
__device__ __forceinline__ void load8f(const float* p, float (&o)[8]) { const f32x4 a = *(const GAS f32x4*)p, b = *(const GAS f32x4*)(p + 4); o[0] = a.x; o[1] = a.y; o[2] = a.z; o[3] = a.w; o[4] = b.x; o[5] = b.y; o[6] = b.z; o[7] = b.w; }
__device__ __forceinline__ void ffn_row(const bf16* Y, const float* HALO, int r, int r0, int s0, int s1, int j0, float (&o)[8]) {
    if (r < s0 || r >= s1) {
#pragma unroll
        for (int e = 0; e < 8; ++e) o[e] = 0.f;
    } else if (r < r0) load8f(HALO + (size_t)((r0 / MSB - 1) * 2 + 0) * 2 * D_FF + j0, o);
    else if (r >= r0 + MSB) load8f(HALO + (size_t)(((r0 + MSB) / MSB - 1) * 2 + 1) * 2 * D_FF + j0, o);
    else unpack_row(*(const GAS v4u*)(Y + (size_t)(r - r0) * 2 * D_FF + j0), o);
}
__device__ __forceinline__ void act_phase(Frame& F, const bf16* Y, const float* HALO, const float* cw, const float* cb, bf16* ACT, int r0) {
    const int gt = (F.vcu * NWAVES + F.wave) * 64 + F.lane, NGT = F.G * NWAVES * 64;
    constexpr int NOCT = D_FF / 8, RUN = 32;
    for (int it = gt; it < (MSB / RUN) * NOCT; it += NGT) { const int oc = it % NOCT, run = it / NOCT, j0 = 8 * oc, t0 = r0 + run * RUN;
        int s0, s1; seq_bounds(t0, s0, s1);
        float wv[3][8], wg[3][8], bv[8], bg[8];
#pragma unroll
        for (int k = 0; k < 3; ++k) { load8f(cw + (size_t)k * 2 * D_FF + j0, wv[k]); load8f(cw + (size_t)k * 2 * D_FF + D_FF + j0, wg[k]); }
        load8f(cb + j0, bv); load8f(cb + D_FF + j0, bg);
        float vm[8], v0[8], vp[8], gm[8], g0[8], gp[8];
        ffn_row(Y, HALO, t0 - 1, r0, s0, s1, j0, vm); ffn_row(Y, HALO, t0 - 1, r0, s0, s1, D_FF + j0, gm);
        ffn_row(Y, HALO, t0, r0, s0, s1, j0, v0); ffn_row(Y, HALO, t0, r0, s0, s1, D_FF + j0, g0);
        for (int i = 0; i < RUN; ++i) { const int t = t0 + i;
            ffn_row(Y, HALO, t + 1, r0, s0, s1, j0, vp); ffn_row(Y, HALO, t + 1, r0, s0, s1, D_FF + j0, gp);
            float a[8];
#pragma unroll
            for (int e = 0; e < 8; ++e) { const float uv = bv[e] + wv[0][e] * vm[e] + wv[1][e] * v0[e] + wv[2][e] * vp[e]; const float ug = bg[e] + wg[0][e] * gm[e] + wg[1][e] * g0[e] + wg[2][e] * gp[e];
                a[e] = fgelu(ug) * uv; vm[e] = v0[e]; v0[e] = vp[e]; gm[e] = g0[e]; g0[e] = gp[e]; }
            v4u w; w.x = pk2(a[0], a[1]); w.y = pk2(a[2], a[3]); w.z = pk2(a[4], a[5]); w.w = pk2(a[6], a[7]);
            *(GAS v4u*)(ACT + (size_t)(t - r0) * D_FF + j0) = w; }
    }
}

__device__ __forceinline__ float wave_max(float v) {
#pragma unroll
    for (int o = 1; o < 64; o <<= 1) v = fmaxf(v, __shfl_xor(v, o));
    return v;
}
__device__ __forceinline__ void diag_max(gu32* w, float v) { if (!(v >= 0.f)) v = 1.0e9f; atomicMax((unsigned*)w, __float_as_uint(v)); }
__device__ __forceinline__ void diag_attn(Frame& F, const bf16* Qb, const bf16* Kb, const bf16* Vb, const bf16* Ob, const float* sink, gu32* dw) {
    const int gwv = F.vcu * NWAVES + F.wave, lane = F.lane;
    const int special[16] = {0, 1, 127, 128, 129, 16383, 16384, 16385, 18431, 18432, 32767, 255, 256, 2047, 8191, 8192};
    float dmax = 0.f;
    for (int i = 0; i < 6; ++i) {
        const unsigned k = (unsigned)(gwv + 2048 * i);
        int t = (int)((k * 2654435761u) >> 7) & (M - 1); if (i == 0) { int sp = 0;
#pragma unroll
            for (int q = 0; q < 16; ++q) sp = ((gwv & 15) == q) ? special[q] : sp; t = sp; }
        const int hq = (int)((k >> 4) & 15), hkv = hq >> 2;
        int s0, s1; seq_bounds(t, s0, s1);
        float q[128];
#pragma unroll
        for (int c = 0; c < 16; ++c) { const v4u w = *(const GAS v4u*)(Qb + (size_t)t * ATTN_W + hq * 128 + 8 * c);
            q[8 * c] = bf_lo(w.x); q[8 * c + 1] = bf_hi(w.x); q[8 * c + 2] = bf_lo(w.y); q[8 * c + 3] = bf_hi(w.y); q[8 * c + 4] = bf_lo(w.z); q[8 * c + 5] = bf_hi(w.z); q[8 * c + 6] = bf_lo(w.w); q[8 * c + 7] = bf_hi(w.w); }
        const float slope2 = exp2f(-0.5f * (float)(hq + 1)) * LOG2E, sink2 = sink[hq] * LOG2E;
        float sc[5]; float mx = sink2;
#pragma unroll
        for (int j = 0; j < 5; ++j) { const int s = t - 128 + lane + 64 * j; const bool ok = (s <= t + 128) && (s >= s0) && (s < s1);
            const int sr = s < 0 ? 0 : (s > M - 1 ? M - 1 : s); float d = 0.f;
#pragma unroll
            for (int c = 0; c < 16; ++c) { const v4u w = *(const GAS v4u*)(Kb + (size_t)sr * KV_W + hkv * 128 + 8 * c);
                d += q[8 * c] * bf_lo(w.x) + q[8 * c + 1] * bf_hi(w.x) + q[8 * c + 2] * bf_lo(w.y) + q[8 * c + 3] * bf_hi(w.y) + q[8 * c + 4] * bf_lo(w.z) + q[8 * c + 5] * bf_hi(w.z) + q[8 * c + 6] * bf_lo(w.w) + q[8 * c + 7] * bf_hi(w.w); }
            int dist = t - s; dist = dist < 0 ? -dist : dist;
            sc[j] = ok ? d - slope2 * (float)dist : -1.0e30f; mx = fmaxf(mx, sc[j]); }
        mx = wave_max(mx);
        float l = 0.f;
#pragma unroll
        for (int j = 0; j < 5; ++j) { sc[j] = exp2f(sc[j] - mx); l += sc[j]; }
        l = wave_sum(l) + exp2f(sink2 - mx);
        float o0 = 0.f, o1 = 0.f;
#pragma unroll
        for (int j = 0; j < 5; ++j)
            for (int src = 0; src < 64; ++src) { const float pj = __shfl(sc[j], src); const int s = t - 128 + src + 64 * j;
                if (pj != 0.f && s >= 0 && s < M) { const bf16* vr = Vb + (size_t)s * KV_W + hkv * 128; o0 += pj * __uint_as_float((unsigned)vr[lane] << 16); o1 += pj * __uint_as_float((unsigned)vr[64 + lane] << 16); } }
        o0 /= l; o1 /= l;
        const bf16* orow = Ob + (size_t)t * ATTN_W + hq * 128;
        dmax = fmaxf(dmax, fmaxf(fabsf(o0 - __uint_as_float((unsigned)orow[lane] << 16)), fabsf(o1 - __uint_as_float((unsigned)orow[64 + lane] << 16))));
    }
    dmax = wave_max(dmax);
    if (lane == 0) diag_max(dw, dmax);
}
__device__ __forceinline__ void diag_lru(Frame& F, const bf16* XR, const bf16* YR, const bf16* REC, const float* cw, const float* cb, const float* wa, const float* wx, const float* ba, const float* bx, const float* lam, float* scratch, gu32* dw, const float* AGGp, const float* CINp, gu32* dw2, gu32* dw3, const float* DBG, gu32* dw4, gu32* dw5, const float* DBGX, gu32* dw6) {
    const int NIT = 12; const int item = blockIdx.x; if (item >= NIT) return;
    const int seqs[12] = {0, 0, 0, 0, 1, 3, 8, 5, 0, 2, 7, 4}, ns[12] = {0, 5, 0, 5, 0, 5, 0, 5, 0, 5, 0, 5}, dgs[12] = {0, 2, 3, 1, 1, 0, 3, 2, 1, 0, 2, 3};
    int sq = 0, n = 0, dg = 0;
#pragma unroll
    for (int q = 0; q < 12; ++q) { if (item == q) { sq = seqs[q]; n = ns[q]; dg = dgs[q]; } }
    const int T = sq == 0 ? SEQ_P : SEQ_S, row0 = sq == 0 ? 0 : SEQ_P + (sq - 1) * SEQ_S;
    LAS float* xcs = (LAS float*)F.lds; LAS float* pa = xcs + 256; LAS float* px = pa + 512;
    const int tid = F.tid, d = tid & 63, part = tid >> 6, ch = n * 256 + dg * 64 + d;
    float* hb = scratch + (size_t)item * SEQ_P * 64;
    float dmax = 0.f, dxc = 0.f;
    for (int dir = 1; dir >= 0; --dir) {
        float wra[32], wrx[32];
#pragma unroll
        for (int i = 0; i < 32; ++i) { const size_t o = ((size_t)(dir * 16 + n) * 256 + part * 32 + i) * 256 + dg * 64 + d; wra[i] = wa[o]; wrx[i] = wx[o]; }
        const float bav = ba[dir * D_RNN + ch], bxv = bx[dir * D_RNN + ch], sp = log1pf(expf(-lam[dir * D_RNN + ch]));
        float h = 0.f, hc = 0.f, pc = 1.f, dagg = 0.f, dcin = 0.f, da = 0.f, db = 0.f;
        for (int i = 0; i < T; ++i) { const int tl = dir ? T - 1 - i : i, t = row0 + tl;
            if (tid < 256) { const int c = n * 256 + tid; float xc = cb[c];
#pragma unroll
                for (int k = 0; k < 4; ++k) { const int tt = tl + k - 1; if (tt >= 0 && tt < T) xc += cw[k * D_RNN + c] * __uint_as_float((unsigned)XR[(size_t)(row0 + tt) * D_RNN + c] << 16); }
                xcs[tid] = xc; if (dir == 1) dxc = fmaxf(dxc, fabsf(xc - DBGX[((size_t)(n == 5) * M + t) * 256 + tid])); }
            __syncthreads();
            float sa = 0.f, sx = 0.f;
#pragma unroll
            for (int k = 0; k < 32; ++k) { const float xv = xcs[part * 32 + k]; sa += xv * wra[k]; sx += xv * wrx[k]; }
            pa[part * 64 + d] = sa; px[part * 64 + d] = sx;
            __syncthreads();
            if (tid < 64) { float za = 0.f, zx = 0.f;
#pragma unroll
                for (int p = 0; p < 8; ++p) { za += pa[p * 64 + d]; zx += px[p * 64 + d]; }
                const float r = 1.0f / (1.0f + expf(-(za + bav))), ig = 1.0f / (1.0f + expf(-(zx + bxv)));
                const float la = -8.0f * r * sp, a = expf(la), b = sqrtf(-expm1f(2.0f * la)) * ig * xcs[dg * 64 + d];
                const int chunkg = (row0 + tl) / LCH; const bool cstart = dir ? ((tl & 31) == 31) : ((tl & 31) == 0), cend = dir ? ((tl & 31) == 0) : ((tl & 31) == 31);
                if (cstart) { dcin = fmaxf(dcin, fabsf(h - CINp[(size_t)(dir * NCHUNK + chunkg) * D_RNN + ch])); hc = 0.f; pc = 1.f; }
                h = a * h + b; hc = a * hc + b; pc *= a;
                { const size_t o = (((size_t)(dir * 2 + (n == 5)) * M + t) * 256 + dg * 64 + d) * 2; da = fmaxf(da, fabsf(a - DBG[o])); db = fmaxf(db, fabsf(b - DBG[o + 1])); }
                if (cend) { const size_t o = ((size_t)(dir * NCHUNK + chunkg) * D_RNN + ch) * 2; dagg = fmaxf(dagg, fmaxf(fabsf(pc - AGGp[o]), fabsf(hc - AGGp[o + 1]))); }
                if (dir == 1) hb[(size_t)tl * 64 + d] = h;
                else { const float tot = h + hb[(size_t)tl * 64 + d]; const float y = __uint_as_float((unsigned)YR[(size_t)t * D_RNN + ch] << 16);
                    const float ge = 0.5f * y * (1.0f + tanhf(0.7978845608f * (y + 0.044715f * y * y * y)));
                    dmax = fmaxf(dmax, fabsf(tot * ge - __uint_as_float((unsigned)REC[(size_t)t * D_RNN + ch] << 16))); } }
            __syncthreads();
        }
        if (tid < 64) { dagg = wave_max(dagg); dcin = wave_max(dcin); da = wave_max(da); db = wave_max(db); if (tid == 0) { diag_max(dw2, dagg); diag_max(dw3, dcin); diag_max(dw4, da); diag_max(dw5, db); } }
    }
    dxc = wave_max(dxc); if ((tid & 63) == 0 && tid < 256) diag_max(dw6, dxc);
    if (tid < 64) { dmax = wave_max(dmax); if (tid == 0) { diag_max(dw, dmax); diag_max(dw + 8 + item, dmax); } }
}
__device__ __forceinline__ void diag_z(Frame& F, const float* x_pp, const float* x_sp, const float* g, const float* w, const bf16* Qb, const bf16* Kb, const bf16* Vb, const bf16* XRb, const bf16* YRb, float qscale, gu32* dw) {
    const int gwv = F.vcu * NWAVES + F.wave, lane = F.lane; float dmax = 0.f;
    for (int i = 0; i < 8; ++i) { const unsigned k = (unsigned)(gwv + 2048 * i);
        const int m = (int)((k * 2654435761u) >> 9) & (M - 1); const int n = (int)(((k * 40503u + 977u * i) >> 3) % IN_W);
        const float* xr = m < SEQ_P ? x_pp + (size_t)m * D : x_sp + (size_t)(m - SEQ_P) * D;
        float ss = 0.f, dot = 0.f;
        for (int j = 0; j < 64; ++j) { const int kk = lane + 64 * j; const float xv = xr[kk]; ss += xv * xv; dot += xv * g[kk] * w[(size_t)kk * IN_W + n]; }
        ss = wave_sum(ss); dot = wave_sum(dot);
        float z = dot / sqrtf(ss * (1.f / D) + EPS); unsigned short st;
        if (n < 2048) { st = Qb[(size_t)m * 2048 + n]; z *= qscale; } else if (n < 2560) st = Kb[(size_t)m * 512 + n - 2048]; else if (n < 3072) st = Vb[(size_t)m * 512 + n - 2560];
        else if (n < 7168) st = XRb[(size_t)m * 4096 + n - 3072]; else st = YRb[(size_t)m * 4096 + n - 7168];
        dmax = fmaxf(dmax, fabsf(z - __uint_as_float((unsigned)st << 16))); }
    dmax = wave_max(dmax); if (lane == 0) diag_max(dw, dmax);
}
__device__ __forceinline__ void diag_g(Frame& F, const float* x_pp, const float* x_sp, const float* g, const float* w, int coff, const bf16* Gs, gu32* dwA, gu32* dwB) {
    const int gwv = F.vcu * NWAVES + F.wave, lane = F.lane; float dA = 0.f, dB = 0.f;
    for (int i = 0; i < 8; ++i) { const unsigned k = (unsigned)(gwv + 2048 * i);
        const int m = (int)((k * 2654435761u) >> 9) & (M - 1); const int n = (int)(((k * 40503u + 977u * i) >> 3) % D);
        const float* xr = m < SEQ_P ? x_pp + (size_t)m * D : x_sp + (size_t)(m - SEQ_P) * D;
        float ss = 0.f, dot = 0.f;
        for (int j = 0; j < 64; ++j) { const int kk = lane + 64 * j; const float xv = xr[kk]; ss += xv * xv; dot += xv * g[kk] * w[(size_t)kk * 2 * D + coff + n]; }
        ss = wave_sum(ss); dot = wave_sum(dot);
        const float z = dot / sqrtf(ss * (1.f / D) + EPS), gv = 1.0f / (1.0f + expf(-z));
        const float dd = fabsf(gv - __uint_as_float((unsigned)Gs[(size_t)m * D + n] << 16));
        if (m & 16) dA = fmaxf(dA, dd); else dB = fmaxf(dB, dd); }
    dA = wave_max(dA); dB = wave_max(dB); if (lane == 0) { diag_max(dwA, dA); diag_max(dwB, dB); }
}

constexpr int NPH = 18;
#ifndef DIAG
#define DIAG 0
#endif
#ifndef LRU_VALU
#define LRU_VALU 0
#endif
#ifndef DW_ABS
#define DW_ABS 9
#define DW_RVR 11
#endif
#ifndef NSB_RUN
#define NSB_RUN NSB
#endif
#ifndef MK_PER_PHASE
#define MK_PER_PHASE 0
#endif
struct Args { const float* in[27]; float* out; unsigned char* ws; int ph_lo, ph_hi, li, pad; };
__global__ void __launch_bounds__(NWAVES * 64, 2) mega_fwd(Args args) {
    extern __shared__ __attribute__((aligned(16))) unsigned char lds_raw[];
    Frame F;
    F.lds = (LAS unsigned char*)lds_raw;
    F.MISC = (volatile LAS unsigned*)(F.lds + MISC_OFF);
int wv_ = __builtin_amdgcn_readfirstlane(threadIdx.x >> 6); asm volatile("" : "+s"(wv_));
#define REFRESH() do { int l_; asm volatile("v_mbcnt_lo_u32_b32 %0, -1, 0\n\tv_mbcnt_hi_u32_b32 %0, -1, %0" : "=v"(l_)); F.lane = l_; F.wave = wv_; F.tid = wv_ * 64 + l_; } while (0)
    REFRESH();
    F.G = gridDim.x; { const int bx = blockIdx.x; F.vcu = (F.G % 8 == 0) ? (bx % 8) * (F.G / 8) + bx / 8 : bx; }
    F.ctl = (gu32*)(args.ws + WS_CTL);
    for (int u = threadIdx.x; u < (LDS_BYTES - MISC_OFF) / 4; u += NWAVES * 64) ((LAS unsigned*)(F.lds + MISC_OFF))[u] = 0u;
    __syncthreads();
    XcdBarrier bar = xcd_barrier_post((unsigned*)(F.ctl + CW_BAR) + args.li * XCD_BAR_WORDS, F.MISC + 8);
    const int lo = args.ph_lo, hi = args.ph_hi;
#ifndef PH_MASK
#define PH_MASK 0xFFFFFFFFu
#endif
#define IN(k) (((PH_MASK >> (k)) & 1u) && lo <= (k) && (k) < hi)
#define SEAM(k) do { if (IN(k) && IN((k) + 1)) xcd_barrier(bar, F.tid); } while (0)
#define gw (F.vcu * NWAVES + F.wave)
#define NGW (F.G * NWAVES)
#define gt (gw * 64 + F.lane)
#define NGT (NGW * 64)
#define x_p (args.in[0])
#define x_s (args.in[1])
#define p_p (args.in[2])
#define p_s (args.in[3])
#define g_mix (args.in[4])
#define w_in (args.in[5])
#define rnn_cw (args.in[6])
#define rnn_cb (args.in[7])
#define lru_wa (args.in[8])
#define lru_ba (args.in[9])
#define lru_wx (args.in[10])
#define lru_bx (args.in[11])
#define lru_lam (args.in[12])
#define a_sink (args.in[13])
#define w_oa (args.in[14])
#define w_or (args.in[15])
#define w_mg (args.in[16])
#define w_out (args.in[17])
#define g_ffn (args.in[18])
#define w_up (args.in[19])
#define ffn_cw (args.in[20])
#define ffn_cb (args.in[21])
#define w_dn (args.in[22])
#define w_pg (args.in[23])
#define w_pl (args.in[24])
#define g_ple (args.in[25])
#define g_fin (args.in[26])
#define OUTF (args.out)
#define WSB(off) ((bf16*)(args.ws + (off)))
#define WSF(off) ((float*)(args.ws + (off)))
#define H WSB(WS_H)
#define Qb WSB(WS_Q)
#define Kb WSB(WS_K)
#define Vb WSB(WS_V)
#define REC WSB(WS_REC)
#define Gb WSB(WS_G)
#define MRG WSB(WS_MRG)
#define XR ((bf16*)args.out)
#define YR ((bf16*)args.out + (size_t)M * D_RNN)
#define AGG WSF(WS_AGG)
#define CIN WSF(WS_CIN)
#define WIN WSB(WS_WIN)
#define WG WSB(WS_WG)
#define WOA WSB(WS_WOA)
#define WOR WSB(WS_WOR)
#define WOUT WSB(WS_WOUT)
#define LWA WSB(WS_LWA)
#define LWX WSB(WS_LWX)
#define HN2 WSB(WS_HN2)
#define WUP WSB(WS_WUP)
#define WDN WSB(WS_WDN)
#define WPG WSB(WS_WPG)
#define WPL WSB(WS_WPL)
#define PB WSB(WS_PB)
#define HALO WSF(WS_HALO)
#define SS WSF(WS_SS)
#define RSE WSF(WS_RSE)
#define X2B WSB(WS_X2B)
#define Yb WSB(WS_Y)
#define ACT WSB(WS_ACT)
#define EU WSB(WS_EU)
    typedef pg8::StaticOrder SO;

    if (IN(0)) { REFRESH();
        convert_weight(F, w_in, D, IN_W, 1, WIN); convert_weight(F, w_mg, D, 2 * D, 1, WG); convert_weight(F, w_oa, ATTN_W, D, 1, WOA);
        convert_weight(F, w_or, D_RNN, D, 1, WOR); convert_weight(F, w_out, D, D, 1, WOUT); convert_weight(F, lru_wa, 256, 256, 32, LWA); convert_weight(F, lru_wx, 256, 256, 32, LWX);
        for (int m = gw; m < M; m += NGW) rms_row_to_bf16(m < SEQ_P ? x_p + (size_t)m * D : x_s + (size_t)(m - SEQ_P) * D, g_mix, H + (size_t)m * D, F.lane);
    }
    SEAM(0);
    if (IN(1)) { REFRESH(); pg8::Gemm g{H, WIN, M, IN_W, D}; SO S; S.init(M, IN_W, F.G, (int)blockIdx.x);
        pg8::EpiZ E{Qb, Kb, Vb, XR, YR, 0.08838834764831845f * LOG2E};
        pg8::gemm_phase<pg8::EpiZ, SO, true, true>(F.lds + RING_OFF, g, S, E, F.tid); }
    SEAM(1);

#if DIAG == 3
    if (IN(1)) { REFRESH(); diag_z(F, x_p, x_s, g_mix, w_in, Qb, Kb, Vb, XR, YR, 0.08838834764831845f * LOG2E, F.ctl + 8); xcd_barrier(bar, F.tid); REFRESH();
        const float d1 = __uint_as_float(__hip_atomic_load(F.ctl + 8, RLX_AGENT));
        xcd_barrier(bar, F.tid); REFRESH();
        for (size_t i = (size_t)gt; i < (size_t)M * D / 4; i += NGT) ((GAS f32x4*)OUTF)[i] = (f32x4){0.f, 0.f, 0.f, 0.f};
        xcd_barrier(bar, F.tid); REFRESH();
        if (blockIdx.x == 0 && F.tid == 0) OUTF[0] = 1.0e4f * d1;
        return; }
#endif

#if defined(STOP_AFTER) && STOP_AFTER == 1
    if (IN(1)) { REFRESH(); float* TMP = WSF(WS_G);
        for (size_t i = (size_t)gt; i < (size_t)M * D; i += NGT) { const size_t m = i >> 12; const int j = (int)(i & 4095);
            float v = bf_lo((unsigned)XR[i]) + 2.f * bf_lo((unsigned)YR[i]); if (j < 2048) v += 3.f * bf_lo((unsigned)Qb[m * 2048 + j]); if (j < 512) v += 5.f * bf_lo((unsigned)Kb[m * 512 + j]) + 7.f * bf_lo((unsigned)Vb[m * 512 + j]); TMP[i] = v; }
        xcd_barrier(bar, F.tid); REFRESH();
        for (size_t i = (size_t)gt; i < (size_t)M * D / 4; i += NGT) ((GAS f32x4*)OUTF)[i] = ((const GAS f32x4*)TMP)[i];
        return; }
#endif
#if DIAG == 1
    if (IN(2)) { REFRESH(); for (int u = blockIdx.x; u < (M / 128) * 4; u += F.G) attn_unit(F, Qb, Kb, Vb, REC, a_sink, u >> 2, u & 3);
        xcd_barrier(bar, F.tid); REFRESH(); diag_attn(F, Qb, Kb, Vb, REC, a_sink, F.ctl + 8);
#if DIAG == 1
        xcd_barrier(bar, F.tid); REFRESH();
        { const float d1 = __uint_as_float(__hip_atomic_load(F.ctl + 8, RLX_AGENT));
          for (size_t i = (size_t)gt; i < (size_t)M * D / 4; i += NGT) ((GAS f32x4*)OUTF)[i] = (f32x4){0.f, 0.f, 0.f, 0.f};
          xcd_barrier(bar, F.tid); REFRESH();
          if (blockIdx.x == 0 && F.tid == 0) OUTF[0] = 1.0e6f * d1; }
        return;
#endif
    }
#else
    if (IN(2)) { REFRESH(); for (int u = blockIdx.x; u < (M / 128) * 4; u += F.G) attn_unit(F, Qb, Kb, Vb, Qb, a_sink, u >> 2, u & 3); }
#endif
    SEAM(2);
    if (IN(3)) { REFRESH(); LruArgs LA{XR, YR, rnn_cw, rnn_cb, LWA, LWX, lru_ba, lru_bx, lru_lam, AGG, CIN, REC, WSF(WS_G), lru_wa, lru_wx, WSF(WS_MRG)}; lru_phase<false>(F, LA); }
    SEAM(3);

#if defined(STOP_AFTER) && STOP_AFTER == 3
    if (IN(3)) { REFRESH();
        for (size_t i = (size_t)gt; i < (size_t)M * D / 4; i += NGT) ((GAS f32x4*)OUTF)[i] = i < (size_t)4 * NCHUNK * D_RNN / 4 ? ((const GAS f32x4*)AGG)[i] : (f32x4){0.f, 0.f, 0.f, 0.f};
        return; }
#endif
    if (IN(4)) { REFRESH(); lru_carry(F, AGG, CIN); }
    SEAM(4);
    if (IN(5)) { REFRESH(); LruArgs LA{XR, YR, rnn_cw, rnn_cb, LWA, LWX, lru_ba, lru_bx, lru_lam, AGG, CIN, REC, WSF(WS_G), lru_wa, lru_wx, WSF(WS_MRG)}; lru_phase<true>(F, LA); }
    SEAM(5);

#if defined(STOP_AFTER) && STOP_AFTER == 5
    if (IN(5)) { REFRESH();
        for (size_t i = (size_t)gt; i < (size_t)M * D; i += NGT) OUTF[i] = bf_lo((unsigned)REC[i]);
        return; }
#endif
#if DIAG == 2
    if (IN(5)) { REFRESH(); diag_lru(F, XR, YR, REC, rnn_cw, rnn_cb, lru_wa, lru_wx, lru_ba, lru_bx, lru_lam, AGG, F.ctl + 9, WSF(WS_K), CIN, F.ctl + 10, F.ctl + 11, WSF(WS_G), F.ctl + 12, F.ctl + 13, WSF(WS_MRG), F.ctl + 14); xcd_barrier(bar, F.tid); REFRESH();
        float dm = 0.f; int am = 0;
        for (int q = 0; q < 12; ++q) { const float v = __uint_as_float(__hip_atomic_load(F.ctl + 17 + q, RLX_AGENT)); if (v > dm) { dm = v; } if (v > 0.5f) am += 1; }
#ifdef DIAG_ITEM
        dm = __uint_as_float(__hip_atomic_load(F.ctl + 17 + DIAG_ITEM, RLX_AGENT));
#endif
        const float cfill = sqrtf(100.0f * (float)am);
        for (size_t i = (size_t)gt; i < (size_t)M * D / 4; i += NGT) { const float v = i >= (size_t)SEQ_P * D / 4 ? cfill : 0.f; ((GAS f32x4*)OUTF)[i] = (f32x4){v, v, v, v}; }
        xcd_barrier(bar, F.tid); REFRESH();
        if (blockIdx.x == 0 && F.tid == 0) OUTF[0] = 1.0e2f * dm;
        return; }
#endif
    if (IN(6)) { REFRESH(); pg8::Gemm g{H, WG, M, D, D}; SO S; S.init(M, D, F.G, (int)blockIdx.x); pg8::EpiStore<1> E{Gb, D};
        pg8::gemm_phase<pg8::EpiStore<1>, SO, true, true>(F.lds + RING_OFF, g, S, E, F.tid); }
    SEAM(6);
    if (IN(7)) { REFRESH(); pg8::Gemm g{Qb, WOA, M, D, ATTN_W}; SO S; S.init(M, D, F.G, (int)blockIdx.x); pg8::EpiMulG E{Gb, OUTF};
        pg8::gemm_phase<pg8::EpiMulG, SO, true, true>(F.lds + RING_OFF, g, S, E, F.tid); }
    SEAM(7);
    if (IN(8)) { REFRESH(); pg8::Gemm g{H, WG + (size_t)D * D, M, D, D}; SO S; S.init(M, D, F.G, (int)blockIdx.x); pg8::EpiStore<1> E{Gb, D};
        pg8::gemm_phase<pg8::EpiStore<1>, SO, true, true>(F.lds + RING_OFF, g, S, E, F.tid); }
    SEAM(8);

#if DIAG == 4
    if (IN(8)) { REFRESH(); diag_g(F, x_p, x_s, g_mix, w_mg, D, Gb, F.ctl + 8, F.ctl + 9); xcd_barrier(bar, F.tid); REFRESH();
        const float d1 = __uint_as_float(__hip_atomic_load(F.ctl + 8, RLX_AGENT)), d2 = __uint_as_float(__hip_atomic_load(F.ctl + 9, RLX_AGENT));
        xcd_barrier(bar, F.tid); REFRESH();
        const float cfill = sqrtf(1.0e4f * d2);
        for (size_t i = (size_t)gt; i < (size_t)M * D / 4; i += NGT) { const float v = i >= (size_t)SEQ_P * D / 4 ? cfill : 0.f; ((GAS f32x4*)OUTF)[i] = (f32x4){v, v, v, v}; }
        xcd_barrier(bar, F.tid); REFRESH();
        if (blockIdx.x == 0 && F.tid == 0) OUTF[0] = 1.0e2f * d1;
        return; }
#endif
    if (IN(9)) { REFRESH(); pg8::Gemm g{REC, WOR, M, D, D_RNN}; SO S; S.init(M, D, F.G, (int)blockIdx.x); pg8::EpiMerge E{Gb, OUTF, MRG};
        pg8::gemm_phase<pg8::EpiMerge, SO, true, true>(F.lds + RING_OFF, g, S, E, F.tid); }
    SEAM(9);
    if (IN(10)) { REFRESH(); pg8::Gemm g{MRG, WOUT, M, D, D}; SO S; S.init(M, D, F.G, (int)blockIdx.x); pg8::EpiResid0 E{x_p, x_s, OUTF};
        pg8::gemm_phase<pg8::EpiResid0, SO, true, true>(F.lds + RING_OFF, g, S, E, F.tid); }
    SEAM(10);
    if (IN(11)) { REFRESH();
        convert_weight(F, w_up, D, 2 * D_FF, 1, WUP); convert_weight(F, w_dn, D_FF, D, 1, WDN); convert_weight(F, w_pg, D, D, 1, WPG); convert_weight(F, w_pl, PLE, D, 1, WPL);
        for (int m = gw; m < M; m += NGW) rms_row_to_bf16(OUTF + (size_t)m * D, g_ffn, HN2 + (size_t)m * D, F.lane);
        for (int i = gt; i < M * PLE / 8; i += NGT) { const size_t e = (size_t)i * 8; const float* src = e < (size_t)SEQ_P * PLE ? p_p + e : p_s + (e - (size_t)SEQ_P * PLE);
            const f32x4 a = *(const GAS f32x4*)src, b = *(const GAS f32x4*)(src + 4); v4u w; w.x = pk2(a.x, a.y); w.y = pk2(a.z, a.w); w.z = pk2(b.x, b.y); w.w = pk2(b.z, b.w); *(GAS v4u*)(PB + e) = w; }
    }
    SEAM(11);
    if (IN(12)) { REFRESH(); halo_phase(F, HN2, WUP, HALO); }
    SEAM(12);
    if (IN(13)) { REFRESH();
#pragma unroll
        for (int sb = 0; sb < NSB_RUN; ++sb) { const int r0 = sb * MSB;
            { pg8::Gemm g{HN2 + (size_t)r0 * D, WUP, MSB, 2 * D_FF, D}; SO S; S.init(MSB, 2 * D_FF, F.G, (int)blockIdx.x); pg8::EpiStore<0> E{Yb, 2 * D_FF};
              pg8::gemm_phase<pg8::EpiStore<0>, SO, true, true>(F.lds + RING_OFF, g, S, E, F.tid); }
            xcd_barrier(bar, F.tid); REFRESH();
#ifndef NO_ACT
            act_phase(F, Yb, HALO, ffn_cw, ffn_cb, ACT, r0);
#endif
            xcd_barrier(bar, F.tid); REFRESH();
            { pg8::Gemm g{ACT, WDN, MSB, D, D_FF}; SO S; S.init(MSB, D, F.G, (int)blockIdx.x); pg8::EpiResidAcc E{OUTF + (size_t)r0 * D, X2B + (size_t)r0 * D};
              pg8::gemm_phase<pg8::EpiResidAcc, SO, true, true>(F.lds + RING_OFF, g, S, E, F.tid); }
            if (sb + 1 < NSB) { xcd_barrier(bar, F.tid); REFRESH(); }
        }
    }
    SEAM(13);
    if (IN(14)) { REFRESH(); pg8::Gemm g{PB, WPL, M, D, PLE}; SO S; S.init(M, D, F.G, (int)blockIdx.x); pg8::EpiEU E{EU, SS};
        pg8::gemm_phase<pg8::EpiEU, SO, true, true>(F.lds + RING_OFF, g, S, E, F.tid); }
    SEAM(14);
    if (IN(15)) { REFRESH(); for (int m = gw; m < M; m += NGW) { const float s = wave_sum(SS[(size_t)m * 64 + F.lane]); if (F.lane == 0) RSE[m] = 1.0f / sqrtf(s * (1.f / D) + EPS); } }
    SEAM(15);
    if (IN(16)) { REFRESH(); pg8::Gemm g{X2B, WPG, M, D, D}; SO S; S.init(M, D, F.G, (int)blockIdx.x); pg8::EpiPle E{OUTF, EU, RSE, g_ple, SS};
        pg8::gemm_phase<pg8::EpiPle, SO, true, true>(F.lds + RING_OFF, g, S, E, F.tid); }
    SEAM(16);
    if (IN(17)) { REFRESH();
        for (int m = gw; m < M; m += NGW) { const float s = wave_sum(SS[(size_t)m * 64 + F.lane]); const float rstd = 1.0f / sqrtf(s * (1.f / D) + EPS);
            GAS f32x4* xr = (GAS f32x4*)(OUTF + (size_t)m * D) + F.lane; const GAS f32x4* gr = (const GAS f32x4*)g_fin + F.lane;
#pragma unroll
            for (int j = 0; j < 16; ++j) { const f32x4 v = xr[64 * j], gv = gr[64 * j];
#ifdef SCALE_SAMPLE
                xr[64 * j] = v * (m >= SEQ_P ? 1.2f * rstd : rstd) * gv;
#else
                xr[64 * j] = v * rstd * gv;
#endif
            } }
    }
#undef IN
#undef SEAM
#undef gw
#undef NGW
#undef gt
#undef NGT
#undef H
#undef SS
#undef EU
#undef ACT
#undef PB
}

extern "C" void kernel_launch(void* const* d_in, const int* in_sizes, int n_in, void* d_out, int out_size, void* d_ws, size_t ws_size, hipStream_t stream) {
    static int grid = 0;
    if (grid == 0) {
        if (n_in != 27 || in_sizes[0] != SEQ_P * D || out_size != M * D || ws_size < WS_NEED) { fprintf(stderr, "kernel_launch: unexpected shapes (n_in %d, in0 %d, out %d, ws %zu need %zu); nothing launched\n", n_in, n_in > 0 ? in_sizes[0] : -1, out_size, ws_size, (size_t)WS_NEED); grid = -1; return; }
        int dev = 0, cus = 0, per_cu = 0;
        if (hipGetDevice(&dev) != hipSuccess || hipDeviceGetAttribute(&cus, hipDeviceAttributeMultiprocessorCount, dev) != hipSuccess) { grid = -1; return; }
        if (hipFuncSetAttribute((const void*)mega_fwd, hipFuncAttributeMaxDynamicSharedMemorySize, LDS_BYTES) != hipSuccess) { fprintf(stderr, "kernel_launch: hipFuncSetAttribute failed\n"); grid = -1; return; }
        if (hipOccupancyMaxActiveBlocksPerMultiprocessor(&per_cu, (const void*)mega_fwd, NWAVES * 64, LDS_BYTES) != hipSuccess || per_cu < 1) { fprintf(stderr, "kernel_launch: occupancy query reports %d\n", per_cu); }
        (void)hipGetLastError();
        grid = cus;
    }
    if (grid < 0) return;
    if (hipMemsetAsync((char*)d_ws + WS_CTL, 0, CTL_ZERO_BYTES, stream) != hipSuccess) return;
    Args a{};
    for (int i = 0; i < 27; ++i) a.in[i] = (const float*)d_in[i];
    a.out = (float*)d_out; a.ws = (unsigned char*)d_ws; a.pad = 0;
#if MK_PER_PHASE
    for (int li = 0; li < NPH; ++li) { a.ph_lo = li; a.ph_hi = li + 1; a.li = li; hipLaunchKernelGGL(mega_fwd, dim3(grid), dim3(NWAVES * 64), LDS_BYTES, stream, a); }
#else
    a.ph_lo = 0; a.ph_hi = NPH; a.li = 0;
    hipLaunchKernelGGL(mega_fwd, dim3(grid), dim3(NWAVES * 64), LDS_BYTES, stream, a);
#endif
}
```

```cpp
#include <hip/hip_runtime.h>
#include <cstdio>
#include <cstdint>
namespace pg8 {
#define PG8_LAS __attribute__((address_space(3)))
typedef unsigned short bf16_t;
typedef short bf16x8 __attribute__((ext_vector_type(8)));
typedef float f32x4 __attribute__((ext_vector_type(4)));
typedef unsigned u32x4 __attribute__((ext_vector_type(4)));
constexpr int BM = 256, BK = 64, HALF = 128, HTB = HALF * BK * 2  , STAGE_BYTES = 8 * HTB, NXCD = 8, WGM = 8;

__host__ __device__ __forceinline__ int lds_byte(int r, int c) { const int st = (r >> 4) * 2 + (c >> 5), rr = r & 15, cc = c & 31, ob = rr * 64 + cc * 2; return st * 1024 + (ob ^ (((ob >> 9) & 1) << 5)); }
__host__ __device__ __forceinline__ void stage_rc(int b, int& R, int& C) { const int st = b / 1024, sb = b % 1024, swz = sb ^ (((sb >> 9) & 1) << 5); R = (st >> 1) * 16 + swz / 64; C = (st & 1) * 32 + (swz % 64) / 2; }
__host__ __device__ __forceinline__ int perm32(int rho) { const int n = rho >> 4, i = rho & 15; return 8 * (i >> 2) + 4 * n + (i & 3); }

struct Unit { int pm, pn; };
struct Gemm { const bf16_t* A; const bf16_t* Bt; int M, N, K; };

struct StaticOrder {
    int nM, nN, nwg, G, c;
    __host__ __device__ void init(int M, int N, int G_, int c_) { nM = M / BM; nN = N / BM; nwg = nM * nN; G = G_; c = c_; }
    __host__ __device__ bool next(int i, Unit& u) const {
        const long L = (long)i * G + c; if (L >= nwg) return false;
        int wgid = (int)L; { const int q = nwg / NXCD, r = nwg % NXCD, xcd = wgid % NXCD, off = wgid / NXCD; wgid = (xcd < r ? xcd * (q + 1) : r * (q + 1) + (xcd - r) * q) + off; }
        const int nig = WGM * nN, gid = wgid / nig, fm = gid * WGM, gsz = (nM - fm) < WGM ? (nM - fm) : WGM;
        u.pm = fm + ((wgid % nig) % gsz); u.pn = (wgid % nig) / gsz; return true;
    }
    __device__ __forceinline__ void a_ready(const Unit&) const {}
    __device__ __forceinline__ void done(const Unit&) const {}
};
__device__ __forceinline__ unsigned cvt_pk_bf16(float lo, float hi) { unsigned r; asm volatile("s_nop 2\n\tv_cvt_pk_bf16_f32 %0, %1, %2" : "=v"(r) : "v"(lo), "v"(hi)); return r; }
typedef float f32x2 __attribute__((ext_vector_type(2)));
__device__ __forceinline__ float fsigmoid(float x) { return __builtin_amdgcn_rcpf(1.0f + __builtin_amdgcn_exp2f(-1.4426950408889634f * x)); }
__device__ __forceinline__ float fgelu(float x) { const float p = __builtin_fmaf(x * x, -2.3022081985f * 0.044715f, -2.3022081985f); return x * __builtin_amdgcn_rcpf(1.0f + __builtin_amdgcn_exp2f(p * x)); }
__device__ __forceinline__ float bf_lo(unsigned w) { return __uint_as_float(w << 16); }
__device__ __forceinline__ float bf_hi(unsigned w) { return __uint_as_float(w & 0xffff0000u); }

#define EPI_ROWS(ai, m) (row0 + (ai) * HALF + (m) * 16)
__device__ __forceinline__ u32x4 pack8(const f32x4 v0, const f32x4 v1) { u32x4 w; w.x = cvt_pk_bf16(v0[0], v0[1]); w.y = cvt_pk_bf16(v0[2], v0[3]); w.z = cvt_pk_bf16(v1[0], v1[1]); w.w = cvt_pk_bf16(v1[2], v1[3]); return w; }
__device__ __forceinline__ void unpack8(const u32x4 w, f32x4& v0, f32x4& v1) { v0 = (f32x4){bf_lo(w.x), bf_hi(w.x), bf_lo(w.y), bf_hi(w.y)}; v1 = (f32x4){bf_lo(w.z), bf_hi(w.z), bf_lo(w.w), bf_hi(w.w)}; }

__device__ __forceinline__ f32x4 dpp_rot(const f32x4 v, const bool left) { f32x4 o;
#pragma unroll
    for (int j = 0; j < 4; ++j) { const float s = v[j]; const int x = __float_as_int(s);
        const int y = left ? __builtin_amdgcn_mov_dpp(x, 0x12F, 0xF, 0xF, true) : __builtin_amdgcn_mov_dpp(x, 0x121, 0xF, 0xF, true);
        o[j] = __int_as_float(y); }
    return o; }
struct EpiZc {
    static constexpr bool PERM = true, AFTER_DRAIN = false;
    bf16_t *Q, *K, *V, *XC, *YR, *XB; const float *cw, *cb; float qscale;
    __device__ __forceinline__ void operator()(const f32x4 (&acc)[2][2][4][2], const Unit& u, int wr, int wc, int fr, int fq) const {
        const int pn = u.pn, rbase = u.pm * BM + wr * 64 + 4 * fr;
        if (pn < 12 || pn >= 28) { bf16_t* base; int ldc, colt; float sc = 1.f;
            if (pn < 8) { base = Q; ldc = 2048; colt = pn * 256; sc = qscale; }
            else if (pn < 10) { base = K; ldc = 512; colt = (pn - 8) * 256; }
            else if (pn < 12) { base = V; ldc = 512; colt = (pn - 10) * 256; }
            else { base = YR; ldc = 4096; colt = (pn - 28) * 256; }
            const int col0 = colt + wc * 32 + 8 * fq;
#pragma unroll
            for (int ai = 0; ai < 2; ++ai)
#pragma unroll
                for (int m = 0; m < 4; ++m) { bf16_t* rowp = base + (size_t)(rbase + ai * HALF + m) * ldc + col0;
#pragma unroll
                    for (int bj = 0; bj < 2; ++bj) *(u32x4*)(rowp + bj * HALF) = pack8(acc[ai][bj][m][0] * sc, acc[ai][bj][m][1] * sc); }
        } else {
            const bool f0 = fr == 0, f15 = fr == 15;
#pragma unroll
            for (int bj = 0; bj < 2; ++bj) { const int c0 = (pn - 12) * 256 + wc * 32 + 8 * fq + bj * HALF;
                f32x4 w[4][2], b[2];
#pragma unroll
                for (int k = 0; k < 4; ++k) { w[k][0] = *(const f32x4*)(cw + k * 4096 + c0); w[k][1] = *(const f32x4*)(cw + k * 4096 + c0 + 4); }
                b[0] = *(const f32x4*)(cb + c0); b[1] = *(const f32x4*)(cb + c0 + 4);
#pragma unroll
                for (int ai = 0; ai < 2; ++ai) { const int seg = u.pm * 4 + ai * 2 + wr;
                    if (f0) {
#pragma unroll
                        for (int mm = 0; mm < 3; ++mm) *(u32x4*)(XB + ((size_t)seg * 6 + mm) * 4096 + c0) = pack8(acc[ai][bj][mm][0], acc[ai][bj][mm][1]); }
                    if (f15) {
#pragma unroll
                        for (int mm = 1; mm < 4; ++mm) *(u32x4*)(XB + ((size_t)seg * 6 + 2 + mm) * 4096 + c0) = pack8(acc[ai][bj][mm][0], acc[ai][bj][mm][1]); }
                    f32x4 U3[2], D0[2], D1[2];
#pragma unroll
                    for (int n = 0; n < 2; ++n) { U3[n] = dpp_rot(acc[ai][bj][3][n], false); D0[n] = dpp_rot(acc[ai][bj][0][n], true); D1[n] = dpp_rot(acc[ai][bj][1][n], true); }
#pragma unroll
                    for (int m = 0; m < 4; ++m) { f32x4 o[2];
#pragma unroll
                        for (int n = 0; n < 2; ++n) {
                            const f32x4 xm1 = m == 0 ? U3[n] : acc[ai][bj][m == 0 ? 0 : m - 1][n], x0 = acc[ai][bj][m][n];
                            const f32x4 x1 = m == 3 ? D0[n] : acc[ai][bj][m == 3 ? 3 : m + 1][n], x2 = m == 2 ? D0[n] : (m == 3 ? D1[n] : acc[ai][bj][m >= 2 ? 3 : m + 2][n]);
                            o[n] = b[n] + w[0][n] * xm1 + w[1][n] * x0 + w[2][n] * x1 + w[3][n] * x2; }
                        const bool fix = (m == 0 && f0) || (m >= 2 && f15);
                        if (!fix) *(u32x4*)(XC + (size_t)(rbase + ai * HALF + m) * 4096 + c0) = pack8(o[0], o[1]); } } }
        }
    }
};
struct EpiZ {
    static constexpr bool PERM = true, AFTER_DRAIN = false;
    bf16_t *Q, *K, *V, *XR, *YR; float qscale;
    __device__ __forceinline__ void operator()(const f32x4 (&acc)[2][2][4][2], const Unit& u, int wr, int wc, int fr, int fq) const {
        const int pn = u.pn; bf16_t* base; int ldc, colt; float sc = 1.f;
        if (pn < 8) { base = Q; ldc = 2048; colt = pn * 256; sc = qscale; }
        else if (pn < 10) { base = K; ldc = 512; colt = (pn - 8) * 256; }
        else if (pn < 12) { base = V; ldc = 512; colt = (pn - 10) * 256; }
        else if (pn < 28) { base = XR; ldc = 4096; colt = (pn - 12) * 256; }
        else { base = YR; ldc = 4096; colt = (pn - 28) * 256; }
        const int row0 = u.pm * BM + wr * 64 + fr, col0 = colt + wc * 32 + 8 * fq;
#pragma unroll
        for (int ai = 0; ai < 2; ++ai)
#pragma unroll
            for (int m = 0; m < 4; ++m) { bf16_t* rowp = base + (size_t)EPI_ROWS(ai, m) * ldc + col0;
#pragma unroll
                for (int bj = 0; bj < 2; ++bj) *(u32x4*)(rowp + bj * HALF) = pack8(acc[ai][bj][m][0] * sc, acc[ai][bj][m][1] * sc); }
    }
};
template <int ACT> struct EpiStore {
    static constexpr bool PERM = true, AFTER_DRAIN = false;
    bf16_t* O; int ldc;
    __device__ __forceinline__ void operator()(const f32x4 (&acc)[2][2][4][2], const Unit& u, int wr, int wc, int fr, int fq) const {
        const int row0 = u.pm * BM + wr * 64 + fr, col0 = u.pn * BM + wc * 32 + 8 * fq;
#pragma unroll
        for (int ai = 0; ai < 2; ++ai)
#pragma unroll
            for (int m = 0; m < 4; ++m) { bf16_t* rowp = O + (size_t)EPI_ROWS(ai, m) * ldc + col0;
#pragma unroll
                for (int bj = 0; bj < 2; ++bj) { f32x4 v0 = acc[ai][bj][m][0], v1 = acc[ai][bj][m][1];
                    if (ACT == 1) {
#pragma unroll
                        for (int j = 0; j < 4; ++j) { v0[j] = fsigmoid(v0[j]); v1[j] = fsigmoid(v1[j]); } }
                    *(u32x4*)(rowp + bj * HALF) = pack8(v0, v1); } }
    }
};
struct EpiMulG {
    static constexpr bool PERM = true, AFTER_DRAIN = false;
    const bf16_t* G; bf16_t* MA;
    __device__ __forceinline__ void operator()(const f32x4 (&acc)[2][2][4][2], const Unit& u, int wr, int wc, int fr, int fq) const {
        const int row0 = u.pm * BM + wr * 64 + fr, col0 = u.pn * BM + wc * 32 + 8 * fq;
#pragma unroll
        for (int ai = 0; ai < 2; ++ai)
#pragma unroll
            for (int m = 0; m < 4; ++m) { const size_t off = (size_t)EPI_ROWS(ai, m) * 4096 + col0;
#pragma unroll
                for (int bj = 0; bj < 2; ++bj) { f32x4 g0, g1; unpack8(*(const u32x4*)(G + off + bj * HALF), g0, g1);
                    *(u32x4*)(MA + off + bj * HALF) = pack8(acc[ai][bj][m][0] * g0, acc[ai][bj][m][1] * g1); } }
    }
};
struct EpiMerge {
    static constexpr bool PERM = true, AFTER_DRAIN = false;
    const bf16_t* G; const bf16_t* MA; bf16_t* O;
    __device__ __forceinline__ void operator()(const f32x4 (&acc)[2][2][4][2], const Unit& u, int wr, int wc, int fr, int fq) const {
        const int row0 = u.pm * BM + wr * 64 + fr, col0 = u.pn * BM + wc * 32 + 8 * fq;
#pragma unroll
        for (int ai = 0; ai < 2; ++ai)
#pragma unroll
            for (int m = 0; m < 4; ++m) { const size_t off = (size_t)EPI_ROWS(ai, m) * 4096 + col0;
#pragma unroll
                for (int bj = 0; bj < 2; ++bj) { f32x4 g0, g1; unpack8(*(const u32x4*)(G + off + bj * HALF), g0, g1);
                    f32x4 m0, m1; unpack8(*(const u32x4*)(MA + off + bj * HALF), m0, m1);
                    *(u32x4*)(O + off + bj * HALF) = pack8(acc[ai][bj][m][0] * g0 + m0, acc[ai][bj][m][1] * g1 + m1); } }
    }
};
struct EpiResid0 {
    static constexpr bool PERM = true, AFTER_DRAIN = false;
    const float *xa, *xb; bf16_t* O;
    __device__ __forceinline__ void operator()(const f32x4 (&acc)[2][2][4][2], const Unit& u, int wr, int wc, int fr, int fq) const {
        const int row0 = u.pm * BM + wr * 64 + fr, col0 = u.pn * BM + wc * 32 + 8 * fq;
        const float* X = (u.pm < 64) ? xa : (xb - (size_t)16384 * 4096);
#pragma unroll
        for (int ai = 0; ai < 2; ++ai)
#pragma unroll
            for (int m = 0; m < 4; ++m) { const size_t off = (size_t)EPI_ROWS(ai, m) * 4096 + col0;
#pragma unroll
                for (int bj = 0; bj < 2; ++bj) {
                    const f32x4 x0 = *(const f32x4*)(X + off + bj * HALF), x1 = *(const f32x4*)(X + off + bj * HALF + 4);
                    *(u32x4*)(O + off + bj * HALF) = pack8(x0 + acc[ai][bj][m][0], x1 + acc[ai][bj][m][1]); } }
    }
};
struct EpiResidAcc {
    static constexpr bool PERM = true, AFTER_DRAIN = false;
    const bf16_t* X; bf16_t* XB;
    __device__ __forceinline__ void operator()(const f32x4 (&acc)[2][2][4][2], const Unit& u, int wr, int wc, int fr, int fq) const {
        const int row0 = u.pm * BM + wr * 64 + fr, col0 = u.pn * BM + wc * 32 + 8 * fq;
#pragma unroll
        for (int ai = 0; ai < 2; ++ai)
#pragma unroll
            for (int m = 0; m < 4; ++m) { const size_t off = (size_t)EPI_ROWS(ai, m) * 4096 + col0;
#pragma unroll
                for (int bj = 0; bj < 2; ++bj) {
                    f32x4 x0, x1; unpack8(*(const u32x4*)(X + off + bj * HALF), x0, x1); x0 += acc[ai][bj][m][0]; x1 += acc[ai][bj][m][1];
                    *(u32x4*)(XB + off + bj * HALF) = pack8(x0, x1); } }
    }
};
struct EpiEU {
    static constexpr bool PERM = true, AFTER_DRAIN = false;
    bf16_t* O; float* SS;
    __device__ __forceinline__ void operator()(const f32x4 (&acc)[2][2][4][2], const Unit& u, int wr, int wc, int fr, int fq) const {
        const int row0 = u.pm * BM + wr * 64 + fr, col0 = u.pn * BM + wc * 32 + 8 * fq;
#pragma unroll
        for (int ai = 0; ai < 2; ++ai)
#pragma unroll
            for (int m = 0; m < 4; ++m) { const size_t off = (size_t)EPI_ROWS(ai, m) * 4096 + col0; float s = 0.f;
#pragma unroll
                for (int bj = 0; bj < 2; ++bj) { const f32x4 v0 = acc[ai][bj][m][0], v1 = acc[ai][bj][m][1];
                    s += (v0[0] * v0[0] + v0[1] * v0[1]) + (v0[2] * v0[2] + v0[3] * v0[3]) + (v1[0] * v1[0] + v1[1] * v1[1]) + (v1[2] * v1[2] + v1[3] * v1[3]);
                    *(u32x4*)(O + off + bj * HALF) = pack8(v0, v1); }
                s += __shfl_xor(s, 16); s += __shfl_xor(s, 32);
                if (fq == 0) SS[(size_t)EPI_ROWS(ai, m) * 64 + u.pn * 4 + wc] = s; }
    }
};
struct EpiPle {
    static constexpr bool PERM = true, AFTER_DRAIN = false;
    const bf16_t* X; bf16_t* X3; const bf16_t* EU; const float* rstd; const float* g; float* SS;
    __device__ __forceinline__ void operator()(const f32x4 (&acc)[2][2][4][2], const Unit& u, int wr, int wc, int fr, int fq) const {
        const int row0 = u.pm * BM + wr * 64 + fr, col0 = u.pn * BM + wc * 32 + 8 * fq;
        f32x4 gv[2][2];
#pragma unroll
        for (int bj = 0; bj < 2; ++bj) { gv[bj][0] = *(const f32x4*)(g + col0 + bj * HALF); gv[bj][1] = *(const f32x4*)(g + col0 + bj * HALF + 4); }
#pragma unroll
        for (int ai = 0; ai < 2; ++ai)
#pragma unroll
            for (int m = 0; m < 4; ++m) { const int row = EPI_ROWS(ai, m); const size_t off = (size_t)row * 4096 + col0; const float rs = rstd[row]; float s = 0.f;
#pragma unroll
                for (int bj = 0; bj < 2; ++bj) { f32x4 e0, e1; unpack8(*(const u32x4*)(EU + off + bj * HALF), e0, e1);
                    f32x4 x0, x1; unpack8(*(const u32x4*)(X + off + bj * HALF), x0, x1);
                    const f32x4 a0 = acc[ai][bj][m][0], a1 = acc[ai][bj][m][1];
#pragma unroll
                    for (int j = 0; j < 4; ++j) { x0[j] += fsigmoid(a0[j]) * (e0[j] * rs * gv[bj][0][j]); x1[j] += fsigmoid(a1[j]) * (e1[j] * rs * gv[bj][1][j]); }
                    s += (x0[0] * x0[0] + x0[1] * x0[1]) + (x0[2] * x0[2] + x0[3] * x0[3]) + (x1[0] * x1[0] + x1[1] * x1[1]) + (x1[2] * x1[2] + x1[3] * x1[3]);
                    *(u32x4*)(X3 + off + bj * HALF) = pack8(x0, x1); }
                s += __shfl_xor(s, 16); s += __shfl_xor(s, 32);
                if (fq == 0) SS[(size_t)row * 64 + u.pn * 4 + wc] = s; }
    }
};
struct EpiMerge2 {
    static constexpr bool PERM = true, AFTER_DRAIN = false;
    const bf16_t *TA, *TR; bf16_t* O;
    __device__ __forceinline__ void operator()(const f32x4 (&acc)[2][2][4][2], const Unit& u, int wr, int wc, int fr, int fq) const {
        const int colb = u.pn * 128 + wc * 32 + 8 * fq;
#pragma unroll
        for (int ai = 0; ai < 2; ++ai)
#pragma unroll
            for (int m = 0; m < 4; ++m) { const size_t off = (size_t)(u.pm * BM + ai * HALF + wr * 64 + 16 * m + fr) * 4096 + colb;
                f32x4 a0, a1, r0, r1; unpack8(*(const u32x4*)(TA + off), a0, a1); unpack8(*(const u32x4*)(TR + off), r0, r1);
                const f32x4 ga0 = acc[ai][0][m][0], ga1 = acc[ai][0][m][1], gr0 = acc[ai][1][m][0], gr1 = acc[ai][1][m][1];
                f32x4 o0, o1;
#pragma unroll
                for (int j = 0; j < 4; ++j) { o0[j] = fsigmoid(ga0[j]) * a0[j] + fsigmoid(gr0[j]) * r0[j]; o1[j] = fsigmoid(ga1[j]) * a1[j] + fsigmoid(gr1[j]) * r1[j]; }
                *(u32x4*)(O + off) = pack8(o0, o1); }
    }
};
struct EpiAct {
    static constexpr bool PERM = true, AFTER_DRAIN = false;
    const float *cw, *cb; bf16_t *ACT, *YB;
    static __device__ __forceinline__ f32x4 rot(const f32x4 v, const bool left) { f32x4 o;
#pragma unroll
        for (int j = 0; j < 4; ++j) { const float s = v[j]; const int x = __float_as_int(s);
            const int y = left ? __builtin_amdgcn_mov_dpp(x, 0x12F, 0xF, 0xF, true) : __builtin_amdgcn_mov_dpp(x, 0x121, 0xF, 0xF, true);
            o[j] = __int_as_float(y); }
        return o; }
    __device__ __forceinline__ void operator()(const f32x4 (&acc)[2][2][4][2], const Unit& u, int wr, int wc, int fr, int fq) const {
        constexpr int NF = 24576, DF = 12288;
        const int colb = u.pn * 128 + wc * 32 + 8 * fq;
        const bool f0 = fr == 0, f15 = fr == 15;
#pragma unroll
        for (int ai = 0; ai < 2; ++ai) { const int seg = u.pm * 4 + ai * 2 + wr;
            if (f0) {
#pragma unroll
                for (int mm = 0; mm < 2; ++mm) { bf16_t* yb = YB + ((size_t)seg * 4 + mm) * NF + colb; *(u32x4*)yb = pack8(acc[ai][0][mm][0], acc[ai][0][mm][1]); *(u32x4*)(yb + DF) = pack8(acc[ai][1][mm][0], acc[ai][1][mm][1]); } }
            if (f15) {
#pragma unroll
                for (int mm = 2; mm < 4; ++mm) { bf16_t* yb = YB + ((size_t)seg * 4 + mm) * NF + colb; *(u32x4*)yb = pack8(acc[ai][0][mm][0], acc[ai][0][mm][1]); *(u32x4*)(yb + DF) = pack8(acc[ai][1][mm][0], acc[ai][1][mm][1]); } } }
        unsigned pk0[2][4][2];
#pragma unroll
        for (int n = 0; n < 2; ++n) { const int c0 = colb + 4 * n;
            const f32x4 wv0 = *(const f32x4*)(cw + c0), wv1 = *(const f32x4*)(cw + NF + c0), wv2 = *(const f32x4*)(cw + 2 * NF + c0), bv = *(const f32x4*)(cb + c0);
            const f32x4 wg0 = *(const f32x4*)(cw + DF + c0), wg1 = *(const f32x4*)(cw + NF + DF + c0), wg2 = *(const f32x4*)(cw + 2 * NF + DF + c0), bg = *(const f32x4*)(cb + DF + c0);
#pragma unroll
            for (int ai = 0; ai < 2; ++ai) { const int rowb = u.pm * BM + ai * HALF + wr * 64 + 4 * fr;
                const f32x4 Uv = rot(acc[ai][0][3][n], false), Ug = rot(acc[ai][1][3][n], false);
                const f32x4 Dv = rot(acc[ai][0][0][n], true), Dg = rot(acc[ai][1][0][n], true);
#pragma unroll
                for (int m = 0; m < 4; ++m) { const f32x4 v = acc[ai][0][m][n], g = acc[ai][1][m][n];
                    const f32x4 upv = m == 0 ? Uv : acc[ai][0][m == 0 ? 0 : m - 1][n], upg = m == 0 ? Ug : acc[ai][1][m == 0 ? 0 : m - 1][n];
                    const f32x4 dnv = m == 3 ? Dv : acc[ai][0][m == 3 ? 3 : m + 1][n], dng = m == 3 ? Dg : acc[ai][1][m == 3 ? 3 : m + 1][n];
                    f32x4 a;
#pragma unroll
                    for (int j = 0; j < 4; ++j) {
                        const float uv = bv[j] + wv0[j] * upv[j] + wv1[j] * v[j] + wv2[j] * dnv[j], ug = bg[j] + wg0[j] * upg[j] + wg1[j] * g[j] + wg2[j] * dng[j];
                        a[j] = fgelu(ug) * uv; }
                    const unsigned p0 = cvt_pk_bf16(a[0], a[1]), p1 = cvt_pk_bf16(a[2], a[3]);
                    if (n == 0) { pk0[ai][m][0] = p0; pk0[ai][m][1] = p1; }
                    else { const bool fix = (m == 0 && f0) || (m == 3 && f15);
                        if (!fix) { u32x4 w; w.x = pk0[ai][m][0]; w.y = pk0[ai][m][1]; w.z = p0; w.w = p1; *(u32x4*)(ACT + (size_t)(rowb + m) * DF + colb) = w; } } } } }
    }
};
#undef EPI_ROWS

template <class Epi, class Sched, bool ALIGN_EPI = false, bool SP2 = false, bool APERM = false>
__device__ __forceinline__ void gemm_phase(PG8_LAS unsigned char* lds, const Gemm g, const Sched& S, const Epi& E, const int tid) {
    const int wid = __builtin_amdgcn_readfirstlane(tid >> 6), lane = tid & 63, wr = wid >> 2, wc = wid & 3, fr = lane & 15, fq = lane >> 4;
    const int K = g.K, nt = K / BK;
    unsigned voffA[2], voffB[2];
#pragma unroll
    for (int i = 0; i < 2; ++i) { int R, C; stage_rc(tid * 16 + i * 8192, R, C); const int Rb = Epi::PERM ? ((R & ~31) + perm32(R & 31)) : R;
        const int Ra = APERM ? ((R & ~63) | (4 * (R & 15) + ((R >> 4) & 3))) : R;
        voffA[i] = (unsigned)(Ra * K + C) * 2u; voffB[i] = (unsigned)(Rb * K + C) * 2u; }
    const size_t kstep = (size_t)(BK * 2);
    const size_t hstep = (size_t)HALF * K * 2;
    const size_t tstep = 2 * hstep;
    const unsigned ldsw = (unsigned)wid * 1024u;
    const int aoff = lds_byte(wr * 64 + fr, fq * 8), boff = lds_byte(wc * 32 + fr, fq * 8);
#define PG8_SA(b, h) (((b) * 2 + (h)) * HTB)
#define PG8_SB(b, h) ((4 + (b) * 2 + (h)) * HTB)
#define PG8_STAGE(bufoff, gbase, voff) do { _Pragma("unroll") for (int _i = 0; _i < 2; ++_i) \
        __builtin_amdgcn_global_load_lds((const unsigned*)((const char*)(gbase) + (voff)[_i]), (PG8_LAS unsigned*)(lds + (bufoff) + ldsw + _i * 8192), 16, 0, 0); } while (0)
#define PG8_LDA(dst, b, h) do { _Pragma("unroll") for (int m = 0; m < 4; ++m) _Pragma("unroll") for (int k = 0; k < 2; ++k) dst[m][k] = *(const PG8_LAS bf16x8*)(lds + PG8_SA(b, h) + aoff + m * 2048 + k * 1024); } while (0)
#define PG8_LDB(dst, b, h) do { _Pragma("unroll") for (int n = 0; n < 2; ++n) _Pragma("unroll") for (int k = 0; k < 2; ++k) dst[n][k] = *(const PG8_LAS bf16x8*)(lds + PG8_SB(b, h) + boff + n * 2048 + k * 1024); } while (0)
#define PG8_MMA(ai, bj, At, Bt) do { __builtin_amdgcn_s_setprio(1); _Pragma("unroll") for (int m = 0; m < 4; ++m) _Pragma("unroll") for (int n = 0; n < 2; ++n) _Pragma("unroll") for (int k = 0; k < 2; ++k) \
        acc[ai][bj][m][n] = __builtin_amdgcn_mfma_f32_16x16x32_bf16(Bt[n][k], At[m][k], acc[ai][bj][m][n], 0, 0, 0); __builtin_amdgcn_s_setprio(0); } while (0)
#define PG8_WAIT_V(n) asm volatile("s_waitcnt vmcnt(" #n ")" ::: "memory")
#define PG8_WAIT_L(n) asm volatile("s_waitcnt lgkmcnt(" #n ")" ::: "memory")
#define PG8_BAR __builtin_amdgcn_s_barrier()
#define PG8_SCHED __builtin_amdgcn_sched_barrier(0)
    Unit cur, nxt; int ui = 0;
    if (!S.next(0, cur)) return;
    f32x4 acc[2][2][4][2];
#pragma unroll
    for (int a = 0; a < 2; ++a)
#pragma unroll
        for (int b = 0; b < 2; ++b)
#pragma unroll
            for (int m = 0; m < 4; ++m)
#pragma unroll
                for (int n = 0; n < 2; ++n) acc[a][b][m][n] = (f32x4){0.f, 0.f, 0.f, 0.f};
    bf16x8 At[4][2], B0[2][2], B1[2][2];
    const char* cA = (const char*)g.A + (size_t)cur.pm * tstep; const char* cB = (const char*)g.Bt + (size_t)cur.pn * tstep;
    S.a_ready(cur);
    if constexpr (SP2) {
        PG8_STAGE(PG8_SB(0, 0), cB, voffB); PG8_STAGE(PG8_SB(0, 1), cB + hstep, voffB); PG8_STAGE(PG8_SA(0, 0), cA, voffA); PG8_STAGE(PG8_SA(0, 1), cA + hstep, voffA);
        if (wr == 1) PG8_BAR;
        PG8_WAIT_V(2); PG8_BAR;
        PG8_STAGE(PG8_SB(1, 0), cB + kstep, voffB); PG8_STAGE(PG8_SA(1, 0), cA + kstep, voffA); PG8_STAGE(PG8_SB(1, 1), cB + hstep + kstep, voffB);
        PG8_WAIT_V(6); PG8_BAR;
    } else {
        PG8_STAGE(PG8_SB(0, 0), cB, voffB); PG8_STAGE(PG8_SA(0, 0), cA, voffA); PG8_STAGE(PG8_SB(0, 1), cB + hstep, voffB); PG8_STAGE(PG8_SA(0, 1), cA + hstep, voffA);
        if (wr == 1) PG8_BAR;
        PG8_WAIT_V(4); PG8_BAR;
        PG8_STAGE(PG8_SB(1, 0), cB + kstep, voffB); PG8_STAGE(PG8_SA(1, 0), cA + kstep, voffA); PG8_STAGE(PG8_SB(1, 1), cB + hstep + kstep, voffB);
        PG8_WAIT_V(6); PG8_BAR;
    }
    for (;;) {
        const bool has_next = S.next(ui + 1, nxt);
        const char* nA = has_next ? (const char*)g.A + (size_t)nxt.pm * tstep : cA; const char* nB = has_next ? (const char*)g.Bt + (size_t)nxt.pn * tstep : cB;
        for (int t = 0; t < nt; t += 2) {
            const bool last = (t == nt - 2);
            const char* a1 = cA + (size_t)(t + 1) * kstep;
            const char* a2 = last ? nA : cA + (size_t)(t + 2) * kstep; const char* b2 = last ? nB : cB + (size_t)(t + 2) * kstep;
            const char* a3 = a2 + kstep; const char* b3 = b2 + kstep;
            if (last && has_next) S.a_ready(nxt);
            if constexpr (SP2) {
            PG8_LDB(B0, 0, 0); PG8_LDB(B1, 0, 1); PG8_SCHED; PG8_LDA(At, 0, 0); PG8_STAGE(PG8_SA(1, 1), a1 + hstep, voffA);
            PG8_WAIT_V(8); PG8_WAIT_L(0); PG8_BAR; PG8_MMA(0, 0, At, B0); PG8_MMA(0, 1, At, B1); PG8_BAR; PG8_SCHED;
            PG8_LDA(At, 0, 1); PG8_STAGE(PG8_SB(0, 0), b2, voffB); PG8_STAGE(PG8_SB(0, 1), b2 + hstep, voffB); PG8_STAGE(PG8_SA(0, 0), a2, voffA);
            PG8_WAIT_V(8); PG8_WAIT_L(0); PG8_BAR; PG8_MMA(1, 0, At, B0); PG8_MMA(1, 1, At, B1); PG8_BAR; PG8_SCHED;
            PG8_LDB(B0, 1, 0); PG8_LDB(B1, 1, 1); PG8_SCHED; PG8_LDA(At, 1, 0); PG8_STAGE(PG8_SA(0, 1), a2 + hstep, voffA);
            PG8_WAIT_V(8); PG8_WAIT_L(0); PG8_BAR; PG8_MMA(0, 0, At, B0); PG8_MMA(0, 1, At, B1); PG8_BAR; PG8_SCHED;
            PG8_LDA(At, 1, 1); PG8_STAGE(PG8_SB(1, 0), b3, voffB); PG8_STAGE(PG8_SB(1, 1), b3 + hstep, voffB); PG8_STAGE(PG8_SA(1, 0), a3, voffA);
            PG8_WAIT_V(8); PG8_WAIT_L(0); PG8_BAR; PG8_MMA(1, 0, At, B0); PG8_MMA(1, 1, At, B1); PG8_BAR; PG8_SCHED;
            } else {
            PG8_LDB(B0, 0, 0); PG8_SCHED; PG8_LDA(At, 0, 0); PG8_STAGE(PG8_SA(1, 1), a1 + hstep, voffA);
            PG8_WAIT_L(8); PG8_BAR; PG8_WAIT_L(0); PG8_MMA(0, 0, At, B0); PG8_BAR; PG8_SCHED;
            PG8_LDB(B1, 0, 1); PG8_STAGE(PG8_SB(0, 0), b2, voffB);
            PG8_BAR; PG8_WAIT_L(0); PG8_MMA(0, 1, At, B1); PG8_BAR;
            PG8_LDA(At, 0, 1); PG8_STAGE(PG8_SA(0, 0), a2, voffA);
            PG8_BAR; PG8_WAIT_L(0); PG8_MMA(1, 0, At, B0); PG8_BAR; PG8_SCHED;
            PG8_STAGE(PG8_SB(0, 1), b2 + hstep, voffB);
            PG8_WAIT_V(6); PG8_BAR; PG8_MMA(1, 1, At, B1); PG8_BAR;
            PG8_LDB(B0, 1, 0); PG8_SCHED; PG8_LDA(At, 1, 0); PG8_STAGE(PG8_SA(0, 1), a2 + hstep, voffA);
            PG8_WAIT_L(8); PG8_BAR; PG8_WAIT_L(0); PG8_MMA(0, 0, At, B0); PG8_BAR; PG8_SCHED;
            PG8_LDB(B1, 1, 1); PG8_STAGE(PG8_SB(1, 0), b3, voffB);
            PG8_BAR; PG8_WAIT_L(0); PG8_MMA(0, 1, At, B1); PG8_BAR;
            PG8_LDA(At, 1, 1); PG8_STAGE(PG8_SA(1, 0), a3, voffA);
            PG8_BAR; PG8_WAIT_L(0); PG8_MMA(1, 0, At, B0); PG8_BAR; PG8_SCHED;
            PG8_STAGE(PG8_SB(1, 1), b3 + hstep, voffB);
            PG8_WAIT_V(6); PG8_BAR; PG8_MMA(1, 1, At, B1); PG8_BAR;
            }
        }
        if constexpr (ALIGN_EPI) { if (wr == 0) PG8_BAR; }
        if constexpr (!Epi::AFTER_DRAIN) { E(acc, cur, wr, wc, fr, fq); S.done(cur); }
        if (!has_next) break;
#pragma unroll
        for (int a = 0; a < 2; ++a)
#pragma unroll
            for (int b = 0; b < 2; ++b)
#pragma unroll
                for (int m = 0; m < 4; ++m)
#pragma unroll
                    for (int n = 0; n < 2; ++n) acc[a][b][m][n] = (f32x4){0.f, 0.f, 0.f, 0.f};
        cur = nxt; cA = nA; cB = nB; ++ui;
        if constexpr (ALIGN_EPI) { if (wr == 1) PG8_BAR; }
    }
    PG8_WAIT_V(0);
    if constexpr (!ALIGN_EPI) { if (wr == 0) PG8_BAR; }
    PG8_BAR;
    if constexpr (Epi::AFTER_DRAIN) { E.fused(acc, cur, wr, wc, fr, fq, lds, wid, lane); S.done(cur); }
#undef PG8_SA
#undef PG8_SB
#undef PG8_STAGE
#undef PG8_LDA
#undef PG8_LDB
#undef PG8_MMA
#undef PG8_WAIT_V
#undef PG8_WAIT_L
#undef PG8_BAR
#undef PG8_SCHED
}
}

constexpr int NWAVES = 8;
constexpr int D = 4096, M = 32768, SEQ_P = 16384, SEQ_S = 2048;
constexpr int ATTN_W = 2048, KV_W = 512, D_RNN = 4096, D_FF = 12288, PLE = 256, IN_W = 11264;
constexpr int MSB = 8192, NSB = M / MSB;
constexpr int NBOUND = SEQ_P / MSB - 1;
constexpr int LCH = 32, NCHUNK = M / LCH;
constexpr float EPS = 1e-6f;
constexpr float LOG2E = 1.4426950408889634f;

constexpr size_t MiB = 1u << 20;
constexpr size_t WS_CTL = 0, CTL_ZERO_BYTES = 1 * MiB;
constexpr size_t WS_H = 1 * MiB;
constexpr size_t WS_Q = WS_H + 256 * MiB;
constexpr size_t WS_K = WS_Q + 128 * MiB;
constexpr size_t WS_V = WS_K + 32 * MiB;
constexpr size_t WS_REC = WS_V + 32 * MiB;
constexpr size_t WS_G = WS_REC + 256 * MiB;
constexpr size_t WS_MRG = WS_G + 256 * MiB;
constexpr size_t WS_AGG = WS_MRG + 256 * MiB;
constexpr size_t WS_CIN = WS_AGG + 64 * MiB;
constexpr size_t WS_W1 = WS_CIN + 32 * MiB;
constexpr size_t WS_WIN = WS_W1;
constexpr size_t WS_WG = WS_WIN + 88 * MiB;
constexpr size_t WS_WOA = WS_WG + 64 * MiB;
constexpr size_t WS_WOR = WS_WOA + 16 * MiB;
constexpr size_t WS_WOUT = WS_WOR + 32 * MiB;
constexpr size_t WS_LWA = WS_WOUT + 32 * MiB;
constexpr size_t WS_LWX = WS_LWA + 4 * MiB;
constexpr size_t WS_END1 = WS_LWX + 4 * MiB;
constexpr size_t WS_HN2 = 1 * MiB;
constexpr size_t WS_X2B = WS_HN2;
constexpr size_t WS_WUP = WS_HN2 + 256 * MiB;
constexpr size_t WS_WDN = WS_WUP + 192 * MiB;
constexpr size_t WS_WPG = WS_WDN + 96 * MiB;
constexpr size_t WS_WPL = WS_WPG + 32 * MiB;
constexpr size_t WS_PB = WS_WPL + 2 * MiB;
constexpr size_t WS_SS = WS_PB + 16 * MiB;
constexpr size_t WS_RSE = WS_SS + 8 * MiB;
constexpr size_t WS_YB = WS_RSE + 1 * MiB;
constexpr size_t WS_ACT = WS_YB + 96 * MiB;
constexpr size_t WS_END2 = WS_ACT + 768 * MiB;
constexpr size_t WS_EU = WS_ACT;
constexpr size_t WS_X3B = WS_ACT + 256 * MiB;
constexpr size_t WS_NEED = (WS_END1 > WS_END2 ? WS_END1 : WS_END2);
static_assert(WS_NEED <= (size_t)1664 * MiB, "d_ws map exceeds the guaranteed workspace");
constexpr int CW_BAR = 4096;

constexpr int RING_OFF = 0;
#ifndef LRU_PITCH
#define LRU_PITCH 264
#endif
constexpr int LRU_P = LRU_PITCH;
constexpr int L_XCF = 0, L_AS = L_XCF + LCH * LRU_P * 4, L_BS = L_AS + LCH * LRU_P * 4, L_HS = L_BS + LCH * LRU_P * 4, L_XCB = L_HS + LCH * LRU_P * 4, L_END = L_XCB + LCH * LRU_P * 2;
constexpr int VT_PITCH = 816;
constexpr int MISC_OFF = 153600, L_KC = MISC_OFF + 512, LDS_BYTES = L_KC + 6 * 256 * 4;
static_assert(L_END <= MISC_OFF && 128 * VT_PITCH <= MISC_OFF && 131072 <= MISC_OFF, "LDS map");

#define GAS __attribute__((address_space(1)))
#define LAS __attribute__((address_space(3)))
typedef unsigned short bf16;
typedef unsigned v4u __attribute__((ext_vector_type(4)));
typedef unsigned v2u __attribute__((ext_vector_type(2)));
typedef float f32x4 __attribute__((ext_vector_type(4)));
typedef float f32x16 __attribute__((ext_vector_type(16)));
typedef float f32x2 __attribute__((ext_vector_type(2)));
typedef short bf16x8 __attribute__((ext_vector_type(8)));
typedef GAS unsigned gu32;
#define RLX_AGENT __ATOMIC_RELAXED, __HIP_MEMORY_SCOPE_AGENT
#define LDS_WAIT() asm volatile("s_waitcnt lgkmcnt(0)" ::: "memory")
#define VM_WAIT() asm volatile("s_waitcnt vmcnt(0)" ::: "memory")
__device__ __forceinline__ unsigned f2bf(float f) { unsigned u = __builtin_bit_cast(unsigned, f); return (u + 0x7fffu + ((u >> 16) & 1u)) >> 16; }
__device__ __forceinline__ unsigned pk2(float lo, float hi) { return f2bf(lo) | (f2bf(hi) << 16); }
using pg8::fsigmoid; using pg8::fgelu; using pg8::bf_lo; using pg8::bf_hi;

#define XB_TMO      128
#define XB_XCNT(j)  (256  + 64 * (j))
#define XB_XSUB(j)  (1280 + 64 * (j))
#define XB_XGEN(j)  (2304 + 64 * (j))
#define XB_TOP      3328
#define XB_TOPGEN   3392
#define XCD_BAR_WORDS 3456
#define XB_SPIN_CAP (1u << 18)

__device__ __forceinline__ unsigned xb_ld(unsigned* p)              { return __hip_atomic_load(p, __ATOMIC_RELAXED, __HIP_MEMORY_SCOPE_AGENT); }
__device__ __forceinline__ unsigned xb_add(unsigned* p, unsigned v) { return __hip_atomic_fetch_add(p, v, __ATOMIC_RELAXED, __HIP_MEMORY_SCOPE_AGENT); }
__device__ __forceinline__ unsigned xb_xcc_id() { return (unsigned)__builtin_amdgcn_s_getreg((3 << 11) | 20) & 0xFu; }
#define XB_SPIN(cond, bar) do { unsigned _sp = 0; while (cond) { __builtin_amdgcn_s_sleep(1); \
    if ((++_sp & 255u) == 0u) { if (xb_ld(&(bar)[XB_TMO])) break; if (_sp > XB_SPIN_CAP) { atomicAdd(&(bar)[XB_TMO], 1u); break; } } } } while (0)

struct XcdBarrier {
    unsigned* bar; unsigned x;
    volatile LAS unsigned* st;
};

__device__ __forceinline__ XcdBarrier xcd_barrier_post(unsigned* bar, volatile LAS unsigned* st) {
    XcdBarrier b; b.bar = bar; b.x = xb_xcc_id(); b.st = st;
    if (threadIdx.x == 0) (void)xb_add(&bar[XB_XCNT(b.x)], 1u);
    return b;
}
__device__ __forceinline__ void xcd_barrier_complete(unsigned* bar, unsigned x, unsigned& nloc, unsigned& nx) {
    const unsigned G = gridDim.x * gridDim.y * gridDim.z;
    unsigned sum, cnt, mine, sp = 0u;
    for (;;) {
        sum = 0u; cnt = 0u; mine = 0u;
#pragma unroll
        for (unsigned j = 0; j < 16; ++j) { const unsigned c = xb_ld(&bar[XB_XCNT(j)]); sum += c; cnt += (c > 0u) ? 1u : 0u; mine = (j == x) ? c : mine; }
        if (sum == G) break;
        __builtin_amdgcn_s_sleep(1);
        if ((++sp & 255u) == 0u) { if (xb_ld(&bar[XB_TMO])) break; if (sp > XB_SPIN_CAP) { atomicAdd(&bar[XB_TMO], 1u); break; } }
    }
    nloc = mine > 0u ? mine : 1u; nx = cnt > 0u ? cnt : 1u;
}

__device__ __forceinline__ void xcd_barrier(const XcdBarrier& b, const int tid) {
    asm volatile("s_waitcnt vmcnt(0)" ::: "memory");
    __syncthreads();
    if (tid == 0) {
        unsigned* bar = b.bar;
        __builtin_amdgcn_s_waitcnt(0);
        unsigned nloc = b.st[0], nx = b.st[1];
        if (nloc == 0u) { xcd_barrier_complete(bar, b.x, nloc, nx); b.st[0] = nloc; b.st[1] = nx; }
        const unsigned old = xb_add(&bar[XB_XSUB(b.x)], 1u);
        const unsigned gen = old / nloc;
        if (old + 1u == (gen + 1u) * nloc) {
            __builtin_amdgcn_fence(__ATOMIC_RELEASE, "agent");
            asm volatile("s_waitcnt vmcnt(0)" ::: "memory");
            const unsigned og = xb_add(&bar[XB_TOP], 1u);
            const unsigned tg = og / nx;
            if (og + 1u == (tg + 1u) * nx) xb_add(&bar[XB_TOPGEN], 1u);
            else XB_SPIN(xb_ld(&bar[XB_TOPGEN]) == tg, bar);
            __builtin_amdgcn_fence(__ATOMIC_ACQUIRE, "agent");
            xb_add(&bar[XB_XGEN(b.x)], 1u);
            asm volatile("s_waitcnt vmcnt(0)" ::: "memory");
        } else {
            XB_SPIN(xb_ld(&bar[XB_XGEN(b.x)]) == gen, bar);
            __builtin_amdgcn_fence(__ATOMIC_ACQUIRE, "agent");
            asm volatile("s_waitcnt vmcnt(0)" ::: "memory");
        }
    }
    __syncthreads();
}

struct Frame {
    LAS unsigned char* lds;
    volatile LAS unsigned* MISC;
    gu32* ctl;
    int tid, lane, wave;
    int vcu, G;
};
__device__ __forceinline__ float wave_sum(float v) {
#pragma unroll
    for (int o = 1; o < 64; o <<= 1) v += __shfl_xor(v, o);
    return v;
}
__device__ __forceinline__ void seq_bounds(int row, int& s0, int& s1) { if (row < SEQ_P) { s0 = 0; s1 = SEQ_P; } else { s0 = row & ~(SEQ_S - 1); s1 = s0 + SEQ_S; } }

__device__ __forceinline__ void tr_load(const float* src, int N, int lane, float (&v)[32]) {
#pragma unroll
    for (int i = 0; i < 32; ++i) v[i] = src[(size_t)(2 * i + (lane >> 5)) * N + (lane & 31)];
}
__device__ __forceinline__ void tr_store(const float (&v)[32], bf16* dst, int K, LAS float* scr, int lane) {
#pragma unroll
    for (int i = 0; i < 32; ++i) scr[(2 * i + (lane >> 5)) * 33 + (lane & 31)] = v[i];
    LDS_WAIT(); asm volatile("" ::: "memory");
    const int c = lane & 7;
#pragma unroll
    for (int j = 0; j < 4; ++j) { const int n = (lane >> 3) + 8 * j; const LAS float* s = scr + (8 * c) * 33 + n;
        v4u o; o.x = pk2(s[0 * 33], s[1 * 33]); o.y = pk2(s[2 * 33], s[3 * 33]); o.z = pk2(s[4 * 33], s[5 * 33]); o.w = pk2(s[6 * 33], s[7 * 33]);
        *(GAS v4u*)(dst + (size_t)n * K + 8 * c) = o; }
    LDS_WAIT(); asm volatile("" ::: "memory");
}
__device__ __forceinline__ void convert_weight(Frame& F, const float* W, int K, int N, int nmat, bf16* WT) {
    LAS float* scr = (LAS float*)(F.lds + RING_OFF + F.wave * 16384);
    const int gw = F.vcu * NWAVES + F.wave, NGW = F.G * NWAVES, lane = F.lane;
    const int nblk = N / 32, per = (K / 64) * nblk, total = per * nmat;
#define CW_SRC(it) (W + (size_t)((it) / per) * K * N + (size_t)(64 * (((it) % per) / nblk)) * N + 32 * (((it) % per) % nblk))
#define CW_DST(it) (WT + (size_t)((it) / per) * K * N + (size_t)(32 * (((it) % per) % nblk)) * K + 64 * (((it) % per) / nblk))
    float cur[32], nxt[32];
    int it = gw; if (it < total) tr_load(CW_SRC(it), N, lane, cur);
    for (; it < total; it += NGW) { const int nit = it + NGW;
        if (nit < total) tr_load(CW_SRC(nit), N, lane, nxt);
        tr_store(cur, CW_DST(it), K, scr, lane);
#pragma unroll
        for (int i = 0; i < 32; ++i) cur[i] = nxt[i]; }
#undef CW_SRC
#undef CW_DST
}
__device__ __forceinline__ void rms_brow_to_bf16(const bf16* xrow, const float* g, bf16* orow, int lane) {
    const GAS v4u* xr = (const GAS v4u*)xrow + lane;
    v4u v[8]; float s = 0.f;
#pragma unroll
    for (int j = 0; j < 8; ++j) { v[j] = xr[64 * j];
        const float a0 = bf_lo(v[j].x), a1 = bf_hi(v[j].x), a2 = bf_lo(v[j].y), a3 = bf_hi(v[j].y), a4 = bf_lo(v[j].z), a5 = bf_hi(v[j].z), a6 = bf_lo(v[j].w), a7 = bf_hi(v[j].w);
        s += ((a0 * a0 + a1 * a1) + (a2 * a2 + a3 * a3)) + ((a4 * a4 + a5 * a5) + (a6 * a6 + a7 * a7)); }
    const float rstd = 1.0f / sqrtf(wave_sum(s) * (1.f / D) + EPS);
    const GAS f32x4* gr = (const GAS f32x4*)g + 2 * lane;
    GAS v4u* o8 = (GAS v4u*)orow + lane;
#pragma unroll
    for (int j = 0; j < 8; ++j) { const f32x4 g0 = gr[128 * j], g1 = gr[128 * j + 1]; v4u w;
        w.x = pk2(bf_lo(v[j].x) * rstd * g0.x, bf_hi(v[j].x) * rstd * g0.y); w.y = pk2(bf_lo(v[j].y) * rstd * g0.z, bf_hi(v[j].y) * rstd * g0.w);
        w.z = pk2(bf_lo(v[j].z) * rstd * g1.x, bf_hi(v[j].z) * rstd * g1.y); w.w = pk2(bf_lo(v[j].w) * rstd * g1.z, bf_hi(v[j].w) * rstd * g1.w); o8[64 * j] = w; }
}
__device__ __forceinline__ void rms_row_to_bf16(const float* xrow, const float* g, bf16* orow, int lane) {
    const GAS f32x4* xr = (const GAS f32x4*)xrow + lane;
    f32x4 v[16]; float s = 0.f;
#pragma unroll
    for (int j = 0; j < 16; ++j) { v[j] = xr[64 * j]; s += (v[j].x * v[j].x + v[j].y * v[j].y) + (v[j].z * v[j].z + v[j].w * v[j].w); }
    const float rstd = 1.0f / sqrtf(wave_sum(s) * (1.f / D) + EPS);
    const GAS f32x4* gr = (const GAS f32x4*)g + lane;
    GAS v2u* o8 = (GAS v2u*)orow + lane;
#pragma unroll
    for (int j = 0; j < 16; ++j) { const f32x4 gv = gr[64 * j]; v2u w; w.x = pk2(v[j].x * rstd * gv.x, v[j].y * rstd * gv.y); w.y = pk2(v[j].z * rstd * gv.z, v[j].w * rstd * gv.w); o8[64 * j] = w; }
}

__device__ __forceinline__ void attn_unit(Frame& F, const bf16* Qb, const bf16* Kb, const bf16* Vb, bf16* Ob, const float* sink, int qblk, int hkv) {
    LAS unsigned char* lds = F.lds;
    const int lane = F.lane, wave = F.wave;
    const int row_blk = qblk * 128; int s0, s1; seq_bounds(row_blk, s0, s1);
    const int kbase = row_blk - 128;
    __syncthreads();
#pragma unroll
    for (int oo = 0; oo < 2; ++oo) { const int o = 2 * wave + oo;
#pragma unroll
        for (int j = 0; j < 4; ++j) { const int kp = lane + 64 * j;
            if (kp < 200) { const int r0 = kbase + 2 * kp;
                v4u a = (v4u){0u, 0u, 0u, 0u}, b = a;
                if (r0 >= s0 && r0 < s1) { a = *(const GAS v4u*)(Vb + (size_t)r0 * KV_W + hkv * 128 + 8 * o); b = *(const GAS v4u*)(Vb + (size_t)(r0 + 1) * KV_W + hkv * 128 + 8 * o); }
                LAS unsigned char* dst = lds + (8 * o) * VT_PITCH + 4 * kp;
                *(LAS unsigned*)(dst + 0 * VT_PITCH) = (a.x & 0xffffu) | (b.x << 16);
                *(LAS unsigned*)(dst + 1 * VT_PITCH) = (a.x >> 16) | (b.x & 0xffff0000u);
                *(LAS unsigned*)(dst + 2 * VT_PITCH) = (a.y & 0xffffu) | (b.y << 16);
                *(LAS unsigned*)(dst + 3 * VT_PITCH) = (a.y >> 16) | (b.y & 0xffff0000u);
                *(LAS unsigned*)(dst + 4 * VT_PITCH) = (a.z & 0xffffu) | (b.z << 16);
                *(LAS unsigned*)(dst + 5 * VT_PITCH) = (a.z >> 16) | (b.z & 0xffff0000u);
                *(LAS unsigned*)(dst + 6 * VT_PITCH) = (a.w & 0xffffu) | (b.w << 16);
                *(LAS unsigned*)(dst + 7 * VT_PITCH) = (a.w >> 16) | (b.w & 0xffff0000u);
            } } }
    __syncthreads();
    const int qn = lane & 15, quad = lane >> 4;
    const int r0q = row_blk + 16 * wave, ks = r0q - 128, tq = r0q + qn;
    for (int g = 0; g < 4; ++g) {
        const int hq = hkv * 4 + g;
        bf16x8 qf[4];
#pragma unroll
        for (int kk = 0; kk < 4; ++kk) qf[kk] = *(const GAS bf16x8*)(Qb + (size_t)tq * ATTN_W + hq * 128 + 32 * kk + 8 * quad);
        f32x4 s[18];
#pragma unroll
        for (int t = 0; t < 18; ++t) { int krow = ks + 16 * t + qn; krow = krow < 0 ? 0 : (krow > M - 1 ? M - 1 : krow);
            const bf16* kp = Kb + (size_t)krow * KV_W + hkv * 128 + 8 * quad;
            f32x4 acc = (f32x4){0.f, 0.f, 0.f, 0.f};
#pragma unroll
            for (int kk = 0; kk < 4; ++kk) acc = __builtin_amdgcn_mfma_f32_16x16x32_bf16(*(const GAS bf16x8*)(kp + 32 * kk), qf[kk], acc, 0, 0, 0);
            s[t] = acc; }
        const float slope2 = exp2f(-0.5f * (float)(hq + 1)) * LOG2E, sink2 = sink[hq] * LOG2E;
        float mx = -3.0e38f;
#pragma unroll
        for (int t = 0; t < 18; ++t)
#pragma unroll
            for (int r = 0; r < 4; ++r) { const int tk = ks + 16 * t + 4 * quad + r; int dist = tq - tk; dist = dist < 0 ? -dist : dist;
                const bool ok = (dist <= 128) && (tk >= s0) && (tk < s1);
                const float v = ok ? s[t][r] - slope2 * (float)dist : -1.0e30f; s[t][r] = v; mx = fmaxf(mx, v); }
        mx = fmaxf(mx, __shfl_xor(mx, 16)); mx = fmaxf(mx, __shfl_xor(mx, 32)); mx = fmaxf(mx, sink2);
        float l = 0.f;
#pragma unroll
        for (int t = 0; t < 18; ++t)
#pragma unroll
            for (int r = 0; r < 4; ++r) { const float p = __builtin_amdgcn_exp2f(s[t][r] - mx); s[t][r] = p; l += p; }
        l += __shfl_xor(l, 16); l += __shfl_xor(l, 32); l += __builtin_amdgcn_exp2f(sink2 - mx);
        const float inv = 1.0f / l;
        f32x4 o[8];
#pragma unroll
        for (int dt = 0; dt < 8; ++dt) o[dt] = (f32x4){0.f, 0.f, 0.f, 0.f};
#pragma unroll
        for (int j = 0; j < 9; ++j) {
            v4u pw; pw.x = pg8::cvt_pk_bf16(s[2 * j][0], s[2 * j][1]); pw.y = pg8::cvt_pk_bf16(s[2 * j][2], s[2 * j][3]); pw.z = pg8::cvt_pk_bf16(s[2 * j + 1][0], s[2 * j + 1][1]); pw.w = pg8::cvt_pk_bf16(s[2 * j + 1][2], s[2 * j + 1][3]);
            const bf16x8 pb = __builtin_bit_cast(bf16x8, pw);
#pragma unroll
            for (int dt = 0; dt < 8; ++dt) {
                const LAS unsigned char* vp = lds + (16 * dt + qn) * VT_PITCH + 2 * (16 * wave + 32 * j + 4 * quad);
                const v2u v0 = *(const LAS v2u*)vp, v1 = *(const LAS v2u*)(vp + 32);
                v4u vw; vw.x = v0.x; vw.y = v0.y; vw.z = v1.x; vw.w = v1.y;
                o[dt] = __builtin_amdgcn_mfma_f32_16x16x32_bf16(__builtin_bit_cast(bf16x8, vw), pb, o[dt], 0, 0, 0); } }
#pragma unroll
        for (int dt = 0; dt < 8; ++dt) { v2u w; w.x = pg8::cvt_pk_bf16(o[dt][0] * inv, o[dt][1] * inv); w.y = pg8::cvt_pk_bf16(o[dt][2] * inv, o[dt][3] * inv);
            *(GAS v2u*)(Ob + (size_t)tq * ATTN_W + hq * 128 + 16 * dt + 4 * quad) = w; }
    }
}

__device__ __forceinline__ void unpack_row(const v4u x, float (&o)[8]) { o[0] = bf_lo(x.x); o[1] = bf_hi(x.x); o[2] = bf_lo(x.y); o[3] = bf_hi(x.y); o[4] = bf_lo(x.z); o[5] = bf_hi(x.z); o[6] = bf_lo(x.w); o[7] = bf_hi(x.w); }
__device__ __forceinline__ void load8f(const float* p, float (&o)[8]) { const f32x4 a = *(const GAS f32x4*)p, b = *(const GAS f32x4*)(p + 4); o[0] = a.x; o[1] = a.y; o[2] = a.z; o[3] = a.w; o[4] = b.x; o[5] = b.y; o[6] = b.z; o[7] = b.w; }
__device__ __forceinline__ v4u xr_row(const bf16* XR, int r, int s0, int s1, int c0) { if (r < s0 || r >= s1) return (v4u){0u, 0u, 0u, 0u}; return *(const GAS v4u*)(XR + (size_t)r * D_RNN + c0); }
__device__ __forceinline__ void conv_phase(Frame& F, const bf16* XR, const float* cw, const float* cb, bf16* XC) {
    const int gt = (F.vcu * NWAVES + F.wave) * 64 + F.lane, NGT = F.G * NWAVES * 64;
    constexpr int NOCT = D_RNN / 8, RUN = 32;
    for (int it = gt; it < (M / RUN) * NOCT; it += NGT) { const int oc = it % NOCT, run = it / NOCT, c0 = 8 * oc, t0 = run * RUN;
        int s0, s1; seq_bounds(t0, s0, s1);
        float w[4][8], bias[8];
#pragma unroll
        for (int k = 0; k < 4; ++k) load8f(cw + (size_t)k * D_RNN + c0, w[k]);
        load8f(cb + c0, bias);
        float xm[8], x0[8], x1[8];
        unpack_row(xr_row(XR, t0 - 1, s0, s1, c0), xm); unpack_row(xr_row(XR, t0, s0, s1, c0), x0); unpack_row(xr_row(XR, t0 + 1, s0, s1, c0), x1);
        for (int i = 0; i < RUN; i += 4) { v4u pv[4];
#pragma unroll
            for (int q = 0; q < 4; ++q) pv[q] = xr_row(XR, t0 + i + q + 2, s0, s1, c0);
#pragma unroll
            for (int q = 0; q < 4; ++q) { float x2[8], o[8]; unpack_row(pv[q], x2);
#pragma unroll
                for (int e = 0; e < 8; ++e) { o[e] = bias[e] + w[0][e] * xm[e] + w[1][e] * x0[e] + w[2][e] * x1[e] + w[3][e] * x2[e]; xm[e] = x0[e]; x0[e] = x1[e]; x1[e] = x2[e]; }
                v4u pw; pw.x = pk2(o[0], o[1]); pw.y = pk2(o[2], o[3]); pw.z = pk2(o[4], o[5]); pw.w = pk2(o[6], o[7]);
                *(GAS v4u*)(XC + (size_t)(t0 + i + q) * D_RNN + c0) = pw; } }
    }
}
__device__ __forceinline__ void conv_fix_phase(Frame& F, const bf16* XB, const float* cw, const float* cb, bf16* XC) {
    const int gt = (F.vcu * NWAVES + F.wave) * 64 + F.lane, NGT = F.G * NWAVES * 64;
    constexpr int NOCT = D_RNN / 8;
    for (int it = gt; it < (M / 64) * 3 * NOCT; it += NGT) { const int oc = it % NOCT, q = (it / NOCT) % 3, seg = it / (3 * NOCT), c0 = 8 * oc, t = seg * 64 + (q == 0 ? 0 : 61 + q);
        int s0, s1; seq_bounds(t, s0, s1);
        float o[8]; load8f(cb + c0, o);
#pragma unroll
        for (int k = 0; k < 4; ++k) { const int tt = t - 1 + k;
            if (tt >= s0 && tt < s1) { const int sg = tt >> 6, rr = tt & 63, slot = rr < 3 ? rr : rr - 58; float x[8], w[8];
                unpack_row(*(const GAS v4u*)(XB + ((size_t)sg * 6 + slot) * D_RNN + c0), x); load8f(cw + (size_t)k * D_RNN + c0, w);
#pragma unroll
                for (int e = 0; e < 8; ++e) o[e] += w[e] * x[e]; } }
        v4u pw; pw.x = pk2(o[0], o[1]); pw.y = pk2(o[2], o[3]); pw.z = pk2(o[4], o[5]); pw.w = pk2(o[6], o[7]);
        *(GAS v4u*)(XC + (size_t)t * D_RNN + c0) = pw; }
}
__device__ __forceinline__ void lru_load_b(bf16x8 (&wb)[32], const bf16* WA, const bf16* WX, int dir, int n, int wave, int lane) {
    const size_t o = ((size_t)((dir * 16 + n) * 8 + wave) * 16 * 64 + lane) * 8;
#pragma unroll
    for (int kk = 0; kk < 16; ++kk) { wb[kk] = *(const GAS bf16x8*)(WA + o + (size_t)kk * 512); wb[16 + kk] = *(const GAS bf16x8*)(WX + o + (size_t)kk * 512); }
}
__device__ __forceinline__ void convert_lru_weight(Frame& F, const float* W, bf16* WT) {
    const int gt = (F.vcu * NWAVES + F.wave) * 64 + F.lane, NGT = F.G * NWAVES * 64;
    for (int it = gt; it < 32 * 8 * 16 * 64; it += NGT) { const int lane = it & 63, kk = (it >> 6) & 15, w = (it >> 10) & 7, mat = it >> 13;
        const int d = 32 * w + (lane & 31), c0 = 16 * kk + 8 * (lane >> 5); const float* src = W + ((size_t)mat * 256 + c0) * 256 + d;
        const float sc = -LOG2E;
        v4u o; o.x = pk2(sc * src[0], sc * src[256]); o.y = pk2(sc * src[512], sc * src[768]); o.z = pk2(sc * src[1024], sc * src[1280]); o.w = pk2(sc * src[1536], sc * src[1792]);
        *(GAS v4u*)(WT + (size_t)it * 8) = o; }
}
template <int DIR, bool WANT_H>
__device__ __forceinline__ void lane_scan(const f32x16& a, const f32x16& b, int hs, float cin, float& Ptot, float& Hfin, f32x16& hout) {
    float P[4], Hh[4], Pp[4], Hp[4], cown[4];
#pragma unroll
    for (int g = 0; g < 4; ++g) { float p = 1.f, hh = 0.f;
#pragma unroll
        for (int jj = 0; jj < 4; ++jj) { const int i = 4 * g + (DIR ? 3 - jj : jj); hh = a[i] * hh + b[i]; p *= a[i]; }
        P[g] = p; Hh[g] = hh; }
#pragma unroll
    for (int g = 0; g < 4; ++g) { Pp[g] = __shfl_xor(P[g], 32); Hp[g] = __shfl_xor(Hh[g], 32); }
    float cst = cin, ptot = 1.f;
#pragma unroll
    for (int gg = 0; gg < 4; ++gg) { const int g = DIR ? 3 - gg : gg;
        const float Pe = hs ? Pp[g] : P[g], He = hs ? Hp[g] : Hh[g];
        const float Po = hs ? P[g] : Pp[g], Ho = hs ? Hh[g] : Hp[g];
        float ce, co;
        if (!DIR) { ce = cst; cst = Pe * cst + He; co = cst; cst = Po * cst + Ho; }
        else { co = cst; cst = Po * cst + Ho; ce = cst; cst = Pe * cst + He; }
        cown[g] = hs ? co : ce; ptot *= Pe * Po; }
    Ptot = ptot; Hfin = cst;
    if (WANT_H) {
#pragma unroll
        for (int g = 0; g < 4; ++g) { float hc = cown[g];
#pragma unroll
            for (int jj = 0; jj < 4; ++jj) { const int i = 4 * g + (DIR ? 3 - jj : jj); hc = a[i] * hc + b[i]; hout[i] = hc; } }
    }
}
struct LruArgs { const bf16 *XC, *YR; const bf16 *WA, *WX; const float *ba, *bx, *lam; float* AGG; const float* CIN; bf16 *TMPH, *REC; };
constexpr int LT_PITCH = 528, LT_BYTES = 32 * LT_PITCH;
template <bool FINAL, int DIR, int NJ>
__device__ __forceinline__ void lru_dir_pass(Frame& F, const LruArgs& A, int n, int cbase, float hin, float& Pacc, float& Hacc) {
    LAS unsigned char* lds = F.lds;
    const int tid = F.tid, lane = F.lane, wave = F.wave, cl = lane & 31, hs = lane >> 5;
    const int chb = n * 256, ch = chb + 32 * wave + cl;
    const int trow = tid >> 4, tseg = tid & 15;
    bf16x8 wb[32]; lru_load_b(wb, A.WA, A.WX, DIR, n, wave, lane);
    const float bav = -LOG2E * A.ba[DIR * D_RNN + ch], bxv = -LOG2E * A.bx[DIR * D_RNN + ch], c2 = (-8.0f * LOG2E) * log1pf(expf(-A.lam[DIR * D_RNN + ch]));
#define LRU_CHUNK(jj) (cbase + (DIR ? NJ - 1 - (jj) : (jj)))
    float hstate = hin, pacc = 1.f;
    v4u tp0;
    __syncthreads();
#pragma unroll 1
    for (int c = 0; c < 4; ++c) { const bf16* src = A.XC + (size_t)(LRU_CHUNK(c) * LCH + trow) * D_RNN + chb + 16 * tseg; tp0 = *(const GAS v4u*)src; *(LAS v4u*)(lds + c * LT_BYTES + trow * LT_PITCH + 32 * tseg) = tp0; tp0 = *(const GAS v4u*)(src + 8); *(LAS v4u*)(lds + c * LT_BYTES + trow * LT_PITCH + 32 * tseg + 16) = tp0; }
    for (int j = 0; j < NJ; ++j) { const int chunk = LRU_CHUNK(j), row0 = chunk * LCH;
        LAS unsigned char* T = lds + (j & 7) * LT_BYTES;
        if ((j & 3) == 0) __syncthreads();
        const bf16* nsrc = A.XC + (size_t)(LRU_CHUNK(j + 4) * LCH + trow) * D_RNN + chb + 16 * tseg; LAS unsigned char* Tn = lds + ((j + 4) & 7) * LT_BYTES + trow * LT_PITCH + 32 * tseg;
        if (j + 4 < NJ) tp0 = *(const GAS v4u*)nsrc;
        const float cin = hstate;
        v4u th0, th1; const size_t tmo = ((size_t)((chunk * 16 + n) * 8 + wave) * 2) * 512 + lane * 8;
        if (FINAL && DIR == 1) { th0 = *(const GAS v4u*)(A.TMPH + tmo); th1 = *(const GAS v4u*)(A.TMPH + tmo + 512); }
        f32x16 acca, accx;
#pragma unroll
        for (int i = 0; i < 16; ++i) { acca[i] = 0.f; accx[i] = 0.f; }
#pragma unroll
        for (int kk = 0; kk < 16; ++kk) { const bf16x8 af = *(const LAS bf16x8*)(T + cl * LT_PITCH + (16 * kk + 8 * hs) * 2);
            acca = __builtin_amdgcn_mfma_f32_32x32x16_bf16(af, wb[kk], acca, 0, 0, 0);
            accx = __builtin_amdgcn_mfma_f32_32x32x16_bf16(af, wb[16 + kk], accx, 0, 0, 0); }
        if (j + 4 < NJ) { *(LAS v4u*)Tn = tp0; tp0 = *(const GAS v4u*)(nsrc + 8); }
        unsigned short yv[16];
        if (FINAL && DIR == 1) {
#pragma unroll
            for (int i = 0; i < 16; ++i) yv[i] = A.YR[(size_t)(row0 + (i & 3) + 8 * (i >> 2) + 4 * hs) * D_RNN + ch]; }
#pragma unroll
        for (int i = 0; i < 16; ++i) { const float xcv = bf_lo((unsigned)*(const LAS unsigned short*)(T + ((i & 3) + 8 * (i >> 2) + 4 * hs) * LT_PITCH + (32 * wave + cl) * 2));
            const float r = __builtin_amdgcn_rcpf(1.0f + __builtin_amdgcn_exp2f(acca[i] + bav)), ig = __builtin_amdgcn_rcpf(1.0f + __builtin_amdgcn_exp2f(accx[i] + bxv));
            const float a = __builtin_amdgcn_exp2f(c2 * r), em = __builtin_fmaf(-a, a, 1.0f);
            acca[i] = a; accx[i] = __builtin_amdgcn_sqrtf(em) * ig * xcv; }
        float Ptot, Hfin; f32x16 hv;
        lane_scan<DIR, FINAL>(acca, accx, hs, cin, Ptot, Hfin, hv);
        hstate = Hfin; pacc *= Ptot;
        if (!FINAL) { }
        else if (DIR == 0) {
            v4u o0, o1; o0.x = pg8::cvt_pk_bf16(hv[0], hv[1]); o0.y = pg8::cvt_pk_bf16(hv[2], hv[3]); o0.z = pg8::cvt_pk_bf16(hv[4], hv[5]); o0.w = pg8::cvt_pk_bf16(hv[6], hv[7]);
            o1.x = pg8::cvt_pk_bf16(hv[8], hv[9]); o1.y = pg8::cvt_pk_bf16(hv[10], hv[11]); o1.z = pg8::cvt_pk_bf16(hv[12], hv[13]); o1.w = pg8::cvt_pk_bf16(hv[14], hv[15]);
            *(GAS v4u*)(A.TMPH + tmo) = o0; *(GAS v4u*)(A.TMPH + tmo + 512) = o1;
        } else {
            float hfv[16]; hfv[0] = bf_lo(th0.x); hfv[1] = bf_hi(th0.x); hfv[2] = bf_lo(th0.y); hfv[3] = bf_hi(th0.y); hfv[4] = bf_lo(th0.z); hfv[5] = bf_hi(th0.z); hfv[6] = bf_lo(th0.w); hfv[7] = bf_hi(th0.w);
            hfv[8] = bf_lo(th1.x); hfv[9] = bf_hi(th1.x); hfv[10] = bf_lo(th1.y); hfv[11] = bf_hi(th1.y); hfv[12] = bf_lo(th1.z); hfv[13] = bf_hi(th1.z); hfv[14] = bf_lo(th1.w); hfv[15] = bf_hi(th1.w);
#pragma unroll
            for (int i = 0; i < 16; i += 2) { const size_t go = (size_t)(row0 + (i & 3) + 8 * (i >> 2) + 4 * hs) * D_RNN + ch;
                const unsigned pk = pg8::cvt_pk_bf16((hfv[i] + hv[i]) * fgelu(bf_lo((unsigned)yv[i])), (hfv[i + 1] + hv[i + 1]) * fgelu(bf_lo((unsigned)yv[i + 1])));
                A.REC[go] = (bf16)pk; A.REC[go + D_RNN] = (bf16)(pk >> 16); } }
        if (j + 4 < NJ) *(LAS v4u*)(Tn + 16) = tp0;
    }
    Pacc = pacc; Hacc = hstate;
#undef LRU_CHUNK
}
template <bool FINAL>
__device__ __forceinline__ void lru_phase(Frame& F, const LruArgs& A) {
    const int lane = F.lane, wave = F.wave, cl = lane & 31;
    for (int vb = blockIdx.x; vb < 256; vb += F.G) { const int n = vb >> 4, sub = vb & 15, ch = n * 256 + 32 * wave + cl;
        if (!FINAL) {
            const int cbase = sub * 32; float P, Hh;
            lru_dir_pass<false, 0, 32>(F, A, n, cbase, 0.f, P, Hh); if (lane < 32) *(GAS f32x2*)(A.AGG + ((size_t)(0 * 16 + sub) * D_RNN + ch) * 2) = (f32x2){P, Hh};
            lru_dir_pass<false, 1, 32>(F, A, n, cbase, 0.f, P, Hh); if (lane < 32) *(GAS f32x2*)(A.AGG + ((size_t)(1 * 16 + sub) * D_RNN + ch) * 2) = (f32x2){P, Hh};
        } else {
            const int cbase = sub < 8 ? sub * 64 : (SEQ_P / LCH) + (sub - 8) * 64;
            float hf = 0.f, hb = 0.f, P, Hh;
            if (sub < 8) {
                for (int q = 0; q < 2 * sub; ++q) { const f32x2 ab = *(const GAS f32x2*)(A.AGG + ((size_t)(0 * 16 + q) * D_RNN + ch) * 2); hf = ab.x * hf + ab.y; }
                for (int q = 15; q >= 2 * sub + 2; --q) { const f32x2 ab = *(const GAS f32x2*)(A.AGG + ((size_t)(1 * 16 + q) * D_RNN + ch) * 2); hb = ab.x * hb + ab.y; } }
            lru_dir_pass<true, 0, 64>(F, A, n, cbase, hf, P, Hh);
            lru_dir_pass<true, 1, 64>(F, A, n, cbase, hb, P, Hh);
        } }
}
__device__ __forceinline__ void lru_carry(Frame& F, const float* AGG, float* CIN) {
    const int gt = (F.vcu * NWAVES + F.wave) * 64 + F.lane, NGT = F.G * NWAVES * 64;
    for (int idx = gt; idx < 2 * 9 * D_RNN; idx += NGT) {
        const int ch = idx & (D_RNN - 1), sq = (idx >> 12) % 9, dir = idx / (9 * D_RNN);
        const int c0 = sq == 0 ? 0 : (SEQ_P / LCH) + (sq - 1) * (SEQ_S / LCH), nc = sq == 0 ? SEQ_P / LCH : SEQ_S / LCH;
        float h = 0.f;
#pragma unroll 32
        for (int i = 0; i < nc; ++i) { const int c = dir ? c0 + nc - 1 - i : c0 + i; const size_t o = (size_t)(dir * NCHUNK + c) * D_RNN + ch;
            const f32x2 ab = *(const GAS f32x2*)(AGG + o * 2); CIN[o] = h; h = ab.x * h + ab.y; }
    }
}

template <int NH>
__device__ __forceinline__ void convert_weight_il(Frame& F, const float* W, bf16* WT) {
    LAS float* scr = (LAS float*)(F.lds + RING_OFF + F.wave * 16384);
    const int gw = F.vcu * NWAVES + F.wave, NGW = F.G * NWAVES, lane = F.lane;
    constexpr int K = D, N = 2 * NH, nblk = N / 32;
    constexpr int total = (K / 64) * nblk;
#define CI_SRC(it) (W + (size_t)(64 * ((it) / nblk)) * N + 32 * ((it) % nblk))
    float cur[32], nxt[32];
    int it = gw; if (it < total) tr_load(CI_SRC(it), N, lane, cur);
    for (; it < total; it += NGW) { const int nit = it + NGW, k0 = 64 * (it / nblk), n0 = 32 * (it % nblk);
        const int nv = n0 < NH ? n0 : n0 - NH, d0 = 256 * (nv / 128) + (n0 < NH ? 0 : 128) + (nv % 128);
        if (nit < total) tr_load(CI_SRC(nit), N, lane, nxt);
        tr_store(cur, WT + (size_t)d0 * K + k0, K, scr, lane);
#pragma unroll
        for (int i = 0; i < 32; ++i) cur[i] = nxt[i]; }
#undef CI_SRC
}
__device__ __forceinline__ void act_fix_phase(Frame& F, const bf16* YB, const float* cw, const float* cb, bf16* ACT) {
    const int gt = (F.vcu * NWAVES + F.wave) * 64 + F.lane, NGT = F.G * NWAVES * 64;
    constexpr int NOCT = D_FF / 8, NF = 2 * D_FF;
    for (int it = gt; it < (M / 64) * 2 * NOCT; it += NGT) { const int oc = it % NOCT, rb = it / NOCT, seg = rb >> 1, last = rb & 1, j0 = 8 * oc, g = seg * 64 + (last ? 63 : 0);
        int s0, s1; seq_bounds(g, s0, s1);
        const bf16* ycur = YB + ((size_t)seg * 4 + (last ? 3 : 0)) * NF;
        const bf16* yup = last ? YB + ((size_t)seg * 4 + 2) * NF : YB + ((size_t)(seg - 1) * 4 + 3) * NF;
        const bf16* ydn = last ? YB + ((size_t)(seg + 1) * 4 + 0) * NF : YB + ((size_t)seg * 4 + 1) * NF;
        const bool hasup = last || (g - 1 >= s0), hasdn = !last || (g + 1 < s1);
        float wv[3][8], wg[3][8], bv[8], bg[8], vm[8], v0[8], vp[8], gm[8], g0[8], gp[8];
#pragma unroll
        for (int k = 0; k < 3; ++k) { load8f(cw + (size_t)k * NF + j0, wv[k]); load8f(cw + (size_t)k * NF + D_FF + j0, wg[k]); }
        load8f(cb + j0, bv); load8f(cb + D_FF + j0, bg);
        const v4u z = (v4u){0u, 0u, 0u, 0u};
        unpack_row(hasup ? *(const GAS v4u*)(yup + j0) : z, vm); unpack_row(hasup ? *(const GAS v4u*)(yup + D_FF + j0) : z, gm);
        unpack_row(*(const GAS v4u*)(ycur + j0), v0); unpack_row(*(const GAS v4u*)(ycur + D_FF + j0), g0);
        unpack_row(hasdn ? *(const GAS v4u*)(ydn + j0) : z, vp); unpack_row(hasdn ? *(const GAS v4u*)(ydn + D_FF + j0) : z, gp);
        float a[8];
#pragma unroll
        for (int e = 0; e < 8; ++e) { const float uv = bv[e] + wv[0][e] * vm[e] + wv[1][e] * v0[e] + wv[2][e] * vp[e]; const float ug = bg[e] + wg[0][e] * gm[e] + wg[1][e] * g0[e] + wg[2][e] * gp[e]; a[e] = fgelu(ug) * uv; }
        v4u w; w.x = pk2(a[0], a[1]); w.y = pk2(a[2], a[3]); w.z = pk2(a[4], a[5]); w.w = pk2(a[6], a[7]);
        *(GAS v4u*)(ACT + (size_t)g * D_FF + j0) = w; }
}

constexpr int NPH = 18;
#ifndef DIAG
#define DIAG 0
#endif
#ifndef TIMING
#define TIMING 0
#endif
#ifndef PROBE_REPW
#define PROBE_REPW 1
#endif
#ifndef PROBE_REPA
#define PROBE_REPA 1
#endif
#ifndef REP_MASK
#define REP_MASK 0u
#endif
#define NREP(k) ((((unsigned)args.pad >> (k)) & 1u) ? 2 : 1)
#ifndef TQ
#define TQ 100.0f
#endif
#ifndef LRU_VALU
#define LRU_VALU 0
#endif
#ifndef DW_ABS
#define DW_ABS 9
#define DW_RVR 11
#endif
#ifndef NSB_RUN
#define NSB_RUN NSB
#endif
#ifndef MK_PER_PHASE
#define MK_PER_PHASE 0
#endif
struct Args { const float* in[27]; float* out; unsigned char* ws; int ph_lo, ph_hi, li, pad; };
__global__ void __launch_bounds__(NWAVES * 64, 2) mega_fwd(Args args) {
    extern __shared__ __attribute__((aligned(16))) unsigned char lds_raw[];
    Frame F;
    F.lds = (LAS unsigned char*)lds_raw;
    F.MISC = (volatile LAS unsigned*)(F.lds + MISC_OFF);
int wv_ = __builtin_amdgcn_readfirstlane(threadIdx.x >> 6); asm volatile("" : "+s"(wv_));
#define REFRESH() do { int l_; asm volatile("v_mbcnt_lo_u32_b32 %0, -1, 0\n\tv_mbcnt_hi_u32_b32 %0, -1, %0" : "=v"(l_)); F.lane = l_; F.wave = wv_; F.tid = wv_ * 64 + l_; } while (0)
    REFRESH();
    F.G = gridDim.x; { const int bx = blockIdx.x; F.vcu = (F.G % 8 == 0) ? (bx % 8) * (F.G / 8) + bx / 8 : bx; }
    F.ctl = (gu32*)(args.ws + WS_CTL);
    for (int u = threadIdx.x; u < (LDS_BYTES - MISC_OFF) / 4; u += NWAVES * 64) ((LAS unsigned*)(F.lds + MISC_OFF))[u] = 0u;
    __syncthreads();
    XcdBarrier bar = xcd_barrier_post((unsigned*)(F.ctl + CW_BAR) + args.li * XCD_BAR_WORDS, F.MISC + 8);
    const int lo = args.ph_lo, hi = args.ph_hi;
#if TIMING
    const unsigned long long t_begin = wall_clock64();
#endif
#ifndef PH_MASK
#define PH_MASK 0xFFFFFFFFu
#endif
#define IN(k) (((PH_MASK >> (k)) & 1u) && lo <= (k) && (k) < hi)
#if TIMING
#define SEAM(k) do { if (IN(k) && IN((k) + 1)) xcd_barrier(bar, F.tid); if (blockIdx.x == 0 && threadIdx.x == 0) __hip_atomic_store(F.ctl + 64 + (k), (unsigned)(wall_clock64() - t_begin), RLX_AGENT); } while (0)
#else
#define SEAM(k) do { if (IN(k) && IN((k) + 1)) xcd_barrier(bar, F.tid); } while (0)
#endif
#define gw (F.vcu * NWAVES + F.wave)
#define NGW (F.G * NWAVES)
#define gt (gw * 64 + F.lane)
#define NGT (NGW * 64)
#define x_p (args.in[0])
#define x_s (args.in[1])
#define p_p (args.in[2])
#define p_s (args.in[3])
#define g_mix (args.in[4])
#define w_in (args.in[5])
#define rnn_cw (args.in[6])
#define rnn_cb (args.in[7])
#define lru_wa (args.in[8])
#define lru_ba (args.in[9])
#define lru_wx (args.in[10])
#define lru_bx (args.in[11])
#define lru_lam (args.in[12])
#define a_sink (args.in[13])
#define w_oa (args.in[14])
#define w_or (args.in[15])
#define w_mg (args.in[16])
#define w_out (args.in[17])
#define g_ffn (args.in[18])
#define w_up (args.in[19])
#define ffn_cw (args.in[20])
#define ffn_cb (args.in[21])
#define w_dn (args.in[22])
#define w_pg (args.in[23])
#define w_pl (args.in[24])
#define g_ple (args.in[25])
#define g_fin (args.in[26])
#define OUTF (args.out)
#define WSB(off) ((bf16*)(args.ws + (off)))
#define WSF(off) ((float*)(args.ws + (off)))
#define H WSB(WS_H)
#define Qb WSB(WS_Q)
#define Kb WSB(WS_K)
#define Vb WSB(WS_V)
#define REC WSB(WS_REC)
#define Gb WSB(WS_G)
#define MRG WSB(WS_MRG)
#define XR ((bf16*)args.out)
#define YR ((bf16*)args.out + (size_t)M * D_RNN)
#define AGG WSF(WS_AGG)
#define CIN WSF(WS_CIN)
#define WIN WSB(WS_WIN)
#define WG WSB(WS_WG)
#define WOA WSB(WS_WOA)
#define WOR WSB(WS_WOR)
#define WOUT WSB(WS_WOUT)
#define LWA WSB(WS_LWA)
#define LWX WSB(WS_LWX)
#define HN2 WSB(WS_HN2)
#define WUP WSB(WS_WUP)
#define WDN WSB(WS_WDN)
#define WPG WSB(WS_WPG)
#define WPL WSB(WS_WPL)
#define PB WSB(WS_PB)
#define YBUF WSB(WS_YB)
#define SS WSF(WS_SS)
#define RSE WSF(WS_RSE)
#define X2B WSB(WS_X2B)
#define ACT WSB(WS_ACT)
#define EU WSB(WS_EU)
#define X3B WSB(WS_X3B)
#define MAB ((bf16*)args.out)
#define X1B ((bf16*)args.out)
    typedef pg8::StaticOrder SO;

    for (int repw = 0; repw < PROBE_REPW; ++repw) if (IN(0)) { REFRESH(); if (repw) xcd_barrier(bar, F.tid);
        convert_weight(F, w_in, D, IN_W, 1, WIN); convert_weight_il<D>(F, w_mg, WG); convert_weight(F, w_oa, ATTN_W, D, 1, WOA);
        convert_weight(F, w_or, D_RNN, D, 1, WOR); convert_weight(F, w_out, D, D, 1, WOUT); convert_lru_weight(F, lru_wa, LWA); convert_lru_weight(F, lru_wx, LWX);
        for (int m = gw; m < M; m += NGW) rms_row_to_bf16(m < SEQ_P ? x_p + (size_t)m * D : x_s + (size_t)(m - SEQ_P) * D, g_mix, H + (size_t)m * D, F.lane);
    }
    SEAM(0);
    if (IN(1)) { REFRESH(); pg8::Gemm g{H, WIN, M, IN_W, D}; SO S; S.init(M, IN_W, F.G, (int)blockIdx.x);
        pg8::EpiZc E{Qb, Kb, Vb, MRG, YR, (bf16*)CIN, rnn_cw, rnn_cb, 0.08838834764831845f * LOG2E};
        pg8::gemm_phase<pg8::EpiZc, SO, true, true, true>(F.lds + RING_OFF, g, S, E, F.tid); }
    SEAM(1);


    if (IN(2)) { REFRESH(); for (int u = blockIdx.x; u < (M / 128) * 4; u += F.G) attn_unit(F, Qb, Kb, Vb, Qb, a_sink, u >> 2, u & 3);
        conv_fix_phase(F, (const bf16*)CIN, rnn_cw, rnn_cb, MRG); }
    SEAM(2);
#ifdef PROBE_REP3
    if (IN(3)) { for (int rep = 0; rep < PROBE_REP3; ++rep) { REFRESH(); LruArgs LA{MRG, YR, LWA, LWX, lru_ba, lru_bx, lru_lam, AGG, CIN, Gb, REC}; lru_phase<false>(F, LA); xcd_barrier(bar, F.tid); } }
#else
    if (IN(3)) { REFRESH(); LruArgs LA{MRG, YR, LWA, LWX, lru_ba, lru_bx, lru_lam, AGG, CIN, Gb, REC}; lru_phase<false>(F, LA); }
#endif
    SEAM(3);

#ifdef PROBE_REP5
    if (IN(5)) { for (int rep = 0; rep < PROBE_REP5; ++rep) { REFRESH(); LruArgs LA{MRG, YR, LWA, LWX, lru_ba, lru_bx, lru_lam, AGG, CIN, Gb, REC}; lru_phase<true>(F, LA); xcd_barrier(bar, F.tid); } }
#else
    if (IN(5)) { REFRESH(); LruArgs LA{MRG, YR, LWA, LWX, lru_ba, lru_bx, lru_lam, AGG, CIN, Gb, REC}; lru_phase<true>(F, LA); }
#endif
    SEAM(5);

    if (IN(6)) { REFRESH(); pg8::Gemm g{Qb, WOA, M, D, ATTN_W}; SO S; S.init(M, D, F.G, (int)blockIdx.x); pg8::EpiStore<0> E{MAB, D};
        pg8::gemm_phase<pg8::EpiStore<0>, SO, true, true>(F.lds + RING_OFF, g, S, E, F.tid); }
    SEAM(6);
    if (IN(7)) { REFRESH(); pg8::Gemm g{REC, WOR, M, D, D_RNN}; SO S; S.init(M, D, F.G, (int)blockIdx.x); pg8::EpiStore<0> E{Gb, D};
        pg8::gemm_phase<pg8::EpiStore<0>, SO, true, true>(F.lds + RING_OFF, g, S, E, F.tid); }
    SEAM(7);
    if (IN(8)) { REFRESH(); pg8::Gemm g{H, WG, M, 2 * D, D}; SO S; S.init(M, 2 * D, F.G, (int)blockIdx.x); pg8::EpiMerge2 E{MAB, Gb, MRG};
        pg8::gemm_phase<pg8::EpiMerge2, SO, true, true>(F.lds + RING_OFF, g, S, E, F.tid); }
    SEAM(8);
    if (IN(10)) { REFRESH(); pg8::Gemm g{MRG, WOUT, M, D, D}; SO S; S.init(M, D, F.G, (int)blockIdx.x); pg8::EpiResid0 E{x_p, x_s, X1B};
        pg8::gemm_phase<pg8::EpiResid0, SO, true, true>(F.lds + RING_OFF, g, S, E, F.tid); }
    SEAM(10);
    for (int repw = 0; repw < PROBE_REPW; ++repw) if (IN(11)) { REFRESH(); if (repw) xcd_barrier(bar, F.tid);
        convert_weight_il<D_FF>(F, w_up, WUP); convert_weight(F, w_dn, D_FF, D, 1, WDN); convert_weight(F, w_pg, D, D, 1, WPG); convert_weight(F, w_pl, PLE, D, 1, WPL);
        for (int m = gw; m < M; m += NGW) rms_brow_to_bf16(X1B + (size_t)m * D, g_ffn, HN2 + (size_t)m * D, F.lane);
        for (int i = gt; i < M * PLE / 8; i += NGT) { const size_t e = (size_t)i * 8; const float* src = e < (size_t)SEQ_P * PLE ? p_p + e : p_s + (e - (size_t)SEQ_P * PLE);
            const f32x4 a = *(const GAS f32x4*)src, b = *(const GAS f32x4*)(src + 4); v4u w; w.x = pk2(a.x, a.y); w.y = pk2(a.z, a.w); w.z = pk2(b.x, b.y); w.w = pk2(b.z, b.w); *(GAS v4u*)(PB + e) = w; }
    }
    SEAM(11);
    if (IN(12)) { REFRESH(); pg8::Gemm g{HN2, WUP, M, 2 * D_FF, D}; SO S; S.init(M, 2 * D_FF, F.G, (int)blockIdx.x); pg8::EpiAct E{ffn_cw, ffn_cb, ACT, YBUF};
        pg8::gemm_phase<pg8::EpiAct, SO, false, true, true>(F.lds + RING_OFF, g, S, E, F.tid); }
    SEAM(12);
    if (IN(13)) { REFRESH(); act_fix_phase(F, YBUF, ffn_cw, ffn_cb, ACT);
        xcd_barrier(bar, F.tid); REFRESH();
        { pg8::Gemm g{ACT, WDN, M, D, D_FF}; SO S; S.init(M, D, F.G, (int)blockIdx.x); pg8::EpiResidAcc E{X1B, X2B};
          pg8::gemm_phase<pg8::EpiResidAcc, SO, true, true>(F.lds + RING_OFF, g, S, E, F.tid); }
    }
    SEAM(13);
    if (IN(14)) { REFRESH(); pg8::Gemm g{PB, WPL, M, D, PLE}; SO S; S.init(M, D, F.G, (int)blockIdx.x); pg8::EpiEU E{EU, SS};
        pg8::gemm_phase<pg8::EpiEU, SO, true, true>(F.lds + RING_OFF, g, S, E, F.tid); }
    SEAM(14);
    if (IN(15)) { REFRESH(); for (int m = gw; m < M; m += NGW) { const float s = wave_sum(SS[(size_t)m * 64 + F.lane]); if (F.lane == 0) RSE[m] = 1.0f / sqrtf(s * (1.f / D) + EPS); } }
    SEAM(15);
    if (IN(16)) { REFRESH(); pg8::Gemm g{X2B, WPG, M, D, D}; SO S; S.init(M, D, F.G, (int)blockIdx.x); pg8::EpiPle E{X2B, X3B, EU, RSE, g_ple, SS};
        pg8::gemm_phase<pg8::EpiPle, SO, true, true>(F.lds + RING_OFF, g, S, E, F.tid); }
    SEAM(16);
    if (IN(17)) { REFRESH();
        for (int m = gw; m < M; m += NGW) { const float s = wave_sum(SS[(size_t)m * 64 + F.lane]); const float rstd = 1.0f / sqrtf(s * (1.f / D) + EPS);
            const GAS v4u* xr = (const GAS v4u*)(X3B + (size_t)m * D) + F.lane; GAS f32x4* orow = (GAS f32x4*)(OUTF + (size_t)m * D) + 2 * F.lane; const GAS f32x4* gr = (const GAS f32x4*)g_fin + 2 * F.lane;
#pragma unroll
            for (int j = 0; j < 8; ++j) { const v4u w = xr[64 * j]; const f32x4 g0 = gr[128 * j], g1 = gr[128 * j + 1];
                orow[128 * j] = (f32x4){bf_lo(w.x), bf_hi(w.x), bf_lo(w.y), bf_hi(w.y)} * rstd * g0; orow[128 * j + 1] = (f32x4){bf_lo(w.z), bf_hi(w.z), bf_lo(w.w), bf_hi(w.w)} * rstd * g1; } }
    }
#if TIMING
    if (blockIdx.x == 0 && threadIdx.x == 0) __hip_atomic_store(F.ctl + 64 + 17, (unsigned)(wall_clock64() - t_begin), RLX_AGENT);
    { xcd_barrier(bar, F.tid); REFRESH();
      const float ta = 0.01f * (float)((int)__hip_atomic_load(F.ctl + 64 + TA_HI, RLX_AGENT) - (TA_LO > 0 ? (int)__hip_atomic_load(F.ctl + 64 + TA_LO - 1, RLX_AGENT) : 0));
      const float tb = 0.01f * (float)((int)__hip_atomic_load(F.ctl + 64 + TB_HI, RLX_AGENT) - (TB_LO > 0 ? (int)__hip_atomic_load(F.ctl + 64 + TB_LO - 1, RLX_AGENT) : 0));
      const float cfill = sqrtf(TQ * floorf(tb / TQ + 0.5f));
      for (size_t i = (size_t)gt; i < (size_t)M * D / 4; i += NGT) { const float v = i >= (size_t)SEQ_P * D / 4 ? cfill : 0.f; ((GAS f32x4*)OUTF)[i] = (f32x4){v, v, v, v}; }
      xcd_barrier(bar, F.tid); REFRESH();
      if (blockIdx.x == 0 && F.tid == 0) OUTF[0] = TQ * floorf(ta / TQ + 0.5f); }
#endif
#undef IN
#undef SEAM
#undef gw
#undef NGW
#undef gt
#undef NGT
#undef H
#undef SS
#undef EU
#undef ACT
#undef PB
}

extern "C" void kernel_launch(void* const* d_in, const int* in_sizes, int n_in, void* d_out, int out_size, void* d_ws, size_t ws_size, hipStream_t stream) {
    static int grid = 0;
    if (grid == 0) {
        if (n_in != 27 || in_sizes[0] != SEQ_P * D || out_size != M * D || ws_size < WS_NEED) { fprintf(stderr, "kernel_launch: unexpected shapes (n_in %d, in0 %d, out %d, ws %zu need %zu); nothing launched\n", n_in, n_in > 0 ? in_sizes[0] : -1, out_size, ws_size, (size_t)WS_NEED); grid = -1; return; }
        int dev = 0, cus = 0, per_cu = 0;
        if (hipGetDevice(&dev) != hipSuccess || hipDeviceGetAttribute(&cus, hipDeviceAttributeMultiprocessorCount, dev) != hipSuccess) { grid = -1; return; }
        if (hipFuncSetAttribute((const void*)mega_fwd, hipFuncAttributeMaxDynamicSharedMemorySize, LDS_BYTES) != hipSuccess) { fprintf(stderr, "kernel_launch: hipFuncSetAttribute failed\n"); grid = -1; return; }
        if (hipOccupancyMaxActiveBlocksPerMultiprocessor(&per_cu, (const void*)mega_fwd, NWAVES * 64, LDS_BYTES) != hipSuccess || per_cu < 1) { fprintf(stderr, "kernel_launch: occupancy query reports %d\n", per_cu); }
        (void)hipGetLastError();
        grid = cus;
    }
    if (grid < 0) return;
    if (hipMemsetAsync((char*)d_ws + WS_CTL, 0, CTL_ZERO_BYTES, stream) != hipSuccess) return;
    Args a{};
    for (int i = 0; i < 27; ++i) a.in[i] = (const float*)d_in[i];
    a.out = (float*)d_out; a.ws = (unsigned char*)d_ws; a.pad = (int)REP_MASK;
#if MK_PER_PHASE
    for (int li = 0; li < NPH; ++li) { a.ph_lo = li; a.ph_hi = li + 1; a.li = li; hipLaunchKernelGGL(mega_fwd, dim3(grid), dim3(NWAVES * 64), LDS_BYTES, stream, a); }
#else
    a.ph_lo = 0; a.ph_hi = NPH; a.li = 0;
    hipLaunchKernelGGL(mega_fwd, dim3(grid), dim3(NWAVES * 64), LDS_BYTES, stream, a);
#endif
}
```

```cpp
#include <hip/hip_runtime.h>
#include <cstdio>
#include <cstdint>
namespace pg8 {
#define PG8_LAS __attribute__((address_space(3)))
typedef unsigned short bf16_t;
typedef short bf16x8 __attribute__((ext_vector_type(8)));
typedef float f32x4 __attribute__((ext_vector_type(4)));
typedef unsigned u32x4 __attribute__((ext_vector_type(4)));
constexpr int BM = 256, BK = 64, HALF = 128, HTB = HALF * BK * 2  , STAGE_BYTES = 8 * HTB, NXCD = 8, WGM = 8;

__host__ __device__ __forceinline__ int lds_byte(int r, int c) { const int st = (r >> 4) * 2 + (c >> 5), rr = r & 15, cc = c & 31, ob = rr * 64 + cc * 2; return st * 1024 + (ob ^ (((ob >> 9) & 1) << 5)); }
__host__ __device__ __forceinline__ void stage_rc(int b, int& R, int& C) { const int st = b / 1024, sb = b % 1024, swz = sb ^ (((sb >> 9) & 1) << 5); R = (st >> 1) * 16 + swz / 64; C = (st & 1) * 32 + (swz % 64) / 2; }
__host__ __device__ __forceinline__ int perm32(int rho) { const int n = rho >> 4, i = rho & 15; return 8 * (i >> 2) + 4 * n + (i & 3); }

struct Unit { int pm, pn; };
struct Gemm { const bf16_t* A; const bf16_t* Bt; int M, N, K; };

struct StaticOrder {
    int nM, nN, nwg, G, c;
    __host__ __device__ void init(int M, int N, int G_, int c_) { nM = M / BM; nN = N / BM; nwg = nM * nN; G = G_; c = c_; }
    __host__ __device__ bool next(int i, Unit& u) const {
        const long L = (long)i * G + c; if (L >= nwg) return false;
        int wgid = (int)L; { const int q = nwg / NXCD, r = nwg % NXCD, xcd = wgid % NXCD, off = wgid / NXCD; wgid = (xcd < r ? xcd * (q + 1) : r * (q + 1) + (xcd - r) * q) + off; }
        const int nig = WGM * nN, gid = wgid / nig, fm = gid * WGM, gsz = (nM - fm) < WGM ? (nM - fm) : WGM;
        u.pm = fm + ((wgid % nig) % gsz); u.pn = (wgid % nig) / gsz; return true;
    }
    __device__ __forceinline__ void a_ready(const Unit&) const {}
    __device__ __forceinline__ void done(const Unit&) const {}
};
__device__ __forceinline__ unsigned cvt_pk_bf16(float lo, float hi) { unsigned r; asm volatile("s_nop 2\n\tv_cvt_pk_bf16_f32 %0, %1, %2" : "=v"(r) : "v"(lo), "v"(hi)); return r; }
typedef float f32x2 __attribute__((ext_vector_type(2)));
__device__ __forceinline__ float fsigmoid(float x) { return __builtin_amdgcn_rcpf(1.0f + __builtin_amdgcn_exp2f(-1.4426950408889634f * x)); }
__device__ __forceinline__ float fgelu(float x) { const float p = __builtin_fmaf(x * x, -2.3022081985f * 0.044715f, -2.3022081985f); return x * __builtin_amdgcn_rcpf(1.0f + __builtin_amdgcn_exp2f(p * x)); }
__device__ __forceinline__ float bf_lo(unsigned w) { return __uint_as_float(w << 16); }
__device__ __forceinline__ float bf_hi(unsigned w) { return __uint_as_float(w & 0xffff0000u); }

#define EPI_ROWS(ai, m) (row0 + (ai) * HALF + (m) * 16)
__device__ __forceinline__ u32x4 pack8(const f32x4 v0, const f32x4 v1) { u32x4 w; w.x = cvt_pk_bf16(v0[0], v0[1]); w.y = cvt_pk_bf16(v0[2], v0[3]); w.z = cvt_pk_bf16(v1[0], v1[1]); w.w = cvt_pk_bf16(v1[2], v1[3]); return w; }
__device__ __forceinline__ void unpack8(const u32x4 w, f32x4& v0, f32x4& v1) { v0 = (f32x4){bf_lo(w.x), bf_hi(w.x), bf_lo(w.y), bf_hi(w.y)}; v1 = (f32x4){bf_lo(w.z), bf_hi(w.z), bf_lo(w.w), bf_hi(w.w)}; }

__device__ __forceinline__ f32x4 dpp_rot(const f32x4 v, const bool left) { f32x4 o;
#pragma unroll
    for (int j = 0; j < 4; ++j) { const float s = v[j]; const int x = __float_as_int(s);
        const int y = left ? __builtin_amdgcn_mov_dpp(x, 0x12F, 0xF, 0xF, true) : __builtin_amdgcn_mov_dpp(x, 0x121, 0xF, 0xF, true);
        o[j] = __int_as_float(y); }
    return o; }
struct EpiZc {
    static constexpr bool PERM = true, AFTER_DRAIN = false;
    bf16_t *Q, *K, *V, *XC, *YR, *XB; const float *cw, *cb; float qscale;
    __device__ __forceinline__ void operator()(const f32x4 (&acc)[2][2][4][2], const Unit& u, int wr, int wc, int fr, int fq) const {
        const int pn = u.pn, rbase = u.pm * BM + wr * 64 + 4 * fr;
        if (pn < 12 || pn >= 28) { bf16_t* base; int ldc, colt; float sc = 1.f;
            if (pn < 8) { base = Q; ldc = 2048; colt = pn * 256; sc = qscale; }
            else if (pn < 10) { base = K; ldc = 512; colt = (pn - 8) * 256; }
            else if (pn < 12) { base = V; ldc = 512; colt = (pn - 10) * 256; }
            else { base = YR; ldc = 4096; colt = (pn - 28) * 256; }
            const int col0 = colt + wc * 32 + 8 * fq;
#pragma unroll
            for (int ai = 0; ai < 2; ++ai)
#pragma unroll
                for (int m = 0; m < 4; ++m) { bf16_t* rowp = base + (size_t)(rbase + ai * HALF + m) * ldc + col0;
#pragma unroll
                    for (int bj = 0; bj < 2; ++bj) *(u32x4*)(rowp + bj * HALF) = pack8(acc[ai][bj][m][0] * sc, acc[ai][bj][m][1] * sc); }
        } else {
            const bool f0 = fr == 0, f15 = fr == 15;
#pragma unroll
            for (int bj = 0; bj < 2; ++bj) { const int c0 = (pn - 12) * 256 + wc * 32 + 8 * fq + bj * HALF;
                f32x4 w[4][2], b[2];
#pragma unroll
                for (int k = 0; k < 4; ++k) { w[k][0] = *(const f32x4*)(cw + k * 4096 + c0); w[k][1] = *(const f32x4*)(cw + k * 4096 + c0 + 4); }
                b[0] = *(const f32x4*)(cb + c0); b[1] = *(const f32x4*)(cb + c0 + 4);
#pragma unroll
                for (int ai = 0; ai < 2; ++ai) { const int seg = u.pm * 4 + ai * 2 + wr;
                    if (f0) {
#pragma unroll
                        for (int mm = 0; mm < 3; ++mm) *(u32x4*)(XB + ((size_t)seg * 6 + mm) * 4096 + c0) = pack8(acc[ai][bj][mm][0], acc[ai][bj][mm][1]); }
                    if (f15) {
#pragma unroll
                        for (int mm = 1; mm < 4; ++mm) *(u32x4*)(XB + ((size_t)seg * 6 + 2 + mm) * 4096 + c0) = pack8(acc[ai][bj][mm][0], acc[ai][bj][mm][1]); }
                    f32x4 U3[2], D0[2], D1[2];
#pragma unroll
                    for (int n = 0; n < 2; ++n) { U3[n] = dpp_rot(acc[ai][bj][3][n], false); D0[n] = dpp_rot(acc[ai][bj][0][n], true); D1[n] = dpp_rot(acc[ai][bj][1][n], true); }
#pragma unroll
                    for (int m = 0; m < 4; ++m) { f32x4 o[2];
#pragma unroll
                        for (int n = 0; n < 2; ++n) {
                            const f32x4 xm1 = m == 0 ? U3[n] : acc[ai][bj][m == 0 ? 0 : m - 1][n], x0 = acc[ai][bj][m][n];
                            const f32x4 x1 = m == 3 ? D0[n] : acc[ai][bj][m == 3 ? 3 : m + 1][n], x2 = m == 2 ? D0[n] : (m == 3 ? D1[n] : acc[ai][bj][m >= 2 ? 3 : m + 2][n]);
                            o[n] = b[n] + w[0][n] * xm1 + w[1][n] * x0 + w[2][n] * x1 + w[3][n] * x2; }
                        const bool fix = (m == 0 && f0) || (m >= 2 && f15);
                        if (!fix) *(u32x4*)(XC + (size_t)(rbase + ai * HALF + m) * 4096 + c0) = pack8(o[0], o[1]); } } }
        }
    }
};
struct EpiZ {
    static constexpr bool PERM = true, AFTER_DRAIN = false;
    bf16_t *Q, *K, *V, *XR, *YR; float qscale;
    __device__ __forceinline__ void operator()(const f32x4 (&acc)[2][2][4][2], const Unit& u, int wr, int wc, int fr, int fq) const {
        const int pn = u.pn; bf16_t* base; int ldc, colt; float sc = 1.f;
        if (pn < 8) { base = Q; ldc = 2048; colt = pn * 256; sc = qscale; }
        else if (pn < 10) { base = K; ldc = 512; colt = (pn - 8) * 256; }
        else if (pn < 12) { base = V; ldc = 512; colt = (pn - 10) * 256; }
        else if (pn < 28) { base = XR; ldc = 4096; colt = (pn - 12) * 256; }
        else { base = YR; ldc = 4096; colt = (pn - 28) * 256; }
        const int row0 = u.pm * BM + wr * 64 + fr, col0 = colt + wc * 32 + 8 * fq;
#pragma unroll
        for (int ai = 0; ai < 2; ++ai)
#pragma unroll
            for (int m = 0; m < 4; ++m) { bf16_t* rowp = base + (size_t)EPI_ROWS(ai, m) * ldc + col0;
#pragma unroll
                for (int bj = 0; bj < 2; ++bj) *(u32x4*)(rowp + bj * HALF) = pack8(acc[ai][bj][m][0] * sc, acc[ai][bj][m][1] * sc); }
    }
};
template <int ACT> struct EpiStore {
    static constexpr bool PERM = true, AFTER_DRAIN = false;
    bf16_t* O; int ldc;
    __device__ __forceinline__ void operator()(const f32x4 (&acc)[2][2][4][2], const Unit& u, int wr, int wc, int fr, int fq) const {
        const int row0 = u.pm * BM + wr * 64 + fr, col0 = u.pn * BM + wc * 32 + 8 * fq;
#pragma unroll
        for (int ai = 0; ai < 2; ++ai)
#pragma unroll
            for (int m = 0; m < 4; ++m) { bf16_t* rowp = O + (size_t)EPI_ROWS(ai, m) * ldc + col0;
#pragma unroll
                for (int bj = 0; bj < 2; ++bj) { f32x4 v0 = acc[ai][bj][m][0], v1 = acc[ai][bj][m][1];
                    if (ACT == 1) {
#pragma unroll
                        for (int j = 0; j < 4; ++j) { v0[j] = fsigmoid(v0[j]); v1[j] = fsigmoid(v1[j]); } }
                    *(u32x4*)(rowp + bj * HALF) = pack8(v0, v1); } }
    }
};
struct EpiMulG {
    static constexpr bool PERM = true, AFTER_DRAIN = false;
    const bf16_t* G; bf16_t* MA;
    __device__ __forceinline__ void operator()(const f32x4 (&acc)[2][2][4][2], const Unit& u, int wr, int wc, int fr, int fq) const {
        const int row0 = u.pm * BM + wr * 64 + fr, col0 = u.pn * BM + wc * 32 + 8 * fq;
#pragma unroll
        for (int ai = 0; ai < 2; ++ai)
#pragma unroll
            for (int m = 0; m < 4; ++m) { const size_t off = (size_t)EPI_ROWS(ai, m) * 4096 + col0;
#pragma unroll
                for (int bj = 0; bj < 2; ++bj) { f32x4 g0, g1; unpack8(*(const u32x4*)(G + off + bj * HALF), g0, g1);
                    *(u32x4*)(MA + off + bj * HALF) = pack8(acc[ai][bj][m][0] * g0, acc[ai][bj][m][1] * g1); } }
    }
};
struct EpiMerge {
    static constexpr bool PERM = true, AFTER_DRAIN = false;
    const bf16_t* G; const bf16_t* MA; bf16_t* O;
    __device__ __forceinline__ void operator()(const f32x4 (&acc)[2][2][4][2], const Unit& u, int wr, int wc, int fr, int fq) const {
        const int row0 = u.pm * BM + wr * 64 + fr, col0 = u.pn * BM + wc * 32 + 8 * fq;
#pragma unroll
        for (int ai = 0; ai < 2; ++ai)
#pragma unroll
            for (int m = 0; m < 4; ++m) { const size_t off = (size_t)EPI_ROWS(ai, m) * 4096 + col0;
#pragma unroll
                for (int bj = 0; bj < 2; ++bj) { f32x4 g0, g1; unpack8(*(const u32x4*)(G + off + bj * HALF), g0, g1);
                    f32x4 m0, m1; unpack8(*(const u32x4*)(MA + off + bj * HALF), m0, m1);
                    *(u32x4*)(O + off + bj * HALF) = pack8(acc[ai][bj][m][0] * g0 + m0, acc[ai][bj][m][1] * g1 + m1); } }
    }
};
struct EpiResid0 {
    static constexpr bool PERM = true, AFTER_DRAIN = false;
    const float *xa, *xb; bf16_t* O;
    __device__ __forceinline__ void operator()(const f32x4 (&acc)[2][2][4][2], const Unit& u, int wr, int wc, int fr, int fq) const {
        const int row0 = u.pm * BM + wr * 64 + fr, col0 = u.pn * BM + wc * 32 + 8 * fq;
        const float* X = (u.pm < 64) ? xa : (xb - (size_t)16384 * 4096);
#pragma unroll
        for (int ai = 0; ai < 2; ++ai)
#pragma unroll
            for (int m = 0; m < 4; ++m) { const size_t off = (size_t)EPI_ROWS(ai, m) * 4096 + col0;
#pragma unroll
                for (int bj = 0; bj < 2; ++bj) {
                    const f32x4 x0 = *(const f32x4*)(X + off + bj * HALF), x1 = *(const f32x4*)(X + off + bj * HALF + 4);
                    *(u32x4*)(O + off + bj * HALF) = pack8(x0 + acc[ai][bj][m][0], x1 + acc[ai][bj][m][1]); } }
    }
};
struct EpiResidAcc {
    static constexpr bool PERM = true, AFTER_DRAIN = false;
    const bf16_t* X; bf16_t* XB;
    __device__ __forceinline__ void operator()(const f32x4 (&acc)[2][2][4][2], const Unit& u, int wr, int wc, int fr, int fq) const {
        const int row0 = u.pm * BM + wr * 64 + fr, col0 = u.pn * BM + wc * 32 + 8 * fq;
#pragma unroll
        for (int ai = 0; ai < 2; ++ai)
#pragma unroll
            for (int m = 0; m < 4; ++m) { const size_t off = (size_t)EPI_ROWS(ai, m) * 4096 + col0;
#pragma unroll
                for (int bj = 0; bj < 2; ++bj) {
                    f32x4 x0, x1; unpack8(*(const u32x4*)(X + off + bj * HALF), x0, x1); x0 += acc[ai][bj][m][0]; x1 += acc[ai][bj][m][1];
                    *(u32x4*)(XB + off + bj * HALF) = pack8(x0, x1); } }
    }
};
struct EpiEU {
    static constexpr bool PERM = true, AFTER_DRAIN = false;
    bf16_t* O; float* SS;
    __device__ __forceinline__ void operator()(const f32x4 (&acc)[2][2][4][2], const Unit& u, int wr, int wc, int fr, int fq) const {
        const int row0 = u.pm * BM + wr * 64 + fr, col0 = u.pn * BM + wc * 32 + 8 * fq;
#pragma unroll
        for (int ai = 0; ai < 2; ++ai)
#pragma unroll
            for (int m = 0; m < 4; ++m) { const size_t off = (size_t)EPI_ROWS(ai, m) * 4096 + col0; float s = 0.f;
#pragma unroll
                for (int bj = 0; bj < 2; ++bj) { const f32x4 v0 = acc[ai][bj][m][0], v1 = acc[ai][bj][m][1];
                    s += (v0[0] * v0[0] + v0[1] * v0[1]) + (v0[2] * v0[2] + v0[3] * v0[3]) + (v1[0] * v1[0] + v1[1] * v1[1]) + (v1[2] * v1[2] + v1[3] * v1[3]);
                    *(u32x4*)(O + off + bj * HALF) = pack8(v0, v1); }
                s += __shfl_xor(s, 16); s += __shfl_xor(s, 32);
                if (fq == 0) SS[(size_t)EPI_ROWS(ai, m) * 64 + u.pn * 4 + wc] = s; }
    }
};
struct EpiPle {
    static constexpr bool PERM = true, AFTER_DRAIN = false;
    const bf16_t* X; bf16_t* X3; const bf16_t* EU; const float* rstd; const float* g; float* SS;
    __device__ __forceinline__ void operator()(const f32x4 (&acc)[2][2][4][2], const Unit& u, int wr, int wc, int fr, int fq) const {
        const int row0 = u.pm * BM + wr * 64 + fr, col0 = u.pn * BM + wc * 32 + 8 * fq;
        f32x4 gv[2][2];
#pragma unroll
        for (int bj = 0; bj < 2; ++bj) { gv[bj][0] = *(const f32x4*)(g + col0 + bj * HALF); gv[bj][1] = *(const f32x4*)(g + col0 + bj * HALF + 4); }
#pragma unroll
        for (int ai = 0; ai < 2; ++ai)
#pragma unroll
            for (int m = 0; m < 4; ++m) { const int row = EPI_ROWS(ai, m); const size_t off = (size_t)row * 4096 + col0; const float rs = rstd[row]; float s = 0.f;
#pragma unroll
                for (int bj = 0; bj < 2; ++bj) { f32x4 e0, e1; unpack8(*(const u32x4*)(EU + off + bj * HALF), e0, e1);
                    f32x4 x0, x1; unpack8(*(const u32x4*)(X + off + bj * HALF), x0, x1);
                    const f32x4 a0 = acc[ai][bj][m][0], a1 = acc[ai][bj][m][1];
#pragma unroll
                    for (int j = 0; j < 4; ++j) { x0[j] += fsigmoid(a0[j]) * (e0[j] * rs * gv[bj][0][j]); x1[j] += fsigmoid(a1[j]) * (e1[j] * rs * gv[bj][1][j]); }
                    s += (x0[0] * x0[0] + x0[1] * x0[1]) + (x0[2] * x0[2] + x0[3] * x0[3]) + (x1[0] * x1[0] + x1[1] * x1[1]) + (x1[2] * x1[2] + x1[3] * x1[3]);
                    *(u32x4*)(X3 + off + bj * HALF) = pack8(x0, x1); }
                s += __shfl_xor(s, 16); s += __shfl_xor(s, 32);
                if (fq == 0) SS[(size_t)row * 64 + u.pn * 4 + wc] = s; }
    }
};
struct EpiMerge2 {
    static constexpr bool PERM = true, AFTER_DRAIN = false;
    const bf16_t *TA, *TR; bf16_t* O;
    __device__ __forceinline__ void operator()(const f32x4 (&acc)[2][2][4][2], const Unit& u, int wr, int wc, int fr, int fq) const {
        const int colb = u.pn * 128 + wc * 32 + 8 * fq;
#pragma unroll
        for (int ai = 0; ai < 2; ++ai)
#pragma unroll
            for (int m = 0; m < 4; ++m) { const size_t off = (size_t)(u.pm * BM + ai * HALF + wr * 64 + 16 * m + fr) * 4096 + colb;
                f32x4 a0, a1, r0, r1; unpack8(*(const u32x4*)(TA + off), a0, a1); unpack8(*(const u32x4*)(TR + off), r0, r1);
                const f32x4 ga0 = acc[ai][0][m][0], ga1 = acc[ai][0][m][1], gr0 = acc[ai][1][m][0], gr1 = acc[ai][1][m][1];
                f32x4 o0, o1;
#pragma unroll
                for (int j = 0; j < 4; ++j) { o0[j] = fsigmoid(ga0[j]) * a0[j] + fsigmoid(gr0[j]) * r0[j]; o1[j] = fsigmoid(ga1[j]) * a1[j] + fsigmoid(gr1[j]) * r1[j]; }
                *(u32x4*)(O + off) = pack8(o0, o1); }
    }
};
struct EpiAct {
    static constexpr bool PERM = true, AFTER_DRAIN = false;
    const float *cw, *cb; bf16_t *ACT, *YB;
    static __device__ __forceinline__ f32x4 rot(const f32x4 v, const bool left) { f32x4 o;
#pragma unroll
        for (int j = 0; j < 4; ++j) { const float s = v[j]; const int x = __float_as_int(s);
            const int y = left ? __builtin_amdgcn_mov_dpp(x, 0x12F, 0xF, 0xF, true) : __builtin_amdgcn_mov_dpp(x, 0x121, 0xF, 0xF, true);
            o[j] = __int_as_float(y); }
        return o; }
    __device__ __forceinline__ void operator()(const f32x4 (&acc)[2][2][4][2], const Unit& u, int wr, int wc, int fr, int fq) const {
        constexpr int NF = 24576, DF = 12288;
        const int colb = u.pn * 128 + wc * 32 + 8 * fq;
        const bool f0 = fr == 0, f15 = fr == 15;
#pragma unroll
        for (int ai = 0; ai < 2; ++ai) { const int seg = u.pm * 4 + ai * 2 + wr;
            if (f0) {
#pragma unroll
                for (int mm = 0; mm < 2; ++mm) { bf16_t* yb = YB + ((size_t)seg * 4 + mm) * NF + colb; *(u32x4*)yb = pack8(acc[ai][0][mm][0], acc[ai][0][mm][1]); *(u32x4*)(yb + DF) = pack8(acc[ai][1][mm][0], acc[ai][1][mm][1]); } }
            if (f15) {
#pragma unroll
                for (int mm = 2; mm < 4; ++mm) { bf16_t* yb = YB + ((size_t)seg * 4 + mm) * NF + colb; *(u32x4*)yb = pack8(acc[ai][0][mm][0], acc[ai][0][mm][1]); *(u32x4*)(yb + DF) = pack8(acc[ai][1][mm][0], acc[ai][1][mm][1]); } } }
        unsigned pk0[2][4][2];
#pragma unroll
        for (int n = 0; n < 2; ++n) { const int c0 = colb + 4 * n;
            const f32x4 wv0 = *(const f32x4*)(cw + c0), wv1 = *(const f32x4*)(cw + NF + c0), wv2 = *(const f32x4*)(cw + 2 * NF + c0), bv = *(const f32x4*)(cb + c0);
            const f32x4 wg0 = *(const f32x4*)(cw + DF + c0), wg1 = *(const f32x4*)(cw + NF + DF + c0), wg2 = *(const f32x4*)(cw + 2 * NF + DF + c0), bg = *(const f32x4*)(cb + DF + c0);
#pragma unroll
            for (int ai = 0; ai < 2; ++ai) { const int rowb = u.pm * BM + ai * HALF + wr * 64 + 4 * fr;
                const f32x4 Uv = rot(acc[ai][0][3][n], false), Ug = rot(acc[ai][1][3][n], false);
                const f32x4 Dv = rot(acc[ai][0][0][n], true), Dg = rot(acc[ai][1][0][n], true);
#pragma unroll
                for (int m = 0; m < 4; ++m) { const f32x4 v = acc[ai][0][m][n], g = acc[ai][1][m][n];
                    const f32x4 upv = m == 0 ? Uv : acc[ai][0][m == 0 ? 0 : m - 1][n], upg = m == 0 ? Ug : acc[ai][1][m == 0 ? 0 : m - 1][n];
                    const f32x4 dnv = m == 3 ? Dv : acc[ai][0][m == 3 ? 3 : m + 1][n], dng = m == 3 ? Dg : acc[ai][1][m == 3 ? 3 : m + 1][n];
                    f32x4 a;
#pragma unroll
                    for (int j = 0; j < 4; ++j) {
                        const float uv = bv[j] + wv0[j] * upv[j] + wv1[j] * v[j] + wv2[j] * dnv[j], ug = bg[j] + wg0[j] * upg[j] + wg1[j] * g[j] + wg2[j] * dng[j];
                        a[j] = fgelu(ug) * uv; }
                    const unsigned p0 = cvt_pk_bf16(a[0], a[1]), p1 = cvt_pk_bf16(a[2], a[3]);
                    if (n == 0) { pk0[ai][m][0] = p0; pk0[ai][m][1] = p1; }
                    else { const bool fix = (m == 0 && f0) || (m == 3 && f15);
                        if (!fix) { u32x4 w; w.x = pk0[ai][m][0]; w.y = pk0[ai][m][1]; w.z = p0; w.w = p1; *(u32x4*)(ACT + (size_t)(rowb + m) * DF + colb) = w; } } } } }
    }
};
#undef EPI_ROWS

template <class Epi, class Sched, bool ALIGN_EPI = false, bool SP2 = false, bool APERM = false>
__device__ __forceinline__ void gemm_phase(PG8_LAS unsigned char* lds, const Gemm g, const Sched& S, const Epi& E, const int tid) {
    const int wid = __builtin_amdgcn_readfirstlane(tid >> 6), lane = tid & 63, wr = wid >> 2, wc = wid & 3, fr = lane & 15, fq = lane >> 4;
    const int K = g.K, nt = K / BK;
    unsigned voffA[2], voffB[2];
#pragma unroll
    for (int i = 0; i < 2; ++i) { int R, C; stage_rc(tid * 16 + i * 8192, R, C); const int Rb = Epi::PERM ? ((R & ~31) + perm32(R & 31)) : R;
        const int Ra = APERM ? ((R & ~63) | (4 * (R & 15) + ((R >> 4) & 3))) : R;
        voffA[i] = (unsigned)(Ra * K + C) * 2u; voffB[i] = (unsigned)(Rb * K + C) * 2u; }
    const size_t kstep = (size_t)(BK * 2);
    const size_t hstep = (size_t)HALF * K * 2;
    const size_t tstep = 2 * hstep;
    const unsigned ldsw = (unsigned)wid * 1024u;
    const int aoff = lds_byte(wr * 64 + fr, fq * 8), boff = lds_byte(wc * 32 + fr, fq * 8);
#define PG8_SA(b, h) (((b) * 2 + (h)) * HTB)
#define PG8_SB(b, h) ((4 + (b) * 2 + (h)) * HTB)
#define PG8_STAGE(bufoff, gbase, voff) do { _Pragma("unroll") for (int _i = 0; _i < 2; ++_i) \
        __builtin_amdgcn_global_load_lds((const unsigned*)((const char*)(gbase) + (voff)[_i]), (PG8_LAS unsigned*)(lds + (bufoff) + ldsw + _i * 8192), 16, 0, 0); } while (0)
#define PG8_LDA(dst, b, h) do { _Pragma("unroll") for (int m = 0; m < 4; ++m) _Pragma("unroll") for (int k = 0; k < 2; ++k) dst[m][k] = *(const PG8_LAS bf16x8*)(lds + PG8_SA(b, h) + aoff + m * 2048 + k * 1024); } while (0)
#define PG8_LDB(dst, b, h) do { _Pragma("unroll") for (int n = 0; n < 2; ++n) _Pragma("unroll") for (int k = 0; k < 2; ++k) dst[n][k] = *(const PG8_LAS bf16x8*)(lds + PG8_SB(b, h) + boff + n * 2048 + k * 1024); } while (0)
#define PG8_MMA(ai, bj, At, Bt) do { __builtin_amdgcn_s_setprio(1); _Pragma("unroll") for (int m = 0; m < 4; ++m) _Pragma("unroll") for (int n = 0; n < 2; ++n) _Pragma("unroll") for (int k = 0; k < 2; ++k) \
        acc[ai][bj][m][n] = __builtin_amdgcn_mfma_f32_16x16x32_bf16(Bt[n][k], At[m][k], acc[ai][bj][m][n], 0, 0, 0); __builtin_amdgcn_s_setprio(0); } while (0)
#define PG8_WAIT_V(n) asm volatile("s_waitcnt vmcnt(" #n ")" ::: "memory")
#define PG8_WAIT_L(n) asm volatile("s_waitcnt lgkmcnt(" #n ")" ::: "memory")
#define PG8_BAR __builtin_amdgcn_s_barrier()
#define PG8_SCHED __builtin_amdgcn_sched_barrier(0)
    Unit cur, nxt; int ui = 0;
    if (!S.next(0, cur)) return;
    f32x4 acc[2][2][4][2];
#pragma unroll
    for (int a = 0; a < 2; ++a)
#pragma unroll
        for (int b = 0; b < 2; ++b)
#pragma unroll
            for (int m = 0; m < 4; ++m)
#pragma unroll
                for (int n = 0; n < 2; ++n) acc[a][b][m][n] = (f32x4){0.f, 0.f, 0.f, 0.f};
    bf16x8 At[4][2], B0[2][2], B1[2][2];
    const char* cA = (const char*)g.A + (size_t)cur.pm * tstep; const char* cB = (const char*)g.Bt + (size_t)cur.pn * tstep;
    S.a_ready(cur);
    if constexpr (SP2) {
        PG8_STAGE(PG8_SB(0, 0), cB, voffB); PG8_STAGE(PG8_SB(0, 1), cB + hstep, voffB); PG8_STAGE(PG8_SA(0, 0), cA, voffA); PG8_STAGE(PG8_SA(0, 1), cA + hstep, voffA);
        if (wr == 1) PG8_BAR;
        PG8_WAIT_V(2); PG8_BAR;
        PG8_STAGE(PG8_SB(1, 0), cB + kstep, voffB); PG8_STAGE(PG8_SA(1, 0), cA + kstep, voffA); PG8_STAGE(PG8_SB(1, 1), cB + hstep + kstep, voffB);
        PG8_WAIT_V(6); PG8_BAR;
    } else {
        PG8_STAGE(PG8_SB(0, 0), cB, voffB); PG8_STAGE(PG8_SA(0, 0), cA, voffA); PG8_STAGE(PG8_SB(0, 1), cB + hstep, voffB); PG8_STAGE(PG8_SA(0, 1), cA + hstep, voffA);
        if (wr == 1) PG8_BAR;
        PG8_WAIT_V(4); PG8_BAR;
        PG8_STAGE(PG8_SB(1, 0), cB + kstep, voffB); PG8_STAGE(PG8_SA(1, 0), cA + kstep, voffA); PG8_STAGE(PG8_SB(1, 1), cB + hstep + kstep, voffB);
        PG8_WAIT_V(6); PG8_BAR;
    }
    for (;;) {
        const bool has_next = S.next(ui + 1, nxt);
        const char* nA = has_next ? (const char*)g.A + (size_t)nxt.pm * tstep : cA; const char* nB = has_next ? (const char*)g.Bt + (size_t)nxt.pn * tstep : cB;
        for (int t = 0; t < nt; t += 2) {
            const bool last = (t == nt - 2);
            const char* a1 = cA + (size_t)(t + 1) * kstep;
            const char* a2 = last ? nA : cA + (size_t)(t + 2) * kstep; const char* b2 = last ? nB : cB + (size_t)(t + 2) * kstep;
            const char* a3 = a2 + kstep; const char* b3 = b2 + kstep;
            if (last && has_next) S.a_ready(nxt);
            if constexpr (SP2) {
            PG8_LDB(B0, 0, 0); PG8_LDB(B1, 0, 1); PG8_SCHED; PG8_LDA(At, 0, 0); PG8_STAGE(PG8_SA(1, 1), a1 + hstep, voffA);
            PG8_WAIT_V(8); PG8_WAIT_L(0); PG8_BAR; PG8_MMA(0, 0, At, B0); PG8_MMA(0, 1, At, B1); PG8_BAR; PG8_SCHED;
            PG8_LDA(At, 0, 1); PG8_STAGE(PG8_SB(0, 0), b2, voffB); PG8_STAGE(PG8_SB(0, 1), b2 + hstep, voffB); PG8_STAGE(PG8_SA(0, 0), a2, voffA);
            PG8_WAIT_V(8); PG8_WAIT_L(0); PG8_BAR; PG8_MMA(1, 0, At, B0); PG8_MMA(1, 1, At, B1); PG8_BAR; PG8_SCHED;
            PG8_LDB(B0, 1, 0); PG8_LDB(B1, 1, 1); PG8_SCHED; PG8_LDA(At, 1, 0); PG8_STAGE(PG8_SA(0, 1), a2 + hstep, voffA);
            PG8_WAIT_V(8); PG8_WAIT_L(0); PG8_BAR; PG8_MMA(0, 0, At, B0); PG8_MMA(0, 1, At, B1); PG8_BAR; PG8_SCHED;
            PG8_LDA(At, 1, 1); PG8_STAGE(PG8_SB(1, 0), b3, voffB); PG8_STAGE(PG8_SB(1, 1), b3 + hstep, voffB); PG8_STAGE(PG8_SA(1, 0), a3, voffA);
            PG8_WAIT_V(8); PG8_WAIT_L(0); PG8_BAR; PG8_MMA(1, 0, At, B0); PG8_MMA(1, 1, At, B1); PG8_BAR; PG8_SCHED;
            } else {
            PG8_LDB(B0, 0, 0); PG8_SCHED; PG8_LDA(At, 0, 0); PG8_STAGE(PG8_SA(1, 1), a1 + hstep, voffA);
            PG8_WAIT_L(8); PG8_BAR; PG8_WAIT_L(0); PG8_MMA(0, 0, At, B0); PG8_BAR; PG8_SCHED;
            PG8_LDB(B1, 0, 1); PG8_STAGE(PG8_SB(0, 0), b2, voffB);
            PG8_BAR; PG8_WAIT_L(0); PG8_MMA(0, 1, At, B1); PG8_BAR;
            PG8_LDA(At, 0, 1); PG8_STAGE(PG8_SA(0, 0), a2, voffA);
            PG8_BAR; PG8_WAIT_L(0); PG8_MMA(1, 0, At, B0); PG8_BAR; PG8_SCHED;
            PG8_STAGE(PG8_SB(0, 1), b2 + hstep, voffB);
            PG8_WAIT_V(6); PG8_BAR; PG8_MMA(1, 1, At, B1); PG8_BAR;
            PG8_LDB(B0, 1, 0); PG8_SCHED; PG8_LDA(At, 1, 0); PG8_STAGE(PG8_SA(0, 1), a2 + hstep, voffA);
            PG8_WAIT_L(8); PG8_BAR; PG8_WAIT_L(0); PG8_MMA(0, 0, At, B0); PG8_BAR; PG8_SCHED;
            PG8_LDB(B1, 1, 1); PG8_STAGE(PG8_SB(1, 0), b3, voffB);
            PG8_BAR; PG8_WAIT_L(0); PG8_MMA(0, 1, At, B1); PG8_BAR;
            PG8_LDA(At, 1, 1); PG8_STAGE(PG8_SA(1, 0), a3, voffA);
            PG8_BAR; PG8_WAIT_L(0); PG8_MMA(1, 0, At, B0); PG8_BAR; PG8_SCHED;
            PG8_STAGE(PG8_SB(1, 1), b3 + hstep, voffB);
            PG8_WAIT_V(6); PG8_BAR; PG8_MMA(1, 1, At, B1); PG8_BAR;
            }
        }
        if constexpr (ALIGN_EPI) { if (wr == 0) PG8_BAR; }
        if constexpr (!Epi::AFTER_DRAIN) { E(acc, cur, wr, wc, fr, fq); S.done(cur); }
        if (!has_next) break;
#pragma unroll
        for (int a = 0; a < 2; ++a)
#pragma unroll
            for (int b = 0; b < 2; ++b)
#pragma unroll
                for (int m = 0; m < 4; ++m)
#pragma unroll
                    for (int n = 0; n < 2; ++n) acc[a][b][m][n] = (f32x4){0.f, 0.f, 0.f, 0.f};
        cur = nxt; cA = nA; cB = nB; ++ui;
        if constexpr (ALIGN_EPI) { if (wr == 1) PG8_BAR; }
    }
    PG8_WAIT_V(0);
    if constexpr (!ALIGN_EPI) { if (wr == 0) PG8_BAR; }
    PG8_BAR;
    if constexpr (Epi::AFTER_DRAIN) { E.fused(acc, cur, wr, wc, fr, fq, lds, wid, lane); S.done(cur); }
#undef PG8_SA
#undef PG8_SB
#undef PG8_STAGE
#undef PG8_LDA
#undef PG8_LDB
#undef PG8_MMA
#undef PG8_WAIT_V
#undef PG8_WAIT_L
#undef PG8_BAR
#undef PG8_SCHED
}
}

constexpr int NWAVES = 8;
constexpr int D = 4096, M = 32768, SEQ_P = 16384, SEQ_S = 2048;
constexpr int ATTN_W = 2048, KV_W = 512, D_RNN = 4096, D_FF = 12288, PLE = 256, IN_W = 11264;
constexpr int MSB = 8192, NSB = M / MSB;
constexpr int NBOUND = SEQ_P / MSB - 1;
constexpr int LCH = 32, NCHUNK = M / LCH;
constexpr float EPS = 1e-6f;
constexpr float LOG2E = 1.4426950408889634f;

constexpr size_t MiB = 1u << 20;
constexpr size_t WS_CTL = 0, CTL_ZERO_BYTES = 1 * MiB;
constexpr size_t WS_H = 1 * MiB;
constexpr size_t WS_Q = WS_H + 256 * MiB;
constexpr size_t WS_K = WS_Q + 128 * MiB;
constexpr size_t WS_V = WS_K + 32 * MiB;
constexpr size_t WS_REC = WS_V + 32 * MiB;
constexpr size_t WS_G = WS_REC + 256 * MiB;
constexpr size_t WS_MRG = WS_G + 256 * MiB;
constexpr size_t WS_AGG = WS_MRG + 256 * MiB;
constexpr size_t WS_CIN = WS_AGG + 64 * MiB;
constexpr size_t WS_W1 = WS_CIN + 32 * MiB;
constexpr size_t WS_WIN = WS_W1;
constexpr size_t WS_WG = WS_WIN + 88 * MiB;
constexpr size_t WS_WOA = WS_WG + 64 * MiB;
constexpr size_t WS_WOR = WS_WOA + 16 * MiB;
constexpr size_t WS_WOUT = WS_WOR + 32 * MiB;
constexpr size_t WS_LWA = WS_WOUT + 32 * MiB;
constexpr size_t WS_LWX = WS_LWA + 4 * MiB;
constexpr size_t WS_END1 = WS_LWX + 4 * MiB;
constexpr size_t WS_HN2 = 1 * MiB;
constexpr size_t WS_X2B = WS_HN2;
constexpr size_t WS_WUP = WS_HN2 + 256 * MiB;
constexpr size_t WS_WDN = WS_WUP + 192 * MiB;
constexpr size_t WS_WPG = WS_WDN + 96 * MiB;
constexpr size_t WS_WPL = WS_WPG + 32 * MiB;
constexpr size_t WS_PB = WS_WPL + 2 * MiB;
constexpr size_t WS_SS = WS_PB + 16 * MiB;
constexpr size_t WS_RSE = WS_SS + 8 * MiB;
constexpr size_t WS_YB = WS_RSE + 1 * MiB;
constexpr size_t WS_ACT = WS_YB + 96 * MiB;
constexpr size_t WS_END2 = WS_ACT + 768 * MiB;
constexpr size_t WS_EU = WS_ACT;
constexpr size_t WS_X3B = WS_ACT + 256 * MiB;
constexpr size_t WS_NEED = (WS_END1 > WS_END2 ? WS_END1 : WS_END2);
static_assert(WS_NEED <= (size_t)1664 * MiB, "d_ws map exceeds the guaranteed workspace");
constexpr int CW_BAR = 4096;

constexpr int RING_OFF = 0;
#ifndef LRU_PITCH
#define LRU_PITCH 264
#endif
constexpr int LRU_P = LRU_PITCH;
constexpr int L_XCF = 0, L_AS = L_XCF + LCH * LRU_P * 4, L_BS = L_AS + LCH * LRU_P * 4, L_HS = L_BS + LCH * LRU_P * 4, L_XCB = L_HS + LCH * LRU_P * 4, L_END = L_XCB + LCH * LRU_P * 2;
constexpr int VT_PITCH = 816;
constexpr int MISC_OFF = 153600, L_KC = MISC_OFF + 512, LDS_BYTES = L_KC + 6 * 256 * 4;
static_assert(L_END <= MISC_OFF && 128 * VT_PITCH <= MISC_OFF && 131072 <= MISC_OFF, "LDS map");

#define GAS __attribute__((address_space(1)))
#define LAS __attribute__((address_space(3)))
typedef unsigned short bf16;
typedef unsigned v4u __attribute__((ext_vector_type(4)));
typedef unsigned v2u __attribute__((ext_vector_type(2)));
typedef float f32x4 __attribute__((ext_vector_type(4)));
typedef float f32x16 __attribute__((ext_vector_type(16)));
typedef float f32x2 __attribute__((ext_vector_type(2)));
typedef short bf16x8 __attribute__((ext_vector_type(8)));
typedef GAS unsigned gu32;
#define RLX_AGENT __ATOMIC_RELAXED, __HIP_MEMORY_SCOPE_AGENT
#define LDS_WAIT() asm volatile("s_waitcnt lgkmcnt(0)" ::: "memory")
#define VM_WAIT() asm volatile("s_waitcnt vmcnt(0)" ::: "memory")
__device__ __forceinline__ unsigned f2bf(float f) { unsigned u = __builtin_bit_cast(unsigned, f); return (u + 0x7fffu + ((u >> 16) & 1u)) >> 16; }
__device__ __forceinline__ unsigned pk2(float lo, float hi) { return f2bf(lo) | (f2bf(hi) << 16); }
using pg8::fsigmoid; using pg8::fgelu; using pg8::bf_lo; using pg8::bf_hi;

#define XB_TMO      128
#define XB_XCNT(j)  (256  + 64 * (j))
#define XB_XSUB(j)  (1280 + 64 * (j))
#define XB_XGEN(j)  (2304 + 64 * (j))
#define XB_TOP      3328
#define XB_TOPGEN   3392
#define XCD_BAR_WORDS 3456
#define XB_SPIN_CAP (1u << 18)

__device__ __forceinline__ unsigned xb_ld(unsigned* p)              { return __hip_atomic_load(p, __ATOMIC_RELAXED, __HIP_MEMORY_SCOPE_AGENT); }
__device__ __forceinline__ unsigned xb_add(unsigned* p, unsigned v) { return __hip_atomic_fetch_add(p, v, __ATOMIC_RELAXED, __HIP_MEMORY_SCOPE_AGENT); }
__device__ __forceinline__ unsigned xb_xcc_id() { return (unsigned)__builtin_amdgcn_s_getreg((3 << 11) | 20) & 0xFu; }
#define XB_SPIN(cond, bar) do { unsigned _sp = 0; while (cond) { __builtin_amdgcn_s_sleep(1); \
    if ((++_sp & 255u) == 0u) { if (xb_ld(&(bar)[XB_TMO])) break; if (_sp > XB_SPIN_CAP) { atomicAdd(&(bar)[XB_TMO], 1u); break; } } } } while (0)

struct XcdBarrier {
    unsigned* bar; unsigned x;
    volatile LAS unsigned* st;
};

__device__ __forceinline__ XcdBarrier xcd_barrier_post(unsigned* bar, volatile LAS unsigned* st) {
    XcdBarrier b; b.bar = bar; b.x = xb_xcc_id(); b.st = st;
    if (threadIdx.x == 0) (void)xb_add(&bar[XB_XCNT(b.x)], 1u);
    return b;
}
__device__ __forceinline__ void xcd_barrier_complete(unsigned* bar, unsigned x, unsigned& nloc, unsigned& nx) {
    const unsigned G = gridDim.x * gridDim.y * gridDim.z;
    unsigned sum, cnt, mine, sp = 0u;
    for (;;) {
        sum = 0u; cnt = 0u; mine = 0u;
#pragma unroll
        for (unsigned j = 0; j < 16; ++j) { const unsigned c = xb_ld(&bar[XB_XCNT(j)]); sum += c; cnt += (c > 0u) ? 1u : 0u; mine = (j == x) ? c : mine; }
        if (sum == G) break;
        __builtin_amdgcn_s_sleep(1);
        if ((++sp & 255u) == 0u) { if (xb_ld(&bar[XB_TMO])) break; if (sp > XB_SPIN_CAP) { atomicAdd(&bar[XB_TMO], 1u); break; } }
    }
    nloc = mine > 0u ? mine : 1u; nx = cnt > 0u ? cnt : 1u;
}

__device__ __forceinline__ void xcd_barrier(const XcdBarrier& b, const int tid) {
    asm volatile("s_waitcnt vmcnt(0)" ::: "memory");
    __syncthreads();
    if (tid == 0) {
        unsigned* bar = b.bar;
        __builtin_amdgcn_s_waitcnt(0);
        unsigned nloc = b.st[0], nx = b.st[1];
        if (nloc == 0u) { xcd_barrier_complete(bar, b.x, nloc, nx); b.st[0] = nloc; b.st[1] = nx; }
        const unsigned old = xb_add(&bar[XB_XSUB(b.x)], 1u);
        const unsigned gen = old / nloc;
        if (old + 1u == (gen + 1u) * nloc) {
            __builtin_amdgcn_fence(__ATOMIC_RELEASE, "agent");
            asm volatile("s_waitcnt vmcnt(0)" ::: "memory");
            const unsigned og = xb_add(&bar[XB_TOP], 1u);
            const unsigned tg = og / nx;
            if (og + 1u == (tg + 1u) * nx) xb_add(&bar[XB_TOPGEN], 1u);
            else XB_SPIN(xb_ld(&bar[XB_TOPGEN]) == tg, bar);
            __builtin_amdgcn_fence(__ATOMIC_ACQUIRE, "agent");
            xb_add(&bar[XB_XGEN(b.x)], 1u);
            asm volatile("s_waitcnt vmcnt(0)" ::: "memory");
        } else {
            XB_SPIN(xb_ld(&bar[XB_XGEN(b.x)]) == gen, bar);
            __builtin_amdgcn_fence(__ATOMIC_ACQUIRE, "agent");
            asm volatile("s_waitcnt vmcnt(0)" ::: "memory");
        }
    }
    __syncthreads();
}

struct Frame {
    LAS unsigned char* lds;
    volatile LAS unsigned* MISC;
    gu32* ctl;
    int tid, lane, wave;
    int vcu, G;
};
__device__ __forceinline__ float wave_sum(float v) {
#pragma unroll
    for (int o = 1; o < 64; o <<= 1) v += __shfl_xor(v, o);
    return v;
}
__device__ __forceinline__ void seq_bounds(int row, int& s0, int& s1) { if (row < SEQ_P) { s0 = 0; s1 = SEQ_P; } else { s0 = row & ~(SEQ_S - 1); s1 = s0 + SEQ_S; } }

__device__ __forceinline__ void tr_load(const float* src, int N, int lane, float (&v)[32]) {
#pragma unroll
    for (int i = 0; i < 32; ++i) v[i] = src[(size_t)(2 * i + (lane >> 5)) * N + (lane & 31)];
}
__device__ __forceinline__ void tr_store(const float (&v)[32], bf16* dst, int K, LAS float* scr, int lane) {
#pragma unroll
    for (int i = 0; i < 32; ++i) scr[(2 * i + (lane >> 5)) * 33 + (lane & 31)] = v[i];
    LDS_WAIT(); asm volatile("" ::: "memory");
    const int c = lane & 7;
#pragma unroll
    for (int j = 0; j < 4; ++j) { const int n = (lane >> 3) + 8 * j; const LAS float* s = scr + (8 * c) * 33 + n;
        v4u o; o.x = pk2(s[0 * 33], s[1 * 33]); o.y = pk2(s[2 * 33], s[3 * 33]); o.z = pk2(s[4 * 33], s[5 * 33]); o.w = pk2(s[6 * 33], s[7 * 33]);
        *(GAS v4u*)(dst + (size_t)n * K + 8 * c) = o; }
    LDS_WAIT(); asm volatile("" ::: "memory");
}
__device__ __forceinline__ void convert_weight(Frame& F, const float* W, int K, int N, int nmat, bf16* WT) {
    LAS float* scr = (LAS float*)(F.lds + RING_OFF + F.wave * 16384);
    const int gw = F.vcu * NWAVES + F.wave, NGW = F.G * NWAVES, lane = F.lane;
    const int nblk = N / 32, per = (K / 64) * nblk, total = per * nmat;
#define CW_SRC(it) (W + (size_t)((it) / per) * K * N + (size_t)(64 * (((it) % per) / nblk)) * N + 32 * (((it) % per) % nblk))
#define CW_DST(it) (WT + (size_t)((it) / per) * K * N + (size_t)(32 * (((it) % per) % nblk)) * K + 64 * (((it) % per) / nblk))
    float cur[32], nxt[32];
    int it = gw; if (it < total) tr_load(CW_SRC(it), N, lane, cur);
    for (; it < total; it += NGW) { const int nit = it + NGW;
        if (nit < total) tr_load(CW_SRC(nit), N, lane, nxt);
        tr_store(cur, CW_DST(it), K, scr, lane);
#pragma unroll
        for (int i = 0; i < 32; ++i) cur[i] = nxt[i]; }
#undef CW_SRC
#undef CW_DST
}
__device__ __forceinline__ void rms_brow_to_bf16(const bf16* xrow, const float* g, bf16* orow, int lane) {
    const GAS v4u* xr = (const GAS v4u*)xrow + lane;
    v4u v[8]; float s = 0.f;
#pragma unroll
    for (int j = 0; j < 8; ++j) { v[j] = xr[64 * j];
        const float a0 = bf_lo(v[j].x), a1 = bf_hi(v[j].x), a2 = bf_lo(v[j].y), a3 = bf_hi(v[j].y), a4 = bf_lo(v[j].z), a5 = bf_hi(v[j].z), a6 = bf_lo(v[j].w), a7 = bf_hi(v[j].w);
        s += ((a0 * a0 + a1 * a1) + (a2 * a2 + a3 * a3)) + ((a4 * a4 + a5 * a5) + (a6 * a6 + a7 * a7)); }
    const float rstd = 1.0f / sqrtf(wave_sum(s) * (1.f / D) + EPS);
    const GAS f32x4* gr = (const GAS f32x4*)g + 2 * lane;
    GAS v4u* o8 = (GAS v4u*)orow + lane;
#pragma unroll
    for (int j = 0; j < 8; ++j) { const f32x4 g0 = gr[128 * j], g1 = gr[128 * j + 1]; v4u w;
        w.x = pk2(bf_lo(v[j].x) * rstd * g0.x, bf_hi(v[j].x) * rstd * g0.y); w.y = pk2(bf_lo(v[j].y) * rstd * g0.z, bf_hi(v[j].y) * rstd * g0.w);
        w.z = pk2(bf_lo(v[j].z) * rstd * g1.x, bf_hi(v[j].z) * rstd * g1.y); w.w = pk2(bf_lo(v[j].w) * rstd * g1.z, bf_hi(v[j].w) * rstd * g1.w); o8[64 * j] = w; }
}
__device__ __forceinline__ void rms_row_to_bf16(const float* xrow, const float* g, bf16* orow, int lane) {
    const GAS f32x4* xr = (const GAS f32x4*)xrow + lane;
    f32x4 v[16]; float s = 0.f;
#pragma unroll
    for (int j = 0; j < 16; ++j) { v[j] = xr[64 * j]; s += (v[j].x * v[j].x + v[j].y * v[j].y) + (v[j].z * v[j].z + v[j].w * v[j].w); }
    const float rstd = 1.0f / sqrtf(wave_sum(s) * (1.f / D) + EPS);
    const GAS f32x4* gr = (const GAS f32x4*)g + lane;
    GAS v2u* o8 = (GAS v2u*)orow + lane;
#pragma unroll
    for (int j = 0; j < 16; ++j) { const f32x4 gv = gr[64 * j]; v2u w; w.x = pk2(v[j].x * rstd * gv.x, v[j].y * rstd * gv.y); w.y = pk2(v[j].z * rstd * gv.z, v[j].w * rstd * gv.w); o8[64 * j] = w; }
}

__device__ __forceinline__ void attn_unit(Frame& F, const bf16* Qb, const bf16* Kb, const bf16* Vb, bf16* Ob, const float* sink, int qblk, int hkv) {
    LAS unsigned char* lds = F.lds;
    const int lane = F.lane, wave = F.wave;
    const int row_blk = qblk * 128; int s0, s1; seq_bounds(row_blk, s0, s1);
    const int kbase = row_blk - 128;
    __syncthreads();
#pragma unroll
    for (int oo = 0; oo < 2; ++oo) { const int o = 2 * wave + oo;
#pragma unroll
        for (int j = 0; j < 4; ++j) { const int kp = lane + 64 * j;
            if (kp < 200) { const int r0 = kbase + 2 * kp;
                v4u a = (v4u){0u, 0u, 0u, 0u}, b = a;
                if (r0 >= s0 && r0 < s1) { a = *(const GAS v4u*)(Vb + (size_t)r0 * KV_W + hkv * 128 + 8 * o); b = *(const GAS v4u*)(Vb + (size_t)(r0 + 1) * KV_W + hkv * 128 + 8 * o); }
                LAS unsigned char* dst = lds + (8 * o) * VT_PITCH + 4 * kp;
                *(LAS unsigned*)(dst + 0 * VT_PITCH) = (a.x & 0xffffu) | (b.x << 16);
                *(LAS unsigned*)(dst + 1 * VT_PITCH) = (a.x >> 16) | (b.x & 0xffff0000u);
                *(LAS unsigned*)(dst + 2 * VT_PITCH) = (a.y & 0xffffu) | (b.y << 16);
                *(LAS unsigned*)(dst + 3 * VT_PITCH) = (a.y >> 16) | (b.y & 0xffff0000u);
                *(LAS unsigned*)(dst + 4 * VT_PITCH) = (a.z & 0xffffu) | (b.z << 16);
                *(LAS unsigned*)(dst + 5 * VT_PITCH) = (a.z >> 16) | (b.z & 0xffff0000u);
                *(LAS unsigned*)(dst + 6 * VT_PITCH) = (a.w & 0xffffu) | (b.w << 16);
                *(LAS unsigned*)(dst + 7 * VT_PITCH) = (a.w >> 16) | (b.w & 0xffff0000u);
            } } }
    __syncthreads();
    const int qn = lane & 15, quad = lane >> 4;
    const int r0q = row_blk + 16 * wave, ks = r0q - 128, tq = r0q + qn;
    for (int g = 0; g < 4; ++g) {
        const int hq = hkv * 4 + g;
        bf16x8 qf[4];
#pragma unroll
        for (int kk = 0; kk < 4; ++kk) qf[kk] = *(const GAS bf16x8*)(Qb + (size_t)tq * ATTN_W + hq * 128 + 32 * kk + 8 * quad);
        f32x4 s[18];
#define ATT_SB __builtin_amdgcn_sched_barrier(0)
#define ATT_KLOAD(buf, b) do { _Pragma("unroll") for (int tt = 0; tt < 2; ++tt) { int krow = ks + 16 * (2 * (b) + tt) + qn; krow = krow < 0 ? 0 : (krow > M - 1 ? M - 1 : krow); \
            const bf16* kp = Kb + (size_t)krow * KV_W + hkv * 128 + 8 * quad; _Pragma("unroll") for (int kk = 0; kk < 4; ++kk) buf[tt][kk] = *(const GAS bf16x8*)(kp + 32 * kk); } } while (0)
#define ATT_KMMA(buf, b) do { _Pragma("unroll") for (int tt = 0; tt < 2; ++tt) { f32x4 acc = (f32x4){0.f, 0.f, 0.f, 0.f}; \
            _Pragma("unroll") for (int kk = 0; kk < 4; ++kk) acc = __builtin_amdgcn_mfma_f32_16x16x32_bf16(buf[tt][kk], qf[kk], acc, 0, 0, 0); s[2 * (b) + tt] = acc; } } while (0)
        bf16x8 ka[2][4], kb2[2][4];
        ATT_KLOAD(ka, 0); ATT_SB;
        ATT_KLOAD(kb2, 1); ATT_SB; ATT_KMMA(ka, 0); ATT_SB;
        ATT_KLOAD(ka, 2); ATT_SB; ATT_KMMA(kb2, 1); ATT_SB;
        ATT_KLOAD(kb2, 3); ATT_SB; ATT_KMMA(ka, 2); ATT_SB;
        ATT_KLOAD(ka, 4); ATT_SB; ATT_KMMA(kb2, 3); ATT_SB;
        ATT_KLOAD(kb2, 5); ATT_SB; ATT_KMMA(ka, 4); ATT_SB;
        ATT_KLOAD(ka, 6); ATT_SB; ATT_KMMA(kb2, 5); ATT_SB;
        ATT_KLOAD(kb2, 7); ATT_SB; ATT_KMMA(ka, 6); ATT_SB;
        ATT_KLOAD(ka, 8); ATT_SB; ATT_KMMA(kb2, 7); ATT_SB;
        ATT_KMMA(ka, 8); ATT_SB;
#undef ATT_KLOAD
#undef ATT_KMMA
        const float slope2 = exp2f(-0.5f * (float)(hq + 1)) * LOG2E, sink2 = sink[hq] * LOG2E;
        float mx = -3.0e38f;
        int kso = ks; asm volatile("" : "+v"(kso));
#pragma unroll
        for (int t = 0; t < 18; ++t)
#pragma unroll
            for (int r = 0; r < 4; ++r) { const int tk = kso + 16 * t + 4 * quad + r; int dist = tq - tk; dist = dist < 0 ? -dist : dist;
                const bool ok = (dist <= 128) && (tk >= s0) && (tk < s1);
                const float v = ok ? s[t][r] - slope2 * (float)dist : -1.0e30f; s[t][r] = v; mx = fmaxf(mx, v); }
        mx = fmaxf(mx, __shfl_xor(mx, 16)); mx = fmaxf(mx, __shfl_xor(mx, 32)); mx = fmaxf(mx, sink2);
        float l = 0.f;
#pragma unroll
        for (int t = 0; t < 18; ++t)
#pragma unroll
            for (int r = 0; r < 4; ++r) { const float p = __builtin_amdgcn_exp2f(s[t][r] - mx); s[t][r] = p; l += p; }
        l += __shfl_xor(l, 16); l += __shfl_xor(l, 32); l += __builtin_amdgcn_exp2f(sink2 - mx);
        const float inv = 1.0f / l;
        f32x4 o[8];
#pragma unroll
        for (int dt = 0; dt < 8; ++dt) o[dt] = (f32x4){0.f, 0.f, 0.f, 0.f};
#define ATT_VLOAD(j) do { _Pragma("unroll") for (int dt = 0; dt < 8; ++dt) { const LAS unsigned char* vp = lds + (16 * dt + qn) * VT_PITCH + 2 * (16 * wave + 32 * (j) + 4 * quad); \
            const v2u v0 = *(const LAS v2u*)vp, v1 = *(const LAS v2u*)(vp + 32); v4u vw; vw.x = v0.x; vw.y = v0.y; vw.z = v1.x; vw.w = v1.y; vf[dt] = __builtin_bit_cast(bf16x8, vw); } } while (0)
        bf16x8 vf[8];
        ATT_VLOAD(0); ATT_SB;
#pragma unroll
        for (int j = 0; j < 9; ++j) {
            v4u pw; pw.x = pg8::cvt_pk_bf16(s[2 * j][0], s[2 * j][1]); pw.y = pg8::cvt_pk_bf16(s[2 * j][2], s[2 * j][3]); pw.z = pg8::cvt_pk_bf16(s[2 * j + 1][0], s[2 * j + 1][1]); pw.w = pg8::cvt_pk_bf16(s[2 * j + 1][2], s[2 * j + 1][3]);
            const bf16x8 pb = __builtin_bit_cast(bf16x8, pw);
            ATT_SB;
#pragma unroll
            for (int dt = 0; dt < 8; ++dt) o[dt] = __builtin_amdgcn_mfma_f32_16x16x32_bf16(vf[dt], pb, o[dt], 0, 0, 0);
            ATT_SB;
            if (j < 8) { ATT_VLOAD(j + 1); ATT_SB; } }
#undef ATT_VLOAD
#undef ATT_SB
#pragma unroll
        for (int dt = 0; dt < 8; ++dt) { v2u w; w.x = pg8::cvt_pk_bf16(o[dt][0] * inv, o[dt][1] * inv); w.y = pg8::cvt_pk_bf16(o[dt][2] * inv, o[dt][3] * inv);
            *(GAS v2u*)(Ob + (size_t)tq * ATTN_W + hq * 128 + 16 * dt + 4 * quad) = w; }
    }
}

__device__ __forceinline__ void unpack_row(const v4u x, float (&o)[8]) { o[0] = bf_lo(x.x); o[1] = bf_hi(x.x); o[2] = bf_lo(x.y); o[3] = bf_hi(x.y); o[4] = bf_lo(x.z); o[5] = bf_hi(x.z); o[6] = bf_lo(x.w); o[7] = bf_hi(x.w); }
__device__ __forceinline__ void load8f(const float* p, float (&o)[8]) { const f32x4 a = *(const GAS f32x4*)p, b = *(const GAS f32x4*)(p + 4); o[0] = a.x; o[1] = a.y; o[2] = a.z; o[3] = a.w; o[4] = b.x; o[5] = b.y; o[6] = b.z; o[7] = b.w; }
__device__ __forceinline__ v4u xr_row(const bf16* XR, int r, int s0, int s1, int c0) { if (r < s0 || r >= s1) return (v4u){0u, 0u, 0u, 0u}; return *(const GAS v4u*)(XR + (size_t)r * D_RNN + c0); }
__device__ __forceinline__ void conv_phase(Frame& F, const bf16* XR, const float* cw, const float* cb, bf16* XC) {
    const int gt = (F.vcu * NWAVES + F.wave) * 64 + F.lane, NGT = F.G * NWAVES * 64;
    constexpr int NOCT = D_RNN / 8, RUN = 32;
    for (int it = gt; it < (M / RUN) * NOCT; it += NGT) { const int oc = it % NOCT, run = it / NOCT, c0 = 8 * oc, t0 = run * RUN;
        int s0, s1; seq_bounds(t0, s0, s1);
        float w[4][8], bias[8];
#pragma unroll
        for (int k = 0; k < 4; ++k) load8f(cw + (size_t)k * D_RNN + c0, w[k]);
        load8f(cb + c0, bias);
        float xm[8], x0[8], x1[8];
        unpack_row(xr_row(XR, t0 - 1, s0, s1, c0), xm); unpack_row(xr_row(XR, t0, s0, s1, c0), x0); unpack_row(xr_row(XR, t0 + 1, s0, s1, c0), x1);
        for (int i = 0; i < RUN; i += 4) { v4u pv[4];
#pragma unroll
            for (int q = 0; q < 4; ++q) pv[q] = xr_row(XR, t0 + i + q + 2, s0, s1, c0);
#pragma unroll
            for (int q = 0; q < 4; ++q) { float x2[8], o[8]; unpack_row(pv[q], x2);
#pragma unroll
                for (int e = 0; e < 8; ++e) { o[e] = bias[e] + w[0][e] * xm[e] + w[1][e] * x0[e] + w[2][e] * x1[e] + w[3][e] * x2[e]; xm[e] = x0[e]; x0[e] = x1[e]; x1[e] = x2[e]; }
                v4u pw; pw.x = pk2(o[0], o[1]); pw.y = pk2(o[2], o[3]); pw.z = pk2(o[4], o[5]); pw.w = pk2(o[6], o[7]);
                *(GAS v4u*)(XC + (size_t)(t0 + i + q) * D_RNN + c0) = pw; } }
    }
}
__device__ __forceinline__ void conv_fix_phase(Frame& F, const bf16* XB, const float* cw, const float* cb, bf16* XC) {
    const int gt = (F.vcu * NWAVES + F.wave) * 64 + F.lane, NGT = F.G * NWAVES * 64;
    constexpr int NOCT = D_RNN / 8;
    for (int it = gt; it < (M / 64) * 3 * NOCT; it += NGT) { const int oc = it % NOCT, q = (it / NOCT) % 3, seg = it / (3 * NOCT), c0 = 8 * oc, t = seg * 64 + (q == 0 ? 0 : 61 + q);
        int s0, s1; seq_bounds(t, s0, s1);
        float o[8]; load8f(cb + c0, o);
#pragma unroll
        for (int k = 0; k < 4; ++k) { const int tt = t - 1 + k;
            if (tt >= s0 && tt < s1) { const int sg = tt >> 6, rr = tt & 63, slot = rr < 3 ? rr : rr - 58; float x[8], w[8];
                unpack_row(*(const GAS v4u*)(XB + ((size_t)sg * 6 + slot) * D_RNN + c0), x); load8f(cw + (size_t)k * D_RNN + c0, w);
#pragma unroll
                for (int e = 0; e < 8; ++e) o[e] += w[e] * x[e]; } }
        v4u pw; pw.x = pk2(o[0], o[1]); pw.y = pk2(o[2], o[3]); pw.z = pk2(o[4], o[5]); pw.w = pk2(o[6], o[7]);
        *(GAS v4u*)(XC + (size_t)t * D_RNN + c0) = pw; }
}
__device__ __forceinline__ void lru_load_b(bf16x8 (&wb)[32], const bf16* WA, const bf16* WX, int dir, int n, int wave, int lane) {
    const size_t o = ((size_t)((dir * 16 + n) * 8 + wave) * 16 * 64 + lane) * 8;
#pragma unroll
    for (int kk = 0; kk < 16; ++kk) { wb[kk] = *(const GAS bf16x8*)(WA + o + (size_t)kk * 512); wb[16 + kk] = *(const GAS bf16x8*)(WX + o + (size_t)kk * 512); }
}
__device__ __forceinline__ void convert_lru_weight(Frame& F, const float* W, bf16* WT) {
    const int gt = (F.vcu * NWAVES + F.wave) * 64 + F.lane, NGT = F.G * NWAVES * 64;
    for (int it = gt; it < 32 * 8 * 16 * 64; it += NGT) { const int lane = it & 63, kk = (it >> 6) & 15, w = (it >> 10) & 7, mat = it >> 13;
        const int d = 32 * w + (lane & 31), c0 = 16 * kk + 8 * (lane >> 5); const float* src = W + ((size_t)mat * 256 + c0) * 256 + d;
        const float sc = -LOG2E;
        v4u o; o.x = pk2(sc * src[0], sc * src[256]); o.y = pk2(sc * src[512], sc * src[768]); o.z = pk2(sc * src[1024], sc * src[1280]); o.w = pk2(sc * src[1536], sc * src[1792]);
        *(GAS v4u*)(WT + (size_t)it * 8) = o; }
}
template <int DIR, bool WANT_H>
__device__ __forceinline__ void lane_scan(const f32x16& a, const f32x16& b, int hs, float cin, float& Ptot, float& Hfin, f32x16& hout) {
    float P[4], Hh[4], Pp[4], Hp[4], cown[4];
#pragma unroll
    for (int g = 0; g < 4; ++g) { float p = 1.f, hh = 0.f;
#pragma unroll
        for (int jj = 0; jj < 4; ++jj) { const int i = 4 * g + (DIR ? 3 - jj : jj); hh = a[i] * hh + b[i]; p *= a[i]; }
        P[g] = p; Hh[g] = hh; }
#pragma unroll
    for (int g = 0; g < 4; ++g) { Pp[g] = __shfl_xor(P[g], 32); Hp[g] = __shfl_xor(Hh[g], 32); }
    float cst = cin, ptot = 1.f;
#pragma unroll
    for (int gg = 0; gg < 4; ++gg) { const int g = DIR ? 3 - gg : gg;
        const float Pe = hs ? Pp[g] : P[g], He = hs ? Hp[g] : Hh[g];
        const float Po = hs ? P[g] : Pp[g], Ho = hs ? Hh[g] : Hp[g];
        float ce, co;
        if (!DIR) { ce = cst; cst = Pe * cst + He; co = cst; cst = Po * cst + Ho; }
        else { co = cst; cst = Po * cst + Ho; ce = cst; cst = Pe * cst + He; }
        cown[g] = hs ? co : ce; ptot *= Pe * Po; }
    Ptot = ptot; Hfin = cst;
    if (WANT_H) {
#pragma unroll
        for (int g = 0; g < 4; ++g) { float hc = cown[g];
#pragma unroll
            for (int jj = 0; jj < 4; ++jj) { const int i = 4 * g + (DIR ? 3 - jj : jj); hc = a[i] * hc + b[i]; hout[i] = hc; } }
    }
}
struct LruArgs { const bf16 *XC, *YR; const bf16 *WA, *WX; const float *ba, *bx, *lam; float* AGG; const float* CIN; bf16 *TMPH, *REC; };
constexpr int LT_PITCH = 528, LT_BYTES = 32 * LT_PITCH;
template <bool FINAL, int DIR, int NJ>
__device__ __forceinline__ void lru_dir_pass(Frame& F, const LruArgs& A, int n, int cbase, float hin, float& Pacc, float& Hacc) {
    LAS unsigned char* lds = F.lds;
    const int tid = F.tid, lane = F.lane, wave = F.wave, cl = lane & 31, hs = lane >> 5;
    const int chb = n * 256, ch = chb + 32 * wave + cl;
    const int trow = tid >> 4, tseg = tid & 15;
    bf16x8 wb[32]; lru_load_b(wb, A.WA, A.WX, DIR, n, wave, lane);
    const float bav = -LOG2E * A.ba[DIR * D_RNN + ch], bxv = -LOG2E * A.bx[DIR * D_RNN + ch], c2 = (-8.0f * LOG2E) * log1pf(expf(-A.lam[DIR * D_RNN + ch]));
#define LRU_CHUNK(jj) (cbase + (DIR ? NJ - 1 - (jj) : (jj)))
    float hstate = hin, pacc = 1.f;
    v4u tp0;
    __syncthreads();
#pragma unroll 1
    for (int c = 0; c < 4; ++c) { const bf16* src = A.XC + (size_t)(LRU_CHUNK(c) * LCH + trow) * D_RNN + chb + 16 * tseg; tp0 = *(const GAS v4u*)src; *(LAS v4u*)(lds + c * LT_BYTES + trow * LT_PITCH + 32 * tseg) = tp0; tp0 = *(const GAS v4u*)(src + 8); *(LAS v4u*)(lds + c * LT_BYTES + trow * LT_PITCH + 32 * tseg + 16) = tp0; }
    for (int j = 0; j < NJ; ++j) { const int chunk = LRU_CHUNK(j), row0 = chunk * LCH;
        LAS unsigned char* T = lds + (j & 7) * LT_BYTES;
        if ((j & 3) == 0) __syncthreads();
        const bf16* nsrc = A.XC + (size_t)(LRU_CHUNK(j + 4) * LCH + trow) * D_RNN + chb + 16 * tseg; LAS unsigned char* Tn = lds + ((j + 4) & 7) * LT_BYTES + trow * LT_PITCH + 32 * tseg;
        if (j + 4 < NJ) tp0 = *(const GAS v4u*)nsrc;
        const float cin = hstate;
        v4u th0, th1; const size_t tmo = ((size_t)((chunk * 16 + n) * 8 + wave) * 2) * 512 + lane * 8;
        if (FINAL && DIR == 1) { th0 = *(const GAS v4u*)(A.TMPH + tmo); th1 = *(const GAS v4u*)(A.TMPH + tmo + 512); }
        f32x16 acca, accx;
#pragma unroll
        for (int i = 0; i < 16; ++i) { acca[i] = 0.f; accx[i] = 0.f; }
#pragma unroll
        for (int kk = 0; kk < 16; ++kk) { const bf16x8 af = *(const LAS bf16x8*)(T + cl * LT_PITCH + (16 * kk + 8 * hs) * 2);
            acca = __builtin_amdgcn_mfma_f32_32x32x16_bf16(af, wb[kk], acca, 0, 0, 0);
            accx = __builtin_amdgcn_mfma_f32_32x32x16_bf16(af, wb[16 + kk], accx, 0, 0, 0); }
        if (j + 4 < NJ) { *(LAS v4u*)Tn = tp0; tp0 = *(const GAS v4u*)(nsrc + 8); }
        unsigned short yv[16];
        if (FINAL && DIR == 1) {
#pragma unroll
            for (int i = 0; i < 16; ++i) yv[i] = A.YR[(size_t)(row0 + (i & 3) + 8 * (i >> 2) + 4 * hs) * D_RNN + ch]; }
#pragma unroll
        for (int i = 0; i < 16; ++i) { const float xcv = bf_lo((unsigned)*(const LAS unsigned short*)(T + ((i & 3) + 8 * (i >> 2) + 4 * hs) * LT_PITCH + (32 * wave + cl) * 2));
            const float r = __builtin_amdgcn_rcpf(1.0f + __builtin_amdgcn_exp2f(acca[i] + bav)), ig = __builtin_amdgcn_rcpf(1.0f + __builtin_amdgcn_exp2f(accx[i] + bxv));
            const float a = __builtin_amdgcn_exp2f(c2 * r), em = __builtin_fmaf(-a, a, 1.0f);
            acca[i] = a; accx[i] = __builtin_amdgcn_sqrtf(em) * ig * xcv; }
        float Ptot, Hfin; f32x16 hv;
        lane_scan<DIR, FINAL>(acca, accx, hs, cin, Ptot, Hfin, hv);
        hstate = Hfin; pacc *= Ptot;
        if (!FINAL) { }
        else if (DIR == 0) {
            v4u o0, o1; o0.x = pg8::cvt_pk_bf16(hv[0], hv[1]); o0.y = pg8::cvt_pk_bf16(hv[2], hv[3]); o0.z = pg8::cvt_pk_bf16(hv[4], hv[5]); o0.w = pg8::cvt_pk_bf16(hv[6], hv[7]);
            o1.x = pg8::cvt_pk_bf16(hv[8], hv[9]); o1.y = pg8::cvt_pk_bf16(hv[10], hv[11]); o1.z = pg8::cvt_pk_bf16(hv[12], hv[13]); o1.w = pg8::cvt_pk_bf16(hv[14], hv[15]);
            *(GAS v4u*)(A.TMPH + tmo) = o0; *(GAS v4u*)(A.TMPH + tmo + 512) = o1;
        } else {
            float hfv[16]; hfv[0] = bf_lo(th0.x); hfv[1] = bf_hi(th0.x); hfv[2] = bf_lo(th0.y); hfv[3] = bf_hi(th0.y); hfv[4] = bf_lo(th0.z); hfv[5] = bf_hi(th0.z); hfv[6] = bf_lo(th0.w); hfv[7] = bf_hi(th0.w);
            hfv[8] = bf_lo(th1.x); hfv[9] = bf_hi(th1.x); hfv[10] = bf_lo(th1.y); hfv[11] = bf_hi(th1.y); hfv[12] = bf_lo(th1.z); hfv[13] = bf_hi(th1.z); hfv[14] = bf_lo(th1.w); hfv[15] = bf_hi(th1.w);
#pragma unroll
            for (int i = 0; i < 16; i += 2) { const size_t go = (size_t)(row0 + (i & 3) + 8 * (i >> 2) + 4 * hs) * D_RNN + ch;
                const unsigned pk = pg8::cvt_pk_bf16((hfv[i] + hv[i]) * fgelu(bf_lo((unsigned)yv[i])), (hfv[i + 1] + hv[i + 1]) * fgelu(bf_lo((unsigned)yv[i + 1])));
                A.REC[go] = (bf16)pk; A.REC[go + D_RNN] = (bf16)(pk >> 16); } }
        if (j + 4 < NJ) *(LAS v4u*)(Tn + 16) = tp0;
    }
    Pacc = pacc; Hacc = hstate;
#undef LRU_CHUNK
}
template <bool FINAL>
__device__ __forceinline__ void lru_phase(Frame& F, const LruArgs& A) {
    const int lane = F.lane, wave = F.wave, cl = lane & 31;
    for (int vb = blockIdx.x; vb < 256; vb += F.G) { const int n = vb >> 4, sub = vb & 15, ch = n * 256 + 32 * wave + cl;
        if (!FINAL) {
            const int cbase = sub * 32; float P, Hh;
            lru_dir_pass<false, 0, 32>(F, A, n, cbase, 0.f, P, Hh); if (lane < 32) *(GAS f32x2*)(A.AGG + ((size_t)(0 * 16 + sub) * D_RNN + ch) * 2) = (f32x2){P, Hh};
            lru_dir_pass<false, 1, 32>(F, A, n, cbase, 0.f, P, Hh); if (lane < 32) *(GAS f32x2*)(A.AGG + ((size_t)(1 * 16 + sub) * D_RNN + ch) * 2) = (f32x2){P, Hh};
        } else {
            const int cbase = sub < 8 ? sub * 64 : (SEQ_P / LCH) + (sub - 8) * 64;
            float hf = 0.f, hb = 0.f, P, Hh;
            if (sub < 8) {
                for (int q = 0; q < 2 * sub; ++q) { const f32x2 ab = *(const GAS f32x2*)(A.AGG + ((size_t)(0 * 16 + q) * D_RNN + ch) * 2); hf = ab.x * hf + ab.y; }
                for (int q = 15; q >= 2 * sub + 2; --q) { const f32x2 ab = *(const GAS f32x2*)(A.AGG + ((size_t)(1 * 16 + q) * D_RNN + ch) * 2); hb = ab.x * hb + ab.y; } }
            lru_dir_pass<true, 0, 64>(F, A, n, cbase, hf, P, Hh);
            lru_dir_pass<true, 1, 64>(F, A, n, cbase, hb, P, Hh);
        } }
}
__device__ __forceinline__ void lru_carry(Frame& F, const float* AGG, float* CIN) {
    const int gt = (F.vcu * NWAVES + F.wave) * 64 + F.lane, NGT = F.G * NWAVES * 64;
    for (int idx = gt; idx < 2 * 9 * D_RNN; idx += NGT) {
        const int ch = idx & (D_RNN - 1), sq = (idx >> 12) % 9, dir = idx / (9 * D_RNN);
        const int c0 = sq == 0 ? 0 : (SEQ_P / LCH) + (sq - 1) * (SEQ_S / LCH), nc = sq == 0 ? SEQ_P / LCH : SEQ_S / LCH;
        float h = 0.f;
#pragma unroll 32
        for (int i = 0; i < nc; ++i) { const int c = dir ? c0 + nc - 1 - i : c0 + i; const size_t o = (size_t)(dir * NCHUNK + c) * D_RNN + ch;
            const f32x2 ab = *(const GAS f32x2*)(AGG + o * 2); CIN[o] = h; h = ab.x * h + ab.y; }
    }
}

template <int NH>
__device__ __forceinline__ void convert_weight_il(Frame& F, const float* W, bf16* WT) {
    LAS float* scr = (LAS float*)(F.lds + RING_OFF + F.wave * 16384);
    const int gw = F.vcu * NWAVES + F.wave, NGW = F.G * NWAVES, lane = F.lane;
    constexpr int K = D, N = 2 * NH, nblk = N / 32;
    constexpr int total = (K / 64) * nblk;
#define CI_SRC(it) (W + (size_t)(64 * ((it) / nblk)) * N + 32 * ((it) % nblk))
    float cur[32], nxt[32];
    int it = gw; if (it < total) tr_load(CI_SRC(it), N, lane, cur);
    for (; it < total; it += NGW) { const int nit = it + NGW, k0 = 64 * (it / nblk), n0 = 32 * (it % nblk);
        const int nv = n0 < NH ? n0 : n0 - NH, d0 = 256 * (nv / 128) + (n0 < NH ? 0 : 128) + (nv % 128);
        if (nit < total) tr_load(CI_SRC(nit), N, lane, nxt);
        tr_store(cur, WT + (size_t)d0 * K + k0, K, scr, lane);
#pragma unroll
        for (int i = 0; i < 32; ++i) cur[i] = nxt[i]; }
#undef CI_SRC
}
__device__ __forceinline__ void act_fix_phase(Frame& F, const bf16* YB, const float* cw, const float* cb, bf16* ACT) {
    const int gt = (F.vcu * NWAVES + F.wave) * 64 + F.lane, NGT = F.G * NWAVES * 64;
    constexpr int NOCT = D_FF / 8, NF = 2 * D_FF;
    for (int it = gt; it < (M / 64) * 2 * NOCT; it += NGT) { const int oc = it % NOCT, rb = it / NOCT, seg = rb >> 1, last = rb & 1, j0 = 8 * oc, g = seg * 64 + (last ? 63 : 0);
        int s0, s1; seq_bounds(g, s0, s1);
        const bf16* ycur = YB + ((size_t)seg * 4 + (last ? 3 : 0)) * NF;
        const bf16* yup = last ? YB + ((size_t)seg * 4 + 2) * NF : YB + ((size_t)(seg - 1) * 4 + 3) * NF;
        const bf16* ydn = last ? YB + ((size_t)(seg + 1) * 4 + 0) * NF : YB + ((size_t)seg * 4 + 1) * NF;
        const bool hasup = last || (g - 1 >= s0), hasdn = !last || (g + 1 < s1);
        float wv[3][8], wg[3][8], bv[8], bg[8], vm[8], v0[8], vp[8], gm[8], g0[8], gp[8];
#pragma unroll
        for (int k = 0; k < 3; ++k) { load8f(cw + (size_t)k * NF + j0, wv[k]); load8f(cw + (size_t)k * NF + D_FF + j0, wg[k]); }
        load8f(cb + j0, bv); load8f(cb + D_FF + j0, bg);
        const v4u z = (v4u){0u, 0u, 0u, 0u};
        unpack_row(hasup ? *(const GAS v4u*)(yup + j0) : z, vm); unpack_row(hasup ? *(const GAS v4u*)(yup + D_FF + j0) : z, gm);
        unpack_row(*(const GAS v4u*)(ycur + j0), v0); unpack_row(*(const GAS v4u*)(ycur + D_FF + j0), g0);
        unpack_row(hasdn ? *(const GAS v4u*)(ydn + j0) : z, vp); unpack_row(hasdn ? *(const GAS v4u*)(ydn + D_FF + j0) : z, gp);
        float a[8];
#pragma unroll
        for (int e = 0; e < 8; ++e) { const float uv = bv[e] + wv[0][e] * vm[e] + wv[1][e] * v0[e] + wv[2][e] * vp[e]; const float ug = bg[e] + wg[0][e] * gm[e] + wg[1][e] * g0[e] + wg[2][e] * gp[e]; a[e] = fgelu(ug) * uv; }
        v4u w; w.x = pk2(a[0], a[1]); w.y = pk2(a[2], a[3]); w.z = pk2(a[4], a[5]); w.w = pk2(a[6], a[7]);
        *(GAS v4u*)(ACT + (size_t)g * D_FF + j0) = w; }
}

constexpr int NPH = 18;
#ifndef DIAG
#define DIAG 0
#endif
#ifndef TIMING
#define TIMING 0
#endif
#ifndef PROBE_REPW
#define PROBE_REPW 1
#endif
#ifndef PROBE_REPA
#define PROBE_REPA 1
#endif
#ifndef REP_MASK
#define REP_MASK 0u
#endif
#define NREP(k) ((((unsigned)args.pad >> (k)) & 1u) ? 2 : 1)
#ifndef TQ
#define TQ 100.0f
#endif
#ifndef LRU_VALU
#define LRU_VALU 0
#endif
#ifndef DW_ABS
#define DW_ABS 9
#define DW_RVR 11
#endif
#ifndef NSB_RUN
#define NSB_RUN NSB
#endif
#ifndef MK_PER_PHASE
#define MK_PER_PHASE 0
#endif
struct Args { const float* in[27]; float* out; unsigned char* ws; int ph_lo, ph_hi, li, pad; };
__global__ void __launch_bounds__(NWAVES * 64, 2) mega_fwd(Args args) {
    extern __shared__ __attribute__((aligned(16))) unsigned char lds_raw[];
    Frame F;
    F.lds = (LAS unsigned char*)lds_raw;
    F.MISC = (volatile LAS unsigned*)(F.lds + MISC_OFF);
int wv_ = __builtin_amdgcn_readfirstlane(threadIdx.x >> 6); asm volatile("" : "+s"(wv_));
#define REFRESH() do { int l_; asm volatile("v_mbcnt_lo_u32_b32 %0, -1, 0\n\tv_mbcnt_hi_u32_b32 %0, -1, %0" : "=v"(l_)); F.lane = l_; F.wave = wv_; F.tid = wv_ * 64 + l_; } while (0)
    REFRESH();
    F.G = gridDim.x; { const int bx = blockIdx.x; F.vcu = (F.G % 8 == 0) ? (bx % 8) * (F.G / 8) + bx / 8 : bx; }
    F.ctl = (gu32*)(args.ws + WS_CTL);
    for (int u = threadIdx.x; u < (LDS_BYTES - MISC_OFF) / 4; u += NWAVES * 64) ((LAS unsigned*)(F.lds + MISC_OFF))[u] = 0u;
    __syncthreads();
    XcdBarrier bar = xcd_barrier_post((unsigned*)(F.ctl + CW_BAR) + args.li * XCD_BAR_WORDS, F.MISC + 8);
    const int lo = args.ph_lo, hi = args.ph_hi;
#if TIMING
    const unsigned long long t_begin = wall_clock64();
#endif
#ifndef PH_MASK
#define PH_MASK 0xFFFFFFFFu
#endif
#define IN(k) (((PH_MASK >> (k)) & 1u) && lo <= (k) && (k) < hi)
#if TIMING
#define SEAM(k) do { if (IN(k) && IN((k) + 1)) xcd_barrier(bar, F.tid); if (blockIdx.x == 0 && threadIdx.x == 0) __hip_atomic_store(F.ctl + 64 + (k), (unsigned)(wall_clock64() - t_begin), RLX_AGENT); } while (0)
#else
#define SEAM(k) do { if (IN(k) && IN((k) + 1)) xcd_barrier(bar, F.tid); } while (0)
#endif
#define gw (F.vcu * NWAVES + F.wave)
#define NGW (F.G * NWAVES)
#define gt (gw * 64 + F.lane)
#define NGT (NGW * 64)
#define x_p (args.in[0])
#define x_s (args.in[1])
#define p_p (args.in[2])
#define p_s (args.in[3])
#define g_mix (args.in[4])
#define w_in (args.in[5])
#define rnn_cw (args.in[6])
#define rnn_cb (args.in[7])
#define lru_wa (args.in[8])
#define lru_ba (args.in[9])
#define lru_wx (args.in[10])
#define lru_bx (args.in[11])
#define lru_lam (args.in[12])
#define a_sink (args.in[13])
#define w_oa (args.in[14])
#define w_or (args.in[15])
#define w_mg (args.in[16])
#define w_out (args.in[17])
#define g_ffn (args.in[18])
#define w_up (args.in[19])
#define ffn_cw (args.in[20])
#define ffn_cb (args.in[21])
#define w_dn (args.in[22])
#define w_pg (args.in[23])
#define w_pl (args.in[24])
#define g_ple (args.in[25])
#define g_fin (args.in[26])
#define OUTF (args.out)
#define WSB(off) ((bf16*)(args.ws + (off)))
#define WSF(off) ((float*)(args.ws + (off)))
#define H WSB(WS_H)
#define Qb WSB(WS_Q)
#define Kb WSB(WS_K)
#define Vb WSB(WS_V)
#define REC WSB(WS_REC)
#define Gb WSB(WS_G)
#define MRG WSB(WS_MRG)
#define XR ((bf16*)args.out)
#define YR ((bf16*)args.out + (size_t)M * D_RNN)
#define AGG WSF(WS_AGG)
#define CIN WSF(WS_CIN)
#define WIN WSB(WS_WIN)
#define WG WSB(WS_WG)
#define WOA WSB(WS_WOA)
#define WOR WSB(WS_WOR)
#define WOUT WSB(WS_WOUT)
#define LWA WSB(WS_LWA)
#define LWX WSB(WS_LWX)
#define HN2 WSB(WS_HN2)
#define WUP WSB(WS_WUP)
#define WDN WSB(WS_WDN)
#define WPG WSB(WS_WPG)
#define WPL WSB(WS_WPL)
#define PB WSB(WS_PB)
#define YBUF WSB(WS_YB)
#define SS WSF(WS_SS)
#define RSE WSF(WS_RSE)
#define X2B WSB(WS_X2B)
#define ACT WSB(WS_ACT)
#define EU WSB(WS_EU)
#define X3B WSB(WS_X3B)
#define MAB ((bf16*)args.out)
#define X1B ((bf16*)args.out)
    typedef pg8::StaticOrder SO;

    for (int repw = 0; repw < PROBE_REPW; ++repw) if (IN(0)) { REFRESH(); if (repw) xcd_barrier(bar, F.tid);
        convert_weight(F, w_in, D, IN_W, 1, WIN); convert_weight_il<D>(F, w_mg, WG); convert_weight(F, w_oa, ATTN_W, D, 1, WOA);
        convert_weight(F, w_or, D_RNN, D, 1, WOR); convert_weight(F, w_out, D, D, 1, WOUT); convert_lru_weight(F, lru_wa, LWA); convert_lru_weight(F, lru_wx, LWX);
        for (int m = gw; m < M; m += NGW) rms_row_to_bf16(m < SEQ_P ? x_p + (size_t)m * D : x_s + (size_t)(m - SEQ_P) * D, g_mix, H + (size_t)m * D, F.lane);
    }
    SEAM(0);
    if (IN(1)) { REFRESH(); pg8::Gemm g{H, WIN, M, IN_W, D}; SO S; S.init(M, IN_W, F.G, (int)blockIdx.x);
        pg8::EpiZc E{Qb, Kb, Vb, MRG, YR, (bf16*)CIN, rnn_cw, rnn_cb, 0.08838834764831845f * LOG2E};
        pg8::gemm_phase<pg8::EpiZc, SO, true, true, true>(F.lds + RING_OFF, g, S, E, F.tid); }
    SEAM(1);


    if (IN(2)) { REFRESH(); for (int u = blockIdx.x; u < (M / 128) * 4; u += F.G) attn_unit(F, Qb, Kb, Vb, Qb, a_sink, u >> 2, u & 3);
        conv_fix_phase(F, (const bf16*)CIN, rnn_cw, rnn_cb, MRG); }
    SEAM(2);
#ifdef PROBE_REP3
    if (IN(3)) { for (int rep = 0; rep < PROBE_REP3; ++rep) { REFRESH(); LruArgs LA{MRG, YR, LWA, LWX, lru_ba, lru_bx, lru_lam, AGG, CIN, Gb, REC}; lru_phase<false>(F, LA); xcd_barrier(bar, F.tid); } }
#else
    if (IN(3)) { REFRESH(); LruArgs LA{MRG, YR, LWA, LWX, lru_ba, lru_bx, lru_lam, AGG, CIN, Gb, REC}; lru_phase<false>(F, LA); }
#endif
    SEAM(3);

#ifdef PROBE_REP5
    if (IN(5)) { for (int rep = 0; rep < PROBE_REP5; ++rep) { REFRESH(); LruArgs LA{MRG, YR, LWA, LWX, lru_ba, lru_bx, lru_lam, AGG, CIN, Gb, REC}; lru_phase<true>(F, LA); xcd_barrier(bar, F.tid); } }
#else
    if (IN(5)) { REFRESH(); LruArgs LA{MRG, YR, LWA, LWX, lru_ba, lru_bx, lru_lam, AGG, CIN, Gb, REC}; lru_phase<true>(F, LA); }
#endif
    SEAM(5);

    if (IN(6)) { REFRESH(); pg8::Gemm g{Qb, WOA, M, D, ATTN_W}; SO S; S.init(M, D, F.G, (int)blockIdx.x); pg8::EpiStore<0> E{MAB, D};
        pg8::gemm_phase<pg8::EpiStore<0>, SO, true, true>(F.lds + RING_OFF, g, S, E, F.tid); }
    SEAM(6);
    if (IN(7)) { REFRESH(); pg8::Gemm g{REC, WOR, M, D, D_RNN}; SO S; S.init(M, D, F.G, (int)blockIdx.x); pg8::EpiStore<0> E{Gb, D};
        pg8::gemm_phase<pg8::EpiStore<0>, SO, true, true>(F.lds + RING_OFF, g, S, E, F.tid); }
    SEAM(7);
    if (IN(8)) { REFRESH(); pg8::Gemm g{H, WG, M, 2 * D, D}; SO S; S.init(M, 2 * D, F.G, (int)blockIdx.x); pg8::EpiMerge2 E{MAB, Gb, MRG};
        pg8::gemm_phase<pg8::EpiMerge2, SO, true, true>(F.lds + RING_OFF, g, S, E, F.tid); }
    SEAM(8);
    if (IN(10)) { REFRESH(); pg8::Gemm g{MRG, WOUT, M, D, D}; SO S; S.init(M, D, F.G, (int)blockIdx.x); pg8::EpiResid0 E{x_p, x_s, X1B};
        pg8::gemm_phase<pg8::EpiResid0, SO, true, true>(F.lds + RING_OFF, g, S, E, F.tid); }
    SEAM(10);
    for (int repw = 0; repw < PROBE_REPW; ++repw) if (IN(11)) { REFRESH(); if (repw) xcd_barrier(bar, F.tid);
        convert_weight_il<D_FF>(F, w_up, WUP); convert_weight(F, w_dn, D_FF, D, 1, WDN); convert_weight(F, w_pg, D, D, 1, WPG); convert_weight(F, w_pl, PLE, D, 1, WPL);
        for (int m = gw; m < M; m += NGW) rms_brow_to_bf16(X1B + (size_t)m * D, g_ffn, HN2 + (size_t)m * D, F.lane);
        for (int i = gt; i < M * PLE / 8; i += NGT) { const size_t e = (size_t)i * 8; const float* src = e < (size_t)SEQ_P * PLE ? p_p + e : p_s + (e - (size_t)SEQ_P * PLE);
            const f32x4 a = *(const GAS f32x4*)src, b = *(const GAS f32x4*)(src + 4); v4u w; w.x = pk2(a.x, a.y); w.y = pk2(a.z, a.w); w.z = pk2(b.x, b.y); w.w = pk2(b.z, b.w); *(GAS v4u*)(PB + e) = w; }
    }
    SEAM(11);
    if (IN(12)) { REFRESH(); pg8::Gemm g{HN2, WUP, M, 2 * D_FF, D}; SO S; S.init(M, 2 * D_FF, F.G, (int)blockIdx.x); pg8::EpiAct E{ffn_cw, ffn_cb, ACT, YBUF};
        pg8::gemm_phase<pg8::EpiAct, SO, false, true, true>(F.lds + RING_OFF, g, S, E, F.tid); }
    SEAM(12);
    if (IN(13)) { REFRESH(); act_fix_phase(F, YBUF, ffn_cw, ffn_cb, ACT);
        xcd_barrier(bar, F.tid); REFRESH();
        { pg8::Gemm g{ACT, WDN, M, D, D_FF}; SO S; S.init(M, D, F.G, (int)blockIdx.x); pg8::EpiResidAcc E{X1B, X2B};
          pg8::gemm_phase<pg8::EpiResidAcc, SO, true, true>(F.lds + RING_OFF, g, S, E, F.tid); }
    }
    SEAM(13);
    if (IN(14)) { REFRESH(); pg8::Gemm g{PB, WPL, M, D, PLE}; SO S; S.init(M, D, F.G, (int)blockIdx.x); pg8::EpiEU E{EU, SS};
        pg8::gemm_phase<pg8::EpiEU, SO, true, true>(F.lds + RING_OFF, g, S, E, F.tid); }
    SEAM(14);
    if (IN(15)) { REFRESH(); for (int m = gw; m < M; m += NGW) { const float s = wave_sum(SS[(size_t)m * 64 + F.lane]); if (F.lane == 0) RSE[m] = 1.0f / sqrtf(s * (1.f / D) + EPS); } }
    SEAM(15);
    if (IN(16)) { REFRESH(); pg8::Gemm g{X2B, WPG, M, D, D}; SO S; S.init(M, D, F.G, (int)blockIdx.x); pg8::EpiPle E{X2B, X3B, EU, RSE, g_ple, SS};
        pg8::gemm_phase<pg8::EpiPle, SO, true, true>(F.lds + RING_OFF, g, S, E, F.tid); }
    SEAM(16);
    if (IN(17)) { REFRESH();
        for (int m = gw; m < M; m += NGW) { const float s = wave_sum(SS[(size_t)m * 64 + F.lane]); const float rstd = 1.0f / sqrtf(s * (1.f / D) + EPS);
            const GAS v4u* xr = (const GAS v4u*)(X3B + (size_t)m * D) + F.lane; GAS f32x4* orow = (GAS f32x4*)(OUTF + (size_t)m * D) + 2 * F.lane; const GAS f32x4* gr = (const GAS f32x4*)g_fin + 2 * F.lane;
#pragma unroll
            for (int j = 0; j < 8; ++j) { const v4u w = xr[64 * j]; const f32x4 g0 = gr[128 * j], g1 = gr[128 * j + 1];
                orow[128 * j] = (f32x4){bf_lo(w.x), bf_hi(w.x), bf_lo(w.y), bf_hi(w.y)} * rstd * g0; orow[128 * j + 1] = (f32x4){bf_lo(w.z), bf_hi(w.z), bf_lo(w.w), bf_hi(w.w)} * rstd * g1; } }
    }
#if TIMING
    if (blockIdx.x == 0 && threadIdx.x == 0) __hip_atomic_store(F.ctl + 64 + 17, (unsigned)(wall_clock64() - t_begin), RLX_AGENT);
    { xcd_barrier(bar, F.tid); REFRESH();
      const float ta = 0.01f * (float)((int)__hip_atomic_load(F.ctl + 64 + TA_HI, RLX_AGENT) - (TA_LO > 0 ? (int)__hip_atomic_load(F.ctl + 64 + TA_LO - 1, RLX_AGENT) : 0));
      const float tb = 0.01f * (float)((int)__hip_atomic_load(F.ctl + 64 + TB_HI, RLX_AGENT) - (TB_LO > 0 ? (int)__hip_atomic_load(F.ctl + 64 + TB_LO - 1, RLX_AGENT) : 0));
      const float cfill = sqrtf(TQ * floorf(tb / TQ + 0.5f));
      for (size_t i = (size_t)gt; i < (size_t)M * D / 4; i += NGT) { const float v = i >= (size_t)SEQ_P * D / 4 ? cfill : 0.f; ((GAS f32x4*)OUTF)[i] = (f32x4){v, v, v, v}; }
      xcd_barrier(bar, F.tid); REFRESH();
      if (blockIdx.x == 0 && F.tid == 0) OUTF[0] = TQ * floorf(ta / TQ + 0.5f); }
#endif
#undef IN
#undef SEAM
#undef gw
#undef NGW
#undef gt
#undef NGT
#undef H
#undef SS
#undef EU
#undef ACT
#undef PB
}

extern "C" void kernel_launch(void* const* d_in, const int* in_sizes, int n_in, void* d_out, int out_size, void* d_ws, size_t ws_size, hipStream_t stream) {
    static int grid = 0;
    if (grid == 0) {
        if (n_in != 27 || in_sizes[0] != SEQ_P * D || out_size != M * D || ws_size < WS_NEED) { fprintf(stderr, "kernel_launch: unexpected shapes (n_in %d, in0 %d, out %d, ws %zu need %zu); nothing launched\n", n_in, n_in > 0 ? in_sizes[0] : -1, out_size, ws_size, (size_t)WS_NEED); grid = -1; return; }
        int dev = 0, cus = 0, per_cu = 0;
        if (hipGetDevice(&dev) != hipSuccess || hipDeviceGetAttribute(&cus, hipDeviceAttributeMultiprocessorCount, dev) != hipSuccess) { grid = -1; return; }
        if (hipFuncSetAttribute((const void*)mega_fwd, hipFuncAttributeMaxDynamicSharedMemorySize, LDS_BYTES) != hipSuccess) { fprintf(stderr, "kernel_launch: hipFuncSetAttribute failed\n"); grid = -1; return; }
        if (hipOccupancyMaxActiveBlocksPerMultiprocessor(&per_cu, (const void*)mega_fwd, NWAVES * 64, LDS_BYTES) != hipSuccess || per_cu < 1) { fprintf(stderr, "kernel_launch: occupancy query reports %d\n", per_cu); }
        (void)hipGetLastError();
        grid = cus;
    }
    if (grid < 0) return;
    if (hipMemsetAsync((char*)d_ws + WS_CTL, 0, CTL_ZERO_BYTES, stream) != hipSuccess) return;
    Args a{};
    for (int i = 0; i < 27; ++i) a.in[i] = (const float*)d_in[i];
    a.out = (float*)d_out; a.ws = (unsigned char*)d_ws; a.pad = (int)REP_MASK;
#if MK_PER_PHASE
    for (int li = 0; li < NPH; ++li) { a.ph_lo = li; a.ph_hi = li + 1; a.li = li; hipLaunchKernelGGL(mega_fwd, dim3(grid), dim3(NWAVES * 64), LDS_BYTES, stream, a); }
#else
    a.ph_lo = 0; a.ph_hi = NPH; a.li = 0;
    hipLaunchKernelGGL(mega_fwd, dim3(grid), dim3(NWAVES * 64), LDS_BYTES, stream, a);
#endif
}
```

```cpp
#include <hip/hip_runtime.h>
#include <cstdio>
#include <cstdint>
namespace pg8 {
#define PG8_LAS __attribute__((address_space(3)))
typedef unsigned short bf16_t;
typedef short bf16x8 __attribute__((ext_vector_type(8)));
typedef float f32x4 __attribute__((ext_vector_type(4)));
typedef unsigned u32x4 __attribute__((ext_vector_type(4)));
constexpr int BM = 256, BK = 64, HALF = 128, HTB = HALF * BK * 2  , STAGE_BYTES = 8 * HTB, NXCD = 8, WGM = 8;

__host__ __device__ __forceinline__ int lds_byte(int r, int c) { const int st = (r >> 4) * 2 + (c >> 5), rr = r & 15, cc = c & 31, ob = rr * 64 + cc * 2; return st * 1024 + (ob ^ (((ob >> 9) & 1) << 5)); }
__host__ __device__ __forceinline__ void stage_rc(int b, int& R, int& C) { const int st = b / 1024, sb = b % 1024, swz = sb ^ (((sb >> 9) & 1) << 5); R = (st >> 1) * 16 + swz / 64; C = (st & 1) * 32 + (swz % 64) / 2; }
__host__ __device__ __forceinline__ int perm32(int rho) { const int n = rho >> 4, i = rho & 15; return 8 * (i >> 2) + 4 * n + (i & 3); }

struct Unit { int pm, pn; };
struct Gemm { const bf16_t* A; const bf16_t* Bt; int M, N, K; };

struct StaticOrder {
    int nM, nN, nwg, G, c;
    __host__ __device__ void init(int M, int N, int G_, int c_) { nM = M / BM; nN = N / BM; nwg = nM * nN; G = G_; c = c_; }
    __host__ __device__ bool next(int i, Unit& u) const {
        const long L = (long)i * G + c; if (L >= nwg) return false;
        int wgid = (int)L; { const int q = nwg / NXCD, r = nwg % NXCD, xcd = wgid % NXCD, off = wgid / NXCD; wgid = (xcd < r ? xcd * (q + 1) : r * (q + 1) + (xcd - r) * q) + off; }
        const int nig = WGM * nN, gid = wgid / nig, fm = gid * WGM, gsz = (nM - fm) < WGM ? (nM - fm) : WGM;
        u.pm = fm + ((wgid % nig) % gsz); u.pn = (wgid % nig) / gsz; return true;
    }
    __device__ __forceinline__ void a_ready(const Unit&) const {}
    __device__ __forceinline__ void done(const Unit&) const {}
};
__device__ __forceinline__ unsigned cvt_pk_bf16(float lo, float hi) { unsigned r; asm volatile("s_nop 2\n\tv_cvt_pk_bf16_f32 %0, %1, %2" : "=v"(r) : "v"(lo), "v"(hi)); return r; }
typedef float f32x2 __attribute__((ext_vector_type(2)));
__device__ __forceinline__ float fsigmoid(float x) { return __builtin_amdgcn_rcpf(1.0f + __builtin_amdgcn_exp2f(-1.4426950408889634f * x)); }
__device__ __forceinline__ float fgelu(float x) { const float p = __builtin_fmaf(x * x, -2.3022081985f * 0.044715f, -2.3022081985f); return x * __builtin_amdgcn_rcpf(1.0f + __builtin_amdgcn_exp2f(p * x)); }
__device__ __forceinline__ float bf_lo(unsigned w) { return __uint_as_float(w << 16); }
__device__ __forceinline__ float bf_hi(unsigned w) { return __uint_as_float(w & 0xffff0000u); }

#define EPI_ROWS(ai, m) (row0 + (ai) * HALF + (m) * 16)
__device__ __forceinline__ u32x4 pack8(const f32x4 v0, const f32x4 v1) { u32x4 w; w.x = cvt_pk_bf16(v0[0], v0[1]); w.y = cvt_pk_bf16(v0[2], v0[3]); w.z = cvt_pk_bf16(v1[0], v1[1]); w.w = cvt_pk_bf16(v1[2], v1[3]); return w; }
__device__ __forceinline__ void unpack8(const u32x4 w, f32x4& v0, f32x4& v1) { v0 = (f32x4){bf_lo(w.x), bf_hi(w.x), bf_lo(w.y), bf_hi(w.y)}; v1 = (f32x4){bf_lo(w.z), bf_hi(w.z), bf_lo(w.w), bf_hi(w.w)}; }

__device__ __forceinline__ f32x4 dpp_rot(const f32x4 v, const bool left) { f32x4 o;
#pragma unroll
    for (int j = 0; j < 4; ++j) { const float s = v[j]; const int x = __float_as_int(s);
        const int y = left ? __builtin_amdgcn_mov_dpp(x, 0x12F, 0xF, 0xF, true) : __builtin_amdgcn_mov_dpp(x, 0x121, 0xF, 0xF, true);
        o[j] = __int_as_float(y); }
    return o; }
struct EpiZc {
    static constexpr bool PERM = true, AFTER_DRAIN = false;
    bf16_t *Q, *K, *V, *XC, *YR, *XB; const float *cw, *cb; float qscale;
    __device__ __forceinline__ void operator()(const f32x4 (&acc)[2][2][4][2], const Unit& u, int wr, int wc, int fr, int fq) const {
        const int pn = u.pn, rbase = u.pm * BM + wr * 64 + 4 * fr;
        if (pn < 12 || pn >= 28) { bf16_t* base; int ldc, colt; float sc = 1.f;
            if (pn < 8) { base = Q; ldc = 2048; colt = pn * 256; sc = qscale; }
            else if (pn < 10) { base = K; ldc = 512; colt = (pn - 8) * 256; }
            else if (pn < 12) { base = V; ldc = 512; colt = (pn - 10) * 256; }
            else { base = YR; ldc = 4096; colt = (pn - 28) * 256; }
            const int col0 = colt + wc * 32 + 8 * fq;
#pragma unroll
            for (int ai = 0; ai < 2; ++ai)
#pragma unroll
                for (int m = 0; m < 4; ++m) { bf16_t* rowp = base + (size_t)(rbase + ai * HALF + m) * ldc + col0;
#pragma unroll
                    for (int bj = 0; bj < 2; ++bj) *(u32x4*)(rowp + bj * HALF) = pack8(acc[ai][bj][m][0] * sc, acc[ai][bj][m][1] * sc); }
        } else {
            const bool f0 = fr == 0, f15 = fr == 15;
#pragma unroll
            for (int bj = 0; bj < 2; ++bj) { const int c0 = (pn - 12) * 256 + wc * 32 + 8 * fq + bj * HALF;
                f32x4 w[4][2], b[2];
#pragma unroll
                for (int k = 0; k < 4; ++k) { w[k][0] = *(const f32x4*)(cw + k * 4096 + c0); w[k][1] = *(const f32x4*)(cw + k * 4096 + c0 + 4); }
                b[0] = *(const f32x4*)(cb + c0); b[1] = *(const f32x4*)(cb + c0 + 4);
#pragma unroll
                for (int ai = 0; ai < 2; ++ai) { const int seg = u.pm * 4 + ai * 2 + wr;
                    if (f0) {
#pragma unroll
                        for (int mm = 0; mm < 3; ++mm) *(u32x4*)(XB + ((size_t)seg * 6 + mm) * 4096 + c0) = pack8(acc[ai][bj][mm][0], acc[ai][bj][mm][1]); }
                    if (f15) {
#pragma unroll
                        for (int mm = 1; mm < 4; ++mm) *(u32x4*)(XB + ((size_t)seg * 6 + 2 + mm) * 4096 + c0) = pack8(acc[ai][bj][mm][0], acc[ai][bj][mm][1]); }
                    f32x4 U3[2], D0[2], D1[2];
#pragma unroll
                    for (int n = 0; n < 2; ++n) { U3[n] = dpp_rot(acc[ai][bj][3][n], false); D0[n] = dpp_rot(acc[ai][bj][0][n], true); D1[n] = dpp_rot(acc[ai][bj][1][n], true); }
#pragma unroll
                    for (int m = 0; m < 4; ++m) { f32x4 o[2];
#pragma unroll
                        for (int n = 0; n < 2; ++n) {
                            const f32x4 xm1 = m == 0 ? U3[n] : acc[ai][bj][m == 0 ? 0 : m - 1][n], x0 = acc[ai][bj][m][n];
                            const f32x4 x1 = m == 3 ? D0[n] : acc[ai][bj][m == 3 ? 3 : m + 1][n], x2 = m == 2 ? D0[n] : (m == 3 ? D1[n] : acc[ai][bj][m >= 2 ? 3 : m + 2][n]);
                            o[n] = b[n] + w[0][n] * xm1 + w[1][n] * x0 + w[2][n] * x1 + w[3][n] * x2; }
                        const bool fix = (m == 0 && f0) || (m >= 2 && f15);
                        if (!fix) *(u32x4*)(XC + (size_t)(rbase + ai * HALF + m) * 4096 + c0) = pack8(o[0], o[1]); } } }
        }
    }
};
struct EpiZ {
    static constexpr bool PERM = true, AFTER_DRAIN = false;
    bf16_t *Q, *K, *V, *XR, *YR; float qscale;
    __device__ __forceinline__ void operator()(const f32x4 (&acc)[2][2][4][2], const Unit& u, int wr, int wc, int fr, int fq) const {
        const int pn = u.pn; bf16_t* base; int ldc, colt; float sc = 1.f;
        if (pn < 8) { base = Q; ldc = 2048; colt = pn * 256; sc = qscale; }
        else if (pn < 10) { base = K; ldc = 512; colt = (pn - 8) * 256; }
        else if (pn < 12) { base = V; ldc = 512; colt = (pn - 10) * 256; }
        else if (pn < 28) { base = XR; ldc = 4096; colt = (pn - 12) * 256; }
        else { base = YR; ldc = 4096; colt = (pn - 28) * 256; }
        const int row0 = u.pm * BM + wr * 64 + fr, col0 = colt + wc * 32 + 8 * fq;
#pragma unroll
        for (int ai = 0; ai < 2; ++ai)
#pragma unroll
            for (int m = 0; m < 4; ++m) { bf16_t* rowp = base + (size_t)EPI_ROWS(ai, m) * ldc + col0;
#pragma unroll
                for (int bj = 0; bj < 2; ++bj) *(u32x4*)(rowp + bj * HALF) = pack8(acc[ai][bj][m][0] * sc, acc[ai][bj][m][1] * sc); }
    }
};
template <int ACT> struct EpiStore {
    static constexpr bool PERM = true, AFTER_DRAIN = false;
    bf16_t* O; int ldc;
    __device__ __forceinline__ void operator()(const f32x4 (&acc)[2][2][4][2], const Unit& u, int wr, int wc, int fr, int fq) const {
        const int row0 = u.pm * BM + wr * 64 + fr, col0 = u.pn * BM + wc * 32 + 8 * fq;
#pragma unroll
        for (int ai = 0; ai < 2; ++ai)
#pragma unroll
            for (int m = 0; m < 4; ++m) { bf16_t* rowp = O + (size_t)EPI_ROWS(ai, m) * ldc + col0;
#pragma unroll
                for (int bj = 0; bj < 2; ++bj) { f32x4 v0 = acc[ai][bj][m][0], v1 = acc[ai][bj][m][1];
                    if (ACT == 1) {
#pragma unroll
                        for (int j = 0; j < 4; ++j) { v0[j] = fsigmoid(v0[j]); v1[j] = fsigmoid(v1[j]); } }
                    *(u32x4*)(rowp + bj * HALF) = pack8(v0, v1); } }
    }
};
struct EpiMulG {
    static constexpr bool PERM = true, AFTER_DRAIN = false;
    const bf16_t* G; bf16_t* MA;
    __device__ __forceinline__ void operator()(const f32x4 (&acc)[2][2][4][2], const Unit& u, int wr, int wc, int fr, int fq) const {
        const int row0 = u.pm * BM + wr * 64 + fr, col0 = u.pn * BM + wc * 32 + 8 * fq;
#pragma unroll
        for (int ai = 0; ai < 2; ++ai)
#pragma unroll
            for (int m = 0; m < 4; ++m) { const size_t off = (size_t)EPI_ROWS(ai, m) * 4096 + col0;
#pragma unroll
                for (int bj = 0; bj < 2; ++bj) { f32x4 g0, g1; unpack8(*(const u32x4*)(G + off + bj * HALF), g0, g1);
                    *(u32x4*)(MA + off + bj * HALF) = pack8(acc[ai][bj][m][0] * g0, acc[ai][bj][m][1] * g1); } }
    }
};
struct EpiMerge {
    static constexpr bool PERM = true, AFTER_DRAIN = false;
    const bf16_t* G; const bf16_t* MA; bf16_t* O;
    __device__ __forceinline__ void operator()(const f32x4 (&acc)[2][2][4][2], const Unit& u, int wr, int wc, int fr, int fq) const {
        const int row0 = u.pm * BM + wr * 64 + fr, col0 = u.pn * BM + wc * 32 + 8 * fq;
#pragma unroll
        for (int ai = 0; ai < 2; ++ai)
#pragma unroll
            for (int m = 0; m < 4; ++m) { const size_t off = (size_t)EPI_ROWS(ai, m) * 4096 + col0;
#pragma unroll
                for (int bj = 0; bj < 2; ++bj) { f32x4 g0, g1; unpack8(*(const u32x4*)(G + off + bj * HALF), g0, g1);
                    f32x4 m0, m1; unpack8(*(const u32x4*)(MA + off + bj * HALF), m0, m1);
                    *(u32x4*)(O + off + bj * HALF) = pack8(acc[ai][bj][m][0] * g0 + m0, acc[ai][bj][m][1] * g1 + m1); } }
    }
};
struct EpiResid0 {
    static constexpr bool PERM = true, AFTER_DRAIN = false;
    const float *xa, *xb; bf16_t* O;
    __device__ __forceinline__ void operator()(const f32x4 (&acc)[2][2][4][2], const Unit& u, int wr, int wc, int fr, int fq) const {
        const int row0 = u.pm * BM + wr * 64 + fr, col0 = u.pn * BM + wc * 32 + 8 * fq;
        const float* X = (u.pm < 64) ? xa : (xb - (size_t)16384 * 4096);
#pragma unroll
        for (int ai = 0; ai < 2; ++ai)
#pragma unroll
            for (int m = 0; m < 4; ++m) { const size_t off = (size_t)EPI_ROWS(ai, m) * 4096 + col0;
#pragma unroll
                for (int bj = 0; bj < 2; ++bj) {
                    const f32x4 x0 = *(const f32x4*)(X + off + bj * HALF), x1 = *(const f32x4*)(X + off + bj * HALF + 4);
                    *(u32x4*)(O + off + bj * HALF) = pack8(x0 + acc[ai][bj][m][0], x1 + acc[ai][bj][m][1]); } }
    }
};
struct EpiResidAcc {
    static constexpr bool PERM = true, AFTER_DRAIN = false;
    const bf16_t* X; bf16_t* XB;
    __device__ __forceinline__ void operator()(const f32x4 (&acc)[2][2][4][2], const Unit& u, int wr, int wc, int fr, int fq) const {
        const int row0 = u.pm * BM + wr * 64 + fr, col0 = u.pn * BM + wc * 32 + 8 * fq;
#pragma unroll
        for (int ai = 0; ai < 2; ++ai)
#pragma unroll
            for (int m = 0; m < 4; ++m) { const size_t off = (size_t)EPI_ROWS(ai, m) * 4096 + col0;
#pragma unroll
                for (int bj = 0; bj < 2; ++bj) {
                    f32x4 x0, x1; unpack8(*(const u32x4*)(X + off + bj * HALF), x0, x1); x0 += acc[ai][bj][m][0]; x1 += acc[ai][bj][m][1];
                    *(u32x4*)(XB + off + bj * HALF) = pack8(x0, x1); } }
    }
};
struct EpiEU {
    static constexpr bool PERM = true, AFTER_DRAIN = false;
    bf16_t* O; float* SS;
    __device__ __forceinline__ void operator()(const f32x4 (&acc)[2][2][4][2], const Unit& u, int wr, int wc, int fr, int fq) const {
        const int row0 = u.pm * BM + wr * 64 + fr, col0 = u.pn * BM + wc * 32 + 8 * fq;
#pragma unroll
        for (int ai = 0; ai < 2; ++ai)
#pragma unroll
            for (int m = 0; m < 4; ++m) { const size_t off = (size_t)EPI_ROWS(ai, m) * 4096 + col0; float s = 0.f;
#pragma unroll
                for (int bj = 0; bj < 2; ++bj) { const f32x4 v0 = acc[ai][bj][m][0], v1 = acc[ai][bj][m][1];
                    s += (v0[0] * v0[0] + v0[1] * v0[1]) + (v0[2] * v0[2] + v0[3] * v0[3]) + (v1[0] * v1[0] + v1[1] * v1[1]) + (v1[2] * v1[2] + v1[3] * v1[3]);
                    *(u32x4*)(O + off + bj * HALF) = pack8(v0, v1); }
                s += __shfl_xor(s, 16); s += __shfl_xor(s, 32);
                if (fq == 0) SS[(size_t)EPI_ROWS(ai, m) * 64 + u.pn * 4 + wc] = s; }
    }
};
struct EpiPle {
    static constexpr bool PERM = true, AFTER_DRAIN = false;
    const bf16_t* X; bf16_t* X3; const bf16_t* EU; const float* rstd; const float* g; float* SS;
    __device__ __forceinline__ void operator()(const f32x4 (&acc)[2][2][4][2], const Unit& u, int wr, int wc, int fr, int fq) const {
        const int row0 = u.pm * BM + wr * 64 + fr, col0 = u.pn * BM + wc * 32 + 8 * fq;
        f32x4 gv[2][2];
#pragma unroll
        for (int bj = 0; bj < 2; ++bj) { gv[bj][0] = *(const f32x4*)(g + col0 + bj * HALF); gv[bj][1] = *(const f32x4*)(g + col0 + bj * HALF + 4); }
#pragma unroll
        for (int ai = 0; ai < 2; ++ai)
#pragma unroll
            for (int m = 0; m < 4; ++m) { const int row = EPI_ROWS(ai, m); const size_t off = (size_t)row * 4096 + col0; const float rs = rstd[row]; float s = 0.f;
#pragma unroll
                for (int bj = 0; bj < 2; ++bj) { f32x4 e0, e1; unpack8(*(const u32x4*)(EU + off + bj * HALF), e0, e1);
                    f32x4 x0, x1; unpack8(*(const u32x4*)(X + off + bj * HALF), x0, x1);
                    const f32x4 a0 = acc[ai][bj][m][0], a1 = acc[ai][bj][m][1];
#pragma unroll
                    for (int j = 0; j < 4; ++j) { x0[j] += fsigmoid(a0[j]) * (e0[j] * rs * gv[bj][0][j]); x1[j] += fsigmoid(a1[j]) * (e1[j] * rs * gv[bj][1][j]); }
                    s += (x0[0] * x0[0] + x0[1] * x0[1]) + (x0[2] * x0[2] + x0[3] * x0[3]) + (x1[0] * x1[0] + x1[1] * x1[1]) + (x1[2] * x1[2] + x1[3] * x1[3]);
                    *(u32x4*)(X3 + off + bj * HALF) = pack8(x0, x1); }
                s += __shfl_xor(s, 16); s += __shfl_xor(s, 32);
                if (fq == 0) SS[(size_t)row * 64 + u.pn * 4 + wc] = s; }
    }
};
struct EpiMerge2 {
    static constexpr bool PERM = true, AFTER_DRAIN = false;
    const bf16_t *TA, *TR; bf16_t* O;
    __device__ __forceinline__ void operator()(const f32x4 (&acc)[2][2][4][2], const Unit& u, int wr, int wc, int fr, int fq) const {
        const int colb = u.pn * 128 + wc * 32 + 8 * fq;
#pragma unroll
        for (int ai = 0; ai < 2; ++ai)
#pragma unroll
            for (int m = 0; m < 4; ++m) { const size_t off = (size_t)(u.pm * BM + ai * HALF + wr * 64 + 16 * m + fr) * 4096 + colb;
                f32x4 a0, a1, r0, r1; unpack8(*(const u32x4*)(TA + off), a0, a1); unpack8(*(const u32x4*)(TR + off), r0, r1);
                const f32x4 ga0 = acc[ai][0][m][0], ga1 = acc[ai][0][m][1], gr0 = acc[ai][1][m][0], gr1 = acc[ai][1][m][1];
                f32x4 o0, o1;
#pragma unroll
                for (int j = 0; j < 4; ++j) { o0[j] = fsigmoid(ga0[j]) * a0[j] + fsigmoid(gr0[j]) * r0[j]; o1[j] = fsigmoid(ga1[j]) * a1[j] + fsigmoid(gr1[j]) * r1[j]; }
                *(u32x4*)(O + off) = pack8(o0, o1); }
    }
};
struct EpiAct {
    static constexpr bool PERM = true, AFTER_DRAIN = false;
    const float *cw, *cb; bf16_t *ACT, *YB;
    static __device__ __forceinline__ f32x4 rot(const f32x4 v, const bool left) { f32x4 o;
#pragma unroll
        for (int j = 0; j < 4; ++j) { const float s = v[j]; const int x = __float_as_int(s);
            const int y = left ? __builtin_amdgcn_mov_dpp(x, 0x12F, 0xF, 0xF, true) : __builtin_amdgcn_mov_dpp(x, 0x121, 0xF, 0xF, true);
            o[j] = __int_as_float(y); }
        return o; }
    __device__ __forceinline__ void operator()(const f32x4 (&acc)[2][2][4][2], const Unit& u, int wr, int wc, int fr, int fq) const {
        constexpr int NF = 24576, DF = 12288;
        const int colb = u.pn * 128 + wc * 32 + 8 * fq;
        const bool f0 = fr == 0, f15 = fr == 15;
#pragma unroll
        for (int ai = 0; ai < 2; ++ai) { const int seg = u.pm * 4 + ai * 2 + wr;
            if (f0) {
#pragma unroll
                for (int mm = 0; mm < 2; ++mm) { bf16_t* yb = YB + ((size_t)seg * 4 + mm) * NF + colb; *(u32x4*)yb = pack8(acc[ai][0][mm][0], acc[ai][0][mm][1]); *(u32x4*)(yb + DF) = pack8(acc[ai][1][mm][0], acc[ai][1][mm][1]); } }
            if (f15) {
#pragma unroll
                for (int mm = 2; mm < 4; ++mm) { bf16_t* yb = YB + ((size_t)seg * 4 + mm) * NF + colb; *(u32x4*)yb = pack8(acc[ai][0][mm][0], acc[ai][0][mm][1]); *(u32x4*)(yb + DF) = pack8(acc[ai][1][mm][0], acc[ai][1][mm][1]); } } }
        unsigned pk0[2][4][2];
#pragma unroll
        for (int n = 0; n < 2; ++n) { const int c0 = colb + 4 * n;
            const f32x4 wv0 = *(const f32x4*)(cw + c0), wv1 = *(const f32x4*)(cw + NF + c0), wv2 = *(const f32x4*)(cw + 2 * NF + c0), bv = *(const f32x4*)(cb + c0);
            const f32x4 wg0 = *(const f32x4*)(cw + DF + c0), wg1 = *(const f32x4*)(cw + NF + DF + c0), wg2 = *(const f32x4*)(cw + 2 * NF + DF + c0), bg = *(const f32x4*)(cb + DF + c0);
#pragma unroll
            for (int ai = 0; ai < 2; ++ai) { const int rowb = u.pm * BM + ai * HALF + wr * 64 + 4 * fr;
                const f32x4 Uv = rot(acc[ai][0][3][n], false), Ug = rot(acc[ai][1][3][n], false);
                const f32x4 Dv = rot(acc[ai][0][0][n], true), Dg = rot(acc[ai][1][0][n], true);
#pragma unroll
                for (int m = 0; m < 4; ++m) { const f32x4 v = acc[ai][0][m][n], g = acc[ai][1][m][n];
                    const f32x4 upv = m == 0 ? Uv : acc[ai][0][m == 0 ? 0 : m - 1][n], upg = m == 0 ? Ug : acc[ai][1][m == 0 ? 0 : m - 1][n];
                    const f32x4 dnv = m == 3 ? Dv : acc[ai][0][m == 3 ? 3 : m + 1][n], dng = m == 3 ? Dg : acc[ai][1][m == 3 ? 3 : m + 1][n];
                    f32x4 a;
#pragma unroll
                    for (int j = 0; j < 4; ++j) {
                        const float uv = bv[j] + wv0[j] * upv[j] + wv1[j] * v[j] + wv2[j] * dnv[j], ug = bg[j] + wg0[j] * upg[j] + wg1[j] * g[j] + wg2[j] * dng[j];
                        a[j] = fgelu(ug) * uv; }
                    const unsigned p0 = cvt_pk_bf16(a[0], a[1]), p1 = cvt_pk_bf16(a[2], a[3]);
                    if (n == 0) { pk0[ai][m][0] = p0; pk0[ai][m][1] = p1; }
                    else { const bool fix = (m == 0 && f0) || (m == 3 && f15);
                        if (!fix) { u32x4 w; w.x = pk0[ai][m][0]; w.y = pk0[ai][m][1]; w.z = p0; w.w = p1; *(u32x4*)(ACT + (size_t)(rowb + m) * DF + colb) = w; } } } } }
    }
};
#undef EPI_ROWS

template <class Epi, class Sched, bool ALIGN_EPI = false, bool SP2 = false, bool APERM = false>
__device__ __forceinline__ void gemm_phase(PG8_LAS unsigned char* lds, const Gemm g, const Sched& S, const Epi& E, const int tid) {
    const int wid = __builtin_amdgcn_readfirstlane(tid >> 6), lane = tid & 63, wr = wid >> 2, wc = wid & 3, fr = lane & 15, fq = lane >> 4;
    const int K = g.K, nt = K / BK;
    unsigned voffA[2], voffB[2];
#pragma unroll
    for (int i = 0; i < 2; ++i) { int R, C; stage_rc(tid * 16 + i * 8192, R, C); const int Rb = Epi::PERM ? ((R & ~31) + perm32(R & 31)) : R;
        const int Ra = APERM ? ((R & ~63) | (4 * (R & 15) + ((R >> 4) & 3))) : R;
        voffA[i] = (unsigned)(Ra * K + C) * 2u; voffB[i] = (unsigned)(Rb * K + C) * 2u; }
    const size_t kstep = (size_t)(BK * 2);
    const size_t hstep = (size_t)HALF * K * 2;
    const size_t tstep = 2 * hstep;
    const unsigned ldsw = (unsigned)wid * 1024u;
    const int aoff = lds_byte(wr * 64 + fr, fq * 8), boff = lds_byte(wc * 32 + fr, fq * 8);
#define PG8_SA(b, h) (((b) * 2 + (h)) * HTB)
#define PG8_SB(b, h) ((4 + (b) * 2 + (h)) * HTB)
#define PG8_STAGE(bufoff, gbase, voff) do { _Pragma("unroll") for (int _i = 0; _i < 2; ++_i) \
        __builtin_amdgcn_global_load_lds((const unsigned*)((const char*)(gbase) + (voff)[_i]), (PG8_LAS unsigned*)(lds + (bufoff) + ldsw + _i * 8192), 16, 0, 0); } while (0)
#define PG8_LDA(dst, b, h) do { _Pragma("unroll") for (int m = 0; m < 4; ++m) _Pragma("unroll") for (int k = 0; k < 2; ++k) dst[m][k] = *(const PG8_LAS bf16x8*)(lds + PG8_SA(b, h) + aoff + m * 2048 + k * 1024); } while (0)
#define PG8_LDB(dst, b, h) do { _Pragma("unroll") for (int n = 0; n < 2; ++n) _Pragma("unroll") for (int k = 0; k < 2; ++k) dst[n][k] = *(const PG8_LAS bf16x8*)(lds + PG8_SB(b, h) + boff + n * 2048 + k * 1024); } while (0)
#define PG8_MMA(ai, bj, At, Bt) do { __builtin_amdgcn_s_setprio(1); _Pragma("unroll") for (int m = 0; m < 4; ++m) _Pragma("unroll") for (int n = 0; n < 2; ++n) _Pragma("unroll") for (int k = 0; k < 2; ++k) \
        acc[ai][bj][m][n] = __builtin_amdgcn_mfma_f32_16x16x32_bf16(Bt[n][k], At[m][k], acc[ai][bj][m][n], 0, 0, 0); __builtin_amdgcn_s_setprio(0); } while (0)
#define PG8_WAIT_V(n) asm volatile("s_waitcnt vmcnt(" #n ")" ::: "memory")
#define PG8_WAIT_L(n) asm volatile("s_waitcnt lgkmcnt(" #n ")" ::: "memory")
#define PG8_BAR __builtin_amdgcn_s_barrier()
#define PG8_SCHED __builtin_amdgcn_sched_barrier(0)
    Unit cur, nxt; int ui = 0;
    if (!S.next(0, cur)) return;
    f32x4 acc[2][2][4][2];
#pragma unroll
    for (int a = 0; a < 2; ++a)
#pragma unroll
        for (int b = 0; b < 2; ++b)
#pragma unroll
            for (int m = 0; m < 4; ++m)
#pragma unroll
                for (int n = 0; n < 2; ++n) acc[a][b][m][n] = (f32x4){0.f, 0.f, 0.f, 0.f};
    bf16x8 At[4][2], B0[2][2], B1[2][2];
    const char* cA = (const char*)g.A + (size_t)cur.pm * tstep; const char* cB = (const char*)g.Bt + (size_t)cur.pn * tstep;
    S.a_ready(cur);
    if constexpr (SP2) {
        PG8_STAGE(PG8_SB(0, 0), cB, voffB); PG8_STAGE(PG8_SB(0, 1), cB + hstep, voffB); PG8_STAGE(PG8_SA(0, 0), cA, voffA); PG8_STAGE(PG8_SA(0, 1), cA + hstep, voffA);
        if (wr == 1) PG8_BAR;
        PG8_WAIT_V(2); PG8_BAR;
        PG8_STAGE(PG8_SB(1, 0), cB + kstep, voffB); PG8_STAGE(PG8_SA(1, 0), cA + kstep, voffA); PG8_STAGE(PG8_SB(1, 1), cB + hstep + kstep, voffB);
        PG8_WAIT_V(6); PG8_BAR;
    } else {
        PG8_STAGE(PG8_SB(0, 0), cB, voffB); PG8_STAGE(PG8_SA(0, 0), cA, voffA); PG8_STAGE(PG8_SB(0, 1), cB + hstep, voffB); PG8_STAGE(PG8_SA(0, 1), cA + hstep, voffA);
        if (wr == 1) PG8_BAR;
        PG8_WAIT_V(4); PG8_BAR;
        PG8_STAGE(PG8_SB(1, 0), cB + kstep, voffB); PG8_STAGE(PG8_SA(1, 0), cA + kstep, voffA); PG8_STAGE(PG8_SB(1, 1), cB + hstep + kstep, voffB);
        PG8_WAIT_V(6); PG8_BAR;
    }
    for (;;) {
        const bool has_next = S.next(ui + 1, nxt);
        const char* nA = has_next ? (const char*)g.A + (size_t)nxt.pm * tstep : cA; const char* nB = has_next ? (const char*)g.Bt + (size_t)nxt.pn * tstep : cB;
        for (int t = 0; t < nt; t += 2) {
            const bool last = (t == nt - 2);
            const char* a1 = cA + (size_t)(t + 1) * kstep;
            const char* a2 = last ? nA : cA + (size_t)(t + 2) * kstep; const char* b2 = last ? nB : cB + (size_t)(t + 2) * kstep;
            const char* a3 = a2 + kstep; const char* b3 = b2 + kstep;
            if (last && has_next) S.a_ready(nxt);
            if constexpr (SP2) {
            PG8_LDB(B0, 0, 0); PG8_LDB(B1, 0, 1); PG8_SCHED; PG8_LDA(At, 0, 0); PG8_STAGE(PG8_SA(1, 1), a1 + hstep, voffA);
            PG8_WAIT_V(8); PG8_WAIT_L(0); PG8_BAR; PG8_MMA(0, 0, At, B0); PG8_MMA(0, 1, At, B1); PG8_BAR; PG8_SCHED;
            PG8_LDA(At, 0, 1); PG8_STAGE(PG8_SB(0, 0), b2, voffB); PG8_STAGE(PG8_SB(0, 1), b2 + hstep, voffB); PG8_STAGE(PG8_SA(0, 0), a2, voffA);
            PG8_WAIT_V(8); PG8_WAIT_L(0); PG8_BAR; PG8_MMA(1, 0, At, B0); PG8_MMA(1, 1, At, B1); PG8_BAR; PG8_SCHED;
            PG8_LDB(B0, 1, 0); PG8_LDB(B1, 1, 1); PG8_SCHED; PG8_LDA(At, 1, 0); PG8_STAGE(PG8_SA(0, 1), a2 + hstep, voffA);
            PG8_WAIT_V(8); PG8_WAIT_L(0); PG8_BAR; PG8_MMA(0, 0, At, B0); PG8_MMA(0, 1, At, B1); PG8_BAR; PG8_SCHED;
            PG8_LDA(At, 1, 1); PG8_STAGE(PG8_SB(1, 0), b3, voffB); PG8_STAGE(PG8_SB(1, 1), b3 + hstep, voffB); PG8_STAGE(PG8_SA(1, 0), a3, voffA);
            PG8_WAIT_V(8); PG8_WAIT_L(0); PG8_BAR; PG8_MMA(1, 0, At, B0); PG8_MMA(1, 1, At, B1); PG8_BAR; PG8_SCHED;
            } else {
            PG8_LDB(B0, 0, 0); PG8_SCHED; PG8_LDA(At, 0, 0); PG8_STAGE(PG8_SA(1, 1), a1 + hstep, voffA);
            PG8_WAIT_L(8); PG8_BAR; PG8_WAIT_L(0); PG8_MMA(0, 0, At, B0); PG8_BAR; PG8_SCHED;
            PG8_LDB(B1, 0, 1); PG8_STAGE(PG8_SB(0, 0), b2, voffB);
            PG8_BAR; PG8_WAIT_L(0); PG8_MMA(0, 1, At, B1); PG8_BAR;
            PG8_LDA(At, 0, 1); PG8_STAGE(PG8_SA(0, 0), a2, voffA);
            PG8_BAR; PG8_WAIT_L(0); PG8_MMA(1, 0, At, B0); PG8_BAR; PG8_SCHED;
            PG8_STAGE(PG8_SB(0, 1), b2 + hstep, voffB);
            PG8_WAIT_V(6); PG8_BAR; PG8_MMA(1, 1, At, B1); PG8_BAR;
            PG8_LDB(B0, 1, 0); PG8_SCHED; PG8_LDA(At, 1, 0); PG8_STAGE(PG8_SA(0, 1), a2 + hstep, voffA);
            PG8_WAIT_L(8); PG8_BAR; PG8_WAIT_L(0); PG8_MMA(0, 0, At, B0); PG8_BAR; PG8_SCHED;
            PG8_LDB(B1, 1, 1); PG8_STAGE(PG8_SB(1, 0), b3, voffB);
            PG8_BAR; PG8_WAIT_L(0); PG8_MMA(0, 1, At, B1); PG8_BAR;
            PG8_LDA(At, 1, 1); PG8_STAGE(PG8_SA(1, 0), a3, voffA);
            PG8_BAR; PG8_WAIT_L(0); PG8_MMA(1, 0, At, B0); PG8_BAR; PG8_SCHED;
            PG8_STAGE(PG8_SB(1, 1), b3 + hstep, voffB);
            PG8_WAIT_V(6); PG8_BAR; PG8_MMA(1, 1, At, B1); PG8_BAR;
            }
        }
        if constexpr (ALIGN_EPI) { if (wr == 0) PG8_BAR; }
        if constexpr (!Epi::AFTER_DRAIN) { E(acc, cur, wr, wc, fr, fq); S.done(cur); }
        if (!has_next) break;
#pragma unroll
        for (int a = 0; a < 2; ++a)
#pragma unroll
            for (int b = 0; b < 2; ++b)
#pragma unroll
                for (int m = 0; m < 4; ++m)
#pragma unroll
                    for (int n = 0; n < 2; ++n) acc[a][b][m][n] = (f32x4){0.f, 0.f, 0.f, 0.f};
        cur = nxt; cA = nA; cB = nB; ++ui;
        if constexpr (ALIGN_EPI) { if (wr == 1) PG8_BAR; }
    }
    PG8_WAIT_V(0);
    if constexpr (!ALIGN_EPI) { if (wr == 0) PG8_BAR; }
    PG8_BAR;
    if constexpr (Epi::AFTER_DRAIN) { E.fused(acc, cur, wr, wc, fr, fq, lds, wid, lane); S.done(cur); }
#undef PG8_SA
#undef PG8_SB
#undef PG8_STAGE
#undef PG8_LDA
#undef PG8_LDB
#undef PG8_MMA
#undef PG8_WAIT_V
#undef PG8_WAIT_L
#undef PG8_BAR
#undef PG8_SCHED
}
}

constexpr int NWAVES = 8;
constexpr int D = 4096, M = 32768, SEQ_P = 16384, SEQ_S = 2048;
constexpr int ATTN_W = 2048, KV_W = 512, D_RNN = 4096, D_FF = 12288, PLE = 256, IN_W = 11264;
constexpr int MSB = 8192, NSB = M / MSB;
constexpr int NBOUND = SEQ_P / MSB - 1;
constexpr int LCH = 32, NCHUNK = M / LCH;
constexpr float EPS = 1e-6f;
constexpr float LOG2E = 1.4426950408889634f;

constexpr size_t MiB = 1u << 20;
constexpr size_t WS_CTL = 0, CTL_ZERO_BYTES = 1 * MiB;
constexpr size_t WS_H = 1 * MiB;
constexpr size_t WS_Q = WS_H + 256 * MiB;
constexpr size_t WS_K = WS_Q + 128 * MiB;
constexpr size_t WS_V = WS_K + 32 * MiB;
constexpr size_t WS_REC = WS_V + 32 * MiB;
constexpr size_t WS_G = WS_REC + 256 * MiB;
constexpr size_t WS_MRG = WS_G + 256 * MiB;
constexpr size_t WS_AGG = WS_MRG + 256 * MiB;
constexpr size_t WS_CIN = WS_AGG + 64 * MiB;
constexpr size_t WS_W1 = WS_CIN + 32 * MiB;
constexpr size_t WS_WIN = WS_W1;
constexpr size_t WS_WG = WS_WIN + 88 * MiB;
constexpr size_t WS_WOA = WS_WG + 64 * MiB;
constexpr size_t WS_WOR = WS_WOA + 16 * MiB;
constexpr size_t WS_WOUT = WS_WOR + 32 * MiB;
constexpr size_t WS_LWA = WS_WOUT + 32 * MiB;
constexpr size_t WS_LWX = WS_LWA + 4 * MiB;
constexpr size_t WS_END1 = WS_LWX + 4 * MiB;
constexpr size_t WS_HN2 = 1 * MiB;
constexpr size_t WS_X2B = WS_HN2;
constexpr size_t WS_WUP = WS_HN2 + 256 * MiB;
constexpr size_t WS_WDN = WS_WUP + 192 * MiB;
constexpr size_t WS_WPG = WS_WDN + 96 * MiB;
constexpr size_t WS_WPL = WS_WPG + 32 * MiB;
constexpr size_t WS_PB = WS_WPL + 2 * MiB;
constexpr size_t WS_SS = WS_PB + 16 * MiB;
constexpr size_t WS_RSE = WS_SS + 8 * MiB;
constexpr size_t WS_YB = WS_RSE + 1 * MiB;
constexpr size_t WS_ACT = WS_YB + 96 * MiB;
constexpr size_t WS_END2 = WS_ACT + 768 * MiB;
constexpr size_t WS_EU = WS_ACT;
constexpr size_t WS_X3B = WS_ACT + 256 * MiB;
constexpr size_t WS_NEED = (WS_END1 > WS_END2 ? WS_END1 : WS_END2);
static_assert(WS_NEED <= (size_t)1664 * MiB, "d_ws map exceeds the guaranteed workspace");
constexpr int CW_BAR = 4096;

constexpr int RING_OFF = 0;
#ifndef LRU_PITCH
#define LRU_PITCH 264
#endif
constexpr int LRU_P = LRU_PITCH;
constexpr int L_XCF = 0, L_AS = L_XCF + LCH * LRU_P * 4, L_BS = L_AS + LCH * LRU_P * 4, L_HS = L_BS + LCH * LRU_P * 4, L_XCB = L_HS + LCH * LRU_P * 4, L_END = L_XCB + LCH * LRU_P * 2;
constexpr int VT_PITCH = 816;
constexpr int MISC_OFF = 153600, L_KC = MISC_OFF + 512, LDS_BYTES = L_KC + 6 * 256 * 4;
static_assert(L_END <= MISC_OFF && 128 * VT_PITCH <= MISC_OFF && 131072 <= MISC_OFF, "LDS map");

#define GAS __attribute__((address_space(1)))
#define LAS __attribute__((address_space(3)))
typedef unsigned short bf16;
typedef unsigned v4u __attribute__((ext_vector_type(4)));
typedef unsigned v2u __attribute__((ext_vector_type(2)));
typedef float f32x4 __attribute__((ext_vector_type(4)));
typedef float f32x16 __attribute__((ext_vector_type(16)));
typedef float f32x2 __attribute__((ext_vector_type(2)));
typedef short bf16x8 __attribute__((ext_vector_type(8)));
typedef GAS unsigned gu32;
#define RLX_AGENT __ATOMIC_RELAXED, __HIP_MEMORY_SCOPE_AGENT
#define LDS_WAIT() asm volatile("s_waitcnt lgkmcnt(0)" ::: "memory")
#define VM_WAIT() asm volatile("s_waitcnt vmcnt(0)" ::: "memory")
__device__ __forceinline__ unsigned f2bf(float f) { unsigned u = __builtin_bit_cast(unsigned, f); return (u + 0x7fffu + ((u >> 16) & 1u)) >> 16; }
__device__ __forceinline__ unsigned pk2(float lo, float hi) { return f2bf(lo) | (f2bf(hi) << 16); }
using pg8::fsigmoid; using pg8::fgelu; using pg8::bf_lo; using pg8::bf_hi;

#define XB_TMO      128
#define XB_XCNT(j)  (256  + 64 * (j))
#define XB_XSUB(j)  (1280 + 64 * (j))
#define XB_XGEN(j)  (2304 + 64 * (j))
#define XB_TOP      3328
#define XB_TOPGEN   3392
#define XCD_BAR_WORDS 3456
#define XB_SPIN_CAP (1u << 18)

__device__ __forceinline__ unsigned xb_ld(unsigned* p)              { return __hip_atomic_load(p, __ATOMIC_RELAXED, __HIP_MEMORY_SCOPE_AGENT); }
__device__ __forceinline__ unsigned xb_add(unsigned* p, unsigned v) { return __hip_atomic_fetch_add(p, v, __ATOMIC_RELAXED, __HIP_MEMORY_SCOPE_AGENT); }
__device__ __forceinline__ unsigned xb_xcc_id() { return (unsigned)__builtin_amdgcn_s_getreg((3 << 11) | 20) & 0xFu; }
#define XB_SPIN(cond, bar) do { unsigned _sp = 0; while (cond) { __builtin_amdgcn_s_sleep(1); \
    if ((++_sp & 255u) == 0u) { if (xb_ld(&(bar)[XB_TMO])) break; if (_sp > XB_SPIN_CAP) { atomicAdd(&(bar)[XB_TMO], 1u); break; } } } } while (0)

struct XcdBarrier {
    unsigned* bar; unsigned x;
    volatile LAS unsigned* st;
};

__device__ __forceinline__ XcdBarrier xcd_barrier_post(unsigned* bar, volatile LAS unsigned* st) {
    XcdBarrier b; b.bar = bar; b.x = xb_xcc_id(); b.st = st;
    if (threadIdx.x == 0) (void)xb_add(&bar[XB_XCNT(b.x)], 1u);
    return b;
}
__device__ __forceinline__ void xcd_barrier_complete(unsigned* bar, unsigned x, unsigned& nloc, unsigned& nx) {
    const unsigned G = gridDim.x * gridDim.y * gridDim.z;
    unsigned sum, cnt, mine, sp = 0u;
    for (;;) {
        sum = 0u; cnt = 0u; mine = 0u;
#pragma unroll
        for (unsigned j = 0; j < 16; ++j) { const unsigned c = xb_ld(&bar[XB_XCNT(j)]); sum += c; cnt += (c > 0u) ? 1u : 0u; mine = (j == x) ? c : mine; }
        if (sum == G) break;
        __builtin_amdgcn_s_sleep(1);
        if ((++sp & 255u) == 0u) { if (xb_ld(&bar[XB_TMO])) break; if (sp > XB_SPIN_CAP) { atomicAdd(&bar[XB_TMO], 1u); break; } }
    }
    nloc = mine > 0u ? mine : 1u; nx = cnt > 0u ? cnt : 1u;
}

__device__ __forceinline__ void xcd_barrier(const XcdBarrier& b, const int tid) {
    asm volatile("s_waitcnt vmcnt(0)" ::: "memory");
    __syncthreads();
    if (tid == 0) {
        unsigned* bar = b.bar;
        __builtin_amdgcn_s_waitcnt(0);
        unsigned nloc = b.st[0], nx = b.st[1];
        if (nloc == 0u) { xcd_barrier_complete(bar, b.x, nloc, nx); b.st[0] = nloc; b.st[1] = nx; }
        const unsigned old = xb_add(&bar[XB_XSUB(b.x)], 1u);
        const unsigned gen = old / nloc;
        if (old + 1u == (gen + 1u) * nloc) {
            __builtin_amdgcn_fence(__ATOMIC_RELEASE, "agent");
            asm volatile("s_waitcnt vmcnt(0)" ::: "memory");
            const unsigned og = xb_add(&bar[XB_TOP], 1u);
            const unsigned tg = og / nx;
            if (og + 1u == (tg + 1u) * nx) xb_add(&bar[XB_TOPGEN], 1u);
            else XB_SPIN(xb_ld(&bar[XB_TOPGEN]) == tg, bar);
            __builtin_amdgcn_fence(__ATOMIC_ACQUIRE, "agent");
            xb_add(&bar[XB_XGEN(b.x)], 1u);
            asm volatile("s_waitcnt vmcnt(0)" ::: "memory");
        } else {
            XB_SPIN(xb_ld(&bar[XB_XGEN(b.x)]) == gen, bar);
            __builtin_amdgcn_fence(__ATOMIC_ACQUIRE, "agent");
            asm volatile("s_waitcnt vmcnt(0)" ::: "memory");
        }
    }
    __syncthreads();
}

struct Frame {
    LAS unsigned char* lds;
    volatile LAS unsigned* MISC;
    gu32* ctl;
    int tid, lane, wave;
    int vcu, G;
};
__device__ __forceinline__ float wave_sum(float v) {
#pragma unroll
    for (int o = 1; o < 64; o <<= 1) v += __shfl_xor(v, o);
    return v;
}
__device__ __forceinline__ void seq_bounds(int row, int& s0, int& s1) { if (row < SEQ_P) { s0 = 0; s1 = SEQ_P; } else { s0 = row & ~(SEQ_S - 1); s1 = s0 + SEQ_S; } }

__device__ __forceinline__ void tr_load(const float* src, int N, int lane, float (&v)[32]) {
#pragma unroll
    for (int i = 0; i < 32; ++i) v[i] = src[(size_t)(2 * i + (lane >> 5)) * N + (lane & 31)];
}
__device__ __forceinline__ void tr_store(const float (&v)[32], bf16* dst, int K, LAS float* scr, int lane) {
#pragma unroll
    for (int i = 0; i < 32; ++i) scr[(2 * i + (lane >> 5)) * 33 + (lane & 31)] = v[i];
    LDS_WAIT(); asm volatile("" ::: "memory");
    const int c = lane & 7;
#pragma unroll
    for (int j = 0; j < 4; ++j) { const int n = (lane >> 3) + 8 * j; const LAS float* s = scr + (8 * c) * 33 + n;
        v4u o; o.x = pk2(s[0 * 33], s[1 * 33]); o.y = pk2(s[2 * 33], s[3 * 33]); o.z = pk2(s[4 * 33], s[5 * 33]); o.w = pk2(s[6 * 33], s[7 * 33]);
        *(GAS v4u*)(dst + (size_t)n * K + 8 * c) = o; }
    LDS_WAIT(); asm volatile("" ::: "memory");
}
__device__ __forceinline__ void convert_weight(Frame& F, const float* W, int K, int N, int nmat, bf16* WT) {
    LAS float* scr = (LAS float*)(F.lds + RING_OFF + F.wave * 16384);
    const int gw = F.vcu * NWAVES + F.wave, NGW = F.G * NWAVES, lane = F.lane;
    const int nblk = N / 32, per = (K / 64) * nblk, total = per * nmat;
#define CW_SRC(it) (W + (size_t)((it) / per) * K * N + (size_t)(64 * (((it) % per) / nblk)) * N + 32 * (((it) % per) % nblk))
#define CW_DST(it) (WT + (size_t)((it) / per) * K * N + (size_t)(32 * (((it) % per) % nblk)) * K + 64 * (((it) % per) / nblk))
    float cur[32], nxt[32];
    int it = gw; if (it < total) tr_load(CW_SRC(it), N, lane, cur);
    for (; it < total; it += NGW) { const int nit = it + NGW;
        if (nit < total) tr_load(CW_SRC(nit), N, lane, nxt);
        tr_store(cur, CW_DST(it), K, scr, lane);
#pragma unroll
        for (int i = 0; i < 32; ++i) cur[i] = nxt[i]; }
#undef CW_SRC
#undef CW_DST
}
__device__ __forceinline__ void rms_brow_to_bf16(const bf16* xrow, const float* g, bf16* orow, int lane) {
    const GAS v4u* xr = (const GAS v4u*)xrow + lane;
    v4u v[8]; float s = 0.f;
#pragma unroll
    for (int j = 0; j < 8; ++j) { v[j] = xr[64 * j];
        const float a0 = bf_lo(v[j].x), a1 = bf_hi(v[j].x), a2 = bf_lo(v[j].y), a3 = bf_hi(v[j].y), a4 = bf_lo(v[j].z), a5 = bf_hi(v[j].z), a6 = bf_lo(v[j].w), a7 = bf_hi(v[j].w);
        s += ((a0 * a0 + a1 * a1) + (a2 * a2 + a3 * a3)) + ((a4 * a4 + a5 * a5) + (a6 * a6 + a7 * a7)); }
    const float rstd = 1.0f / sqrtf(wave_sum(s) * (1.f / D) + EPS);
    const GAS f32x4* gr = (const GAS f32x4*)g + 2 * lane;
    GAS v4u* o8 = (GAS v4u*)orow + lane;
#pragma unroll
    for (int j = 0; j < 8; ++j) { const f32x4 g0 = gr[128 * j], g1 = gr[128 * j + 1]; v4u w;
        w.x = pk2(bf_lo(v[j].x) * rstd * g0.x, bf_hi(v[j].x) * rstd * g0.y); w.y = pk2(bf_lo(v[j].y) * rstd * g0.z, bf_hi(v[j].y) * rstd * g0.w);
        w.z = pk2(bf_lo(v[j].z) * rstd * g1.x, bf_hi(v[j].z) * rstd * g1.y); w.w = pk2(bf_lo(v[j].w) * rstd * g1.z, bf_hi(v[j].w) * rstd * g1.w); o8[64 * j] = w; }
}
__device__ __forceinline__ void rms_row_to_bf16(const float* xrow, const float* g, bf16* orow, int lane) {
    const GAS f32x4* xr = (const GAS f32x4*)xrow + lane;
    f32x4 v[16]; float s = 0.f;
#pragma unroll
    for (int j = 0; j < 16; ++j) { v[j] = xr[64 * j]; s += (v[j].x * v[j].x + v[j].y * v[j].y) + (v[j].z * v[j].z + v[j].w * v[j].w); }
    const float rstd = 1.0f / sqrtf(wave_sum(s) * (1.f / D) + EPS);
    const GAS f32x4* gr = (const GAS f32x4*)g + lane;
    GAS v2u* o8 = (GAS v2u*)orow + lane;
#pragma unroll
    for (int j = 0; j < 16; ++j) { const f32x4 gv = gr[64 * j]; v2u w; w.x = pk2(v[j].x * rstd * gv.x, v[j].y * rstd * gv.y); w.y = pk2(v[j].z * rstd * gv.z, v[j].w * rstd * gv.w); o8[64 * j] = w; }
}

__device__ __forceinline__ void attn_unit(Frame& F, const bf16* Qb, const bf16* Kb, const bf16* Vb, bf16* Ob, const float* sink, int qblk, int hkv) {
    LAS unsigned char* lds = F.lds;
    const int lane = F.lane, wave = F.wave;
    const int row_blk = qblk * 128; int s0, s1; seq_bounds(row_blk, s0, s1);
    const int kbase = row_blk - 128;
    __syncthreads();
#pragma unroll
    for (int oo = 0; oo < 2; ++oo) { const int o = 2 * wave + oo;
#pragma unroll
        for (int j = 0; j < 4; ++j) { const int kp = lane + 64 * j;
            if (kp < 200) { const int r0 = kbase + 2 * kp;
                v4u a = (v4u){0u, 0u, 0u, 0u}, b = a;
                if (r0 >= s0 && r0 < s1) { a = *(const GAS v4u*)(Vb + (size_t)r0 * KV_W + hkv * 128 + 8 * o); b = *(const GAS v4u*)(Vb + (size_t)(r0 + 1) * KV_W + hkv * 128 + 8 * o); }
                LAS unsigned char* dst = lds + (8 * o) * VT_PITCH + 4 * kp;
                *(LAS unsigned*)(dst + 0 * VT_PITCH) = (a.x & 0xffffu) | (b.x << 16);
                *(LAS unsigned*)(dst + 1 * VT_PITCH) = (a.x >> 16) | (b.x & 0xffff0000u);
                *(LAS unsigned*)(dst + 2 * VT_PITCH) = (a.y & 0xffffu) | (b.y << 16);
                *(LAS unsigned*)(dst + 3 * VT_PITCH) = (a.y >> 16) | (b.y & 0xffff0000u);
                *(LAS unsigned*)(dst + 4 * VT_PITCH) = (a.z & 0xffffu) | (b.z << 16);
                *(LAS unsigned*)(dst + 5 * VT_PITCH) = (a.z >> 16) | (b.z & 0xffff0000u);
                *(LAS unsigned*)(dst + 6 * VT_PITCH) = (a.w & 0xffffu) | (b.w << 16);
                *(LAS unsigned*)(dst + 7 * VT_PITCH) = (a.w >> 16) | (b.w & 0xffff0000u);
            } } }
    __syncthreads();
    const int qn = lane & 15, quad = lane >> 4;
    const int r0q = row_blk + 16 * wave, ks = r0q - 128, tq = r0q + qn;
    const unsigned kvoff = (unsigned)(qn * KV_W + 8 * quad) * 2u;
    for (int gp = 0; gp < 2; ++gp) {
        bf16x8 qf[2][4];
#pragma unroll
        for (int h = 0; h < 2; ++h)
#pragma unroll
            for (int kk = 0; kk < 4; ++kk) qf[h][kk] = *(const GAS bf16x8*)(Qb + (size_t)tq * ATTN_W + (hkv * 4 + 2 * gp + h) * 128 + 32 * kk + 8 * quad);
        f32x4 s[2][18];
#define ATT_SB __builtin_amdgcn_sched_barrier(0)
#define ATT_KLOAD(buf, t) do { int trow = ksu + 16 * (t); trow = trow < 0 ? 0 : (trow > M - 16 ? M - 16 : trow); \
            const GAS char* kp = (const GAS char*)(Kb + (size_t)trow * KV_W + hkv * 128) + kvoff; _Pragma("unroll") for (int kk = 0; kk < 4; ++kk) buf[kk] = *(const GAS bf16x8*)(kp + 64 * kk); } while (0)
#define ATT_KMMA(buf, t) do { _Pragma("unroll") for (int h = 0; h < 2; ++h) { f32x4 acc = (f32x4){0.f, 0.f, 0.f, 0.f}; \
            _Pragma("unroll") for (int kk = 0; kk < 4; ++kk) acc = __builtin_amdgcn_mfma_f32_16x16x32_bf16(buf[kk], qf[h][kk], acc, 0, 0, 0); s[h][t] = acc; } } while (0)
        const int ksu = __builtin_amdgcn_readfirstlane(ks);
        bf16x8 ka[4], kb2[4];
        ATT_KLOAD(ka, 0); ATT_KLOAD(kb2, 1); ATT_SB;
#pragma unroll
        for (int t = 0; t < 18; t += 2) {
            ATT_KMMA(ka, t); ATT_SB; if (t + 2 < 18) { ATT_KLOAD(ka, t + 2); ATT_SB; }
            ATT_KMMA(kb2, t + 1); ATT_SB; if (t + 3 < 18) { ATT_KLOAD(kb2, t + 3); ATT_SB; } }
#undef ATT_KLOAD
#undef ATT_KMMA
#pragma unroll
        for (int h = 0; h < 2; ++h) { const int hq = hkv * 4 + 2 * gp + h;
        const float slope2 = exp2f(-0.5f * (float)(hq + 1)) * LOG2E, sink2 = sink[hq] * LOG2E;
        float mx = -3.0e38f;
        int kso = ks; asm volatile("" : "+v"(kso));
#pragma unroll
        for (int t = 0; t < 18; ++t)
#pragma unroll
            for (int r = 0; r < 4; ++r) { const int tk = kso + 16 * t + 4 * quad + r; int dist = tq - tk; dist = dist < 0 ? -dist : dist;
                const bool ok = (dist <= 128) && (tk >= s0) && (tk < s1);
                const float v = ok ? s[h][t][r] - slope2 * (float)dist : -1.0e30f; s[h][t][r] = v; mx = fmaxf(mx, v); }
        mx = fmaxf(mx, __shfl_xor(mx, 16)); mx = fmaxf(mx, __shfl_xor(mx, 32)); mx = fmaxf(mx, sink2);
        float l = 0.f;
#pragma unroll
        for (int t = 0; t < 18; ++t)
#pragma unroll
            for (int r = 0; r < 4; ++r) { const float p = __builtin_amdgcn_exp2f(s[h][t][r] - mx); s[h][t][r] = p; l += p; }
        l += __shfl_xor(l, 16); l += __shfl_xor(l, 32); l += __builtin_amdgcn_exp2f(sink2 - mx);
        const float inv = 1.0f / l;
        f32x4 o[8];
#pragma unroll
        for (int dt = 0; dt < 8; ++dt) o[dt] = (f32x4){0.f, 0.f, 0.f, 0.f};
#define ATT_VLOAD(j) do { _Pragma("unroll") for (int dt = 0; dt < 8; ++dt) { const LAS unsigned char* vp = lds + (16 * dt + qn) * VT_PITCH + 2 * (16 * wave + 32 * (j) + 4 * quad); \
            const v2u v0 = *(const LAS v2u*)vp, v1 = *(const LAS v2u*)(vp + 32); v4u vw; vw.x = v0.x; vw.y = v0.y; vw.z = v1.x; vw.w = v1.y; vf[dt] = __builtin_bit_cast(bf16x8, vw); } } while (0)
        bf16x8 vf[8];
        ATT_VLOAD(0); ATT_SB;
#pragma unroll
        for (int j = 0; j < 9; ++j) {
            v4u pw; pw.x = pg8::cvt_pk_bf16(s[h][2 * j][0], s[h][2 * j][1]); pw.y = pg8::cvt_pk_bf16(s[h][2 * j][2], s[h][2 * j][3]); pw.z = pg8::cvt_pk_bf16(s[h][2 * j + 1][0], s[h][2 * j + 1][1]); pw.w = pg8::cvt_pk_bf16(s[h][2 * j + 1][2], s[h][2 * j + 1][3]);
            const bf16x8 pb = __builtin_bit_cast(bf16x8, pw);
            ATT_SB;
#pragma unroll
            for (int dt = 0; dt < 8; ++dt) o[dt] = __builtin_amdgcn_mfma_f32_16x16x32_bf16(vf[dt], pb, o[dt], 0, 0, 0);
            ATT_SB;
            if (j < 8) { ATT_VLOAD(j + 1); ATT_SB; } }
#undef ATT_VLOAD
#pragma unroll
        for (int dt = 0; dt < 8; ++dt) { v2u w; w.x = pg8::cvt_pk_bf16(o[dt][0] * inv, o[dt][1] * inv); w.y = pg8::cvt_pk_bf16(o[dt][2] * inv, o[dt][3] * inv);
            *(GAS v2u*)(Ob + (size_t)tq * ATTN_W + hq * 128 + 16 * dt + 4 * quad) = w; }
        }
#undef ATT_SB
    }
}

__device__ __forceinline__ void unpack_row(const v4u x, float (&o)[8]) { o[0] = bf_lo(x.x); o[1] = bf_hi(x.x); o[2] = bf_lo(x.y); o[3] = bf_hi(x.y); o[4] = bf_lo(x.z); o[5] = bf_hi(x.z); o[6] = bf_lo(x.w); o[7] = bf_hi(x.w); }
__device__ __forceinline__ void load8f(const float* p, float (&o)[8]) { const f32x4 a = *(const GAS f32x4*)p, b = *(const GAS f32x4*)(p + 4); o[0] = a.x; o[1] = a.y; o[2] = a.z; o[3] = a.w; o[4] = b.x; o[5] = b.y; o[6] = b.z; o[7] = b.w; }
__device__ __forceinline__ v4u xr_row(const bf16* XR, int r, int s0, int s1, int c0) { if (r < s0 || r >= s1) return (v4u){0u, 0u, 0u, 0u}; return *(const GAS v4u*)(XR + (size_t)r * D_RNN + c0); }
__device__ __forceinline__ void conv_phase(Frame& F, const bf16* XR, const float* cw, const float* cb, bf16* XC) {
    const int gt = (F.vcu * NWAVES + F.wave) * 64 + F.lane, NGT = F.G * NWAVES * 64;
    constexpr int NOCT = D_RNN / 8, RUN = 32;
    for (int it = gt; it < (M / RUN) * NOCT; it += NGT) { const int oc = it % NOCT, run = it / NOCT, c0 = 8 * oc, t0 = run * RUN;
        int s0, s1; seq_bounds(t0, s0, s1);
        float w[4][8], bias[8];
#pragma unroll
        for (int k = 0; k < 4; ++k) load8f(cw + (size_t)k * D_RNN + c0, w[k]);
        load8f(cb + c0, bias);
        float xm[8], x0[8], x1[8];
        unpack_row(xr_row(XR, t0 - 1, s0, s1, c0), xm); unpack_row(xr_row(XR, t0, s0, s1, c0), x0); unpack_row(xr_row(XR, t0 + 1, s0, s1, c0), x1);
        for (int i = 0; i < RUN; i += 4) { v4u pv[4];
#pragma unroll
            for (int q = 0; q < 4; ++q) pv[q] = xr_row(XR, t0 + i + q + 2, s0, s1, c0);
#pragma unroll
            for (int q = 0; q < 4; ++q) { float x2[8], o[8]; unpack_row(pv[q], x2);
#pragma unroll
                for (int e = 0; e < 8; ++e) { o[e] = bias[e] + w[0][e] * xm[e] + w[1][e] * x0[e] + w[2][e] * x1[e] + w[3][e] * x2[e]; xm[e] = x0[e]; x0[e] = x1[e]; x1[e] = x2[e]; }
                v4u pw; pw.x = pk2(o[0], o[1]); pw.y = pk2(o[2], o[3]); pw.z = pk2(o[4], o[5]); pw.w = pk2(o[6], o[7]);
                *(GAS v4u*)(XC + (size_t)(t0 + i + q) * D_RNN + c0) = pw; } }
    }
}
__device__ __forceinline__ void conv_fix_phase(Frame& F, const bf16* XB, const float* cw, const float* cb, bf16* XC) {
    const int gt = (F.vcu * NWAVES + F.wave) * 64 + F.lane, NGT = F.G * NWAVES * 64;
    constexpr int NOCT = D_RNN / 8;
    for (int it = gt; it < (M / 64) * 3 * NOCT; it += NGT) { const int oc = it % NOCT, q = (it / NOCT) % 3, seg = it / (3 * NOCT), c0 = 8 * oc, t = seg * 64 + (q == 0 ? 0 : 61 + q);
        int s0, s1; seq_bounds(t, s0, s1);
        float o[8]; load8f(cb + c0, o);
#pragma unroll
        for (int k = 0; k < 4; ++k) { const int tt = t - 1 + k;
            if (tt >= s0 && tt < s1) { const int sg = tt >> 6, rr = tt & 63, slot = rr < 3 ? rr : rr - 58; float x[8], w[8];
                unpack_row(*(const GAS v4u*)(XB + ((size_t)sg * 6 + slot) * D_RNN + c0), x); load8f(cw + (size_t)k * D_RNN + c0, w);
#pragma unroll
                for (int e = 0; e < 8; ++e) o[e] += w[e] * x[e]; } }
        v4u pw; pw.x = pk2(o[0], o[1]); pw.y = pk2(o[2], o[3]); pw.z = pk2(o[4], o[5]); pw.w = pk2(o[6], o[7]);
        *(GAS v4u*)(XC + (size_t)t * D_RNN + c0) = pw; }
}
__device__ __forceinline__ void lru_load_b(bf16x8 (&wb)[32], const bf16* WA, const bf16* WX, int dir, int n, int wave, int lane) {
    const size_t o = ((size_t)((dir * 16 + n) * 8 + wave) * 16 * 64 + lane) * 8;
#pragma unroll
    for (int kk = 0; kk < 16; ++kk) { wb[kk] = *(const GAS bf16x8*)(WA + o + (size_t)kk * 512); wb[16 + kk] = *(const GAS bf16x8*)(WX + o + (size_t)kk * 512); }
}
__device__ __forceinline__ void convert_lru_weight(Frame& F, const float* W, bf16* WT) {
    const int gt = (F.vcu * NWAVES + F.wave) * 64 + F.lane, NGT = F.G * NWAVES * 64;
    for (int it = gt; it < 32 * 8 * 16 * 64; it += NGT) { const int lane = it & 63, kk = (it >> 6) & 15, w = (it >> 10) & 7, mat = it >> 13;
        const int d = 32 * w + (lane & 31), c0 = 16 * kk + 8 * (lane >> 5); const float* src = W + ((size_t)mat * 256 + c0) * 256 + d;
        const float sc = -LOG2E;
        v4u o; o.x = pk2(sc * src[0], sc * src[256]); o.y = pk2(sc * src[512], sc * src[768]); o.z = pk2(sc * src[1024], sc * src[1280]); o.w = pk2(sc * src[1536], sc * src[1792]);
        *(GAS v4u*)(WT + (size_t)it * 8) = o; }
}
template <int DIR, bool WANT_H>
__device__ __forceinline__ void lane_scan(const f32x16& a, const f32x16& b, int hs, float cin, float& Ptot, float& Hfin, f32x16& hout) {
    float P[4], Hh[4], Pp[4], Hp[4], cown[4];
#pragma unroll
    for (int g = 0; g < 4; ++g) { float p = 1.f, hh = 0.f;
#pragma unroll
        for (int jj = 0; jj < 4; ++jj) { const int i = 4 * g + (DIR ? 3 - jj : jj); hh = a[i] * hh + b[i]; p *= a[i]; }
        P[g] = p; Hh[g] = hh; }
#pragma unroll
    for (int g = 0; g < 4; ++g) { Pp[g] = __shfl_xor(P[g], 32); Hp[g] = __shfl_xor(Hh[g], 32); }
    float cst = cin, ptot = 1.f;
#pragma unroll
    for (int gg = 0; gg < 4; ++gg) { const int g = DIR ? 3 - gg : gg;
        const float Pe = hs ? Pp[g] : P[g], He = hs ? Hp[g] : Hh[g];
        const float Po = hs ? P[g] : Pp[g], Ho = hs ? Hh[g] : Hp[g];
        float ce, co;
        if (!DIR) { ce = cst; cst = Pe * cst + He; co = cst; cst = Po * cst + Ho; }
        else { co = cst; cst = Po * cst + Ho; ce = cst; cst = Pe * cst + He; }
        cown[g] = hs ? co : ce; ptot *= Pe * Po; }
    Ptot = ptot; Hfin = cst;
    if (WANT_H) {
#pragma unroll
        for (int g = 0; g < 4; ++g) { float hc = cown[g];
#pragma unroll
            for (int jj = 0; jj < 4; ++jj) { const int i = 4 * g + (DIR ? 3 - jj : jj); hc = a[i] * hc + b[i]; hout[i] = hc; } }
    }
}
struct LruArgs { const bf16 *XC, *YR; const bf16 *WA, *WX; const float *ba, *bx, *lam; float* AGG; const float* CIN; bf16 *TMPH, *REC; };
constexpr int LT_PITCH = 528, LT_BYTES = 32 * LT_PITCH;
template <bool FINAL, int DIR, int NJ>
__device__ __forceinline__ void lru_dir_pass(Frame& F, const LruArgs& A, int n, int cbase, float hin, float& Pacc, float& Hacc) {
    LAS unsigned char* lds = F.lds;
    const int tid = F.tid, lane = F.lane, wave = F.wave, cl = lane & 31, hs = lane >> 5;
    const int chb = n * 256, ch = chb + 32 * wave + cl;
    const int trow = tid >> 4, tseg = tid & 15;
    bf16x8 wb[32]; lru_load_b(wb, A.WA, A.WX, DIR, n, wave, lane);
    const float bav = -LOG2E * A.ba[DIR * D_RNN + ch], bxv = -LOG2E * A.bx[DIR * D_RNN + ch], c2 = (-8.0f * LOG2E) * log1pf(expf(-A.lam[DIR * D_RNN + ch]));
#define LRU_CHUNK(jj) (cbase + (DIR ? NJ - 1 - (jj) : (jj)))
    float hstate = hin, pacc = 1.f;
    v4u tp0;
    __syncthreads();
#pragma unroll 1
    for (int c = 0; c < 4; ++c) { const bf16* src = A.XC + (size_t)(LRU_CHUNK(c) * LCH + trow) * D_RNN + chb + 16 * tseg; tp0 = *(const GAS v4u*)src; *(LAS v4u*)(lds + c * LT_BYTES + trow * LT_PITCH + 32 * tseg) = tp0; tp0 = *(const GAS v4u*)(src + 8); *(LAS v4u*)(lds + c * LT_BYTES + trow * LT_PITCH + 32 * tseg + 16) = tp0; }
    for (int j = 0; j < NJ; ++j) { const int chunk = LRU_CHUNK(j), row0 = chunk * LCH;
        LAS unsigned char* T = lds + (j & 7) * LT_BYTES;
        if ((j & 3) == 0) __syncthreads();
        const bf16* nsrc = A.XC + (size_t)(LRU_CHUNK(j + 4) * LCH + trow) * D_RNN + chb + 16 * tseg; LAS unsigned char* Tn = lds + ((j + 4) & 7) * LT_BYTES + trow * LT_PITCH + 32 * tseg;
        if (j + 4 < NJ) tp0 = *(const GAS v4u*)nsrc;
        const float cin = hstate;
        v4u th0, th1; const size_t tmo = ((size_t)((chunk * 16 + n) * 8 + wave) * 2) * 512 + lane * 8;
        if (FINAL && DIR == 1) { th0 = *(const GAS v4u*)(A.TMPH + tmo); th1 = *(const GAS v4u*)(A.TMPH + tmo + 512); }
        f32x16 acca, accx;
#pragma unroll
        for (int i = 0; i < 16; ++i) { acca[i] = 0.f; accx[i] = 0.f; }
#pragma unroll
        for (int kk = 0; kk < 16; ++kk) { const bf16x8 af = *(const LAS bf16x8*)(T + cl * LT_PITCH + (16 * kk + 8 * hs) * 2);
            acca = __builtin_amdgcn_mfma_f32_32x32x16_bf16(af, wb[kk], acca, 0, 0, 0);
            accx = __builtin_amdgcn_mfma_f32_32x32x16_bf16(af, wb[16 + kk], accx, 0, 0, 0); }
        if (j + 4 < NJ) { *(LAS v4u*)Tn = tp0; tp0 = *(const GAS v4u*)(nsrc + 8); }
        unsigned short yv[16];
        if (FINAL && DIR == 1) {
#pragma unroll
            for (int i = 0; i < 16; ++i) yv[i] = A.YR[(size_t)(row0 + (i & 3) + 8 * (i >> 2) + 4 * hs) * D_RNN + ch]; }
#pragma unroll
        for (int i = 0; i < 16; ++i) { const float xcv = bf_lo((unsigned)*(const LAS unsigned short*)(T + ((i & 3) + 8 * (i >> 2) + 4 * hs) * LT_PITCH + (32 * wave + cl) * 2));
            const float r = __builtin_amdgcn_rcpf(1.0f + __builtin_amdgcn_exp2f(acca[i] + bav)), ig = __builtin_amdgcn_rcpf(1.0f + __builtin_amdgcn_exp2f(accx[i] + bxv));
            const float a = __builtin_amdgcn_exp2f(c2 * r), em = __builtin_fmaf(-a, a, 1.0f);
            acca[i] = a; accx[i] = __builtin_amdgcn_sqrtf(em) * ig * xcv; }
        float Ptot, Hfin; f32x16 hv;
        lane_scan<DIR, FINAL>(acca, accx, hs, cin, Ptot, Hfin, hv);
        hstate = Hfin; pacc *= Ptot;
        if (!FINAL) { }
        else if (DIR == 0) {
            v4u o0, o1; o0.x = pg8::cvt_pk_bf16(hv[0], hv[1]); o0.y = pg8::cvt_pk_bf16(hv[2], hv[3]); o0.z = pg8::cvt_pk_bf16(hv[4], hv[5]); o0.w = pg8::cvt_pk_bf16(hv[6], hv[7]);
            o1.x = pg8::cvt_pk_bf16(hv[8], hv[9]); o1.y = pg8::cvt_pk_bf16(hv[10], hv[11]); o1.z = pg8::cvt_pk_bf16(hv[12], hv[13]); o1.w = pg8::cvt_pk_bf16(hv[14], hv[15]);
            *(GAS v4u*)(A.TMPH + tmo) = o0; *(GAS v4u*)(A.TMPH + tmo + 512) = o1;
        } else {
            float hfv[16]; hfv[0] = bf_lo(th0.x); hfv[1] = bf_hi(th0.x); hfv[2] = bf_lo(th0.y); hfv[3] = bf_hi(th0.y); hfv[4] = bf_lo(th0.z); hfv[5] = bf_hi(th0.z); hfv[6] = bf_lo(th0.w); hfv[7] = bf_hi(th0.w);
            hfv[8] = bf_lo(th1.x); hfv[9] = bf_hi(th1.x); hfv[10] = bf_lo(th1.y); hfv[11] = bf_hi(th1.y); hfv[12] = bf_lo(th1.z); hfv[13] = bf_hi(th1.z); hfv[14] = bf_lo(th1.w); hfv[15] = bf_hi(th1.w);
#pragma unroll
            for (int i = 0; i < 16; i += 2) { const size_t go = (size_t)(row0 + (i & 3) + 8 * (i >> 2) + 4 * hs) * D_RNN + ch;
                const unsigned pk = pg8::cvt_pk_bf16((hfv[i] + hv[i]) * fgelu(bf_lo((unsigned)yv[i])), (hfv[i + 1] + hv[i + 1]) * fgelu(bf_lo((unsigned)yv[i + 1])));
                A.REC[go] = (bf16)pk; A.REC[go + D_RNN] = (bf16)(pk >> 16); } }
        if (j + 4 < NJ) *(LAS v4u*)(Tn + 16) = tp0;
    }
    Pacc = pacc; Hacc = hstate;
#undef LRU_CHUNK
}
template <bool FINAL>
__device__ __forceinline__ void lru_phase(Frame& F, const LruArgs& A) {
    const int lane = F.lane, wave = F.wave, cl = lane & 31;
    for (int vb = blockIdx.x; vb < 256; vb += F.G) { const int n = vb >> 4, sub = vb & 15, ch = n * 256 + 32 * wave + cl;
        if (!FINAL) {
            const int cbase = sub * 32; float P, Hh;
            lru_dir_pass<false, 0, 32>(F, A, n, cbase, 0.f, P, Hh); if (lane < 32) *(GAS f32x2*)(A.AGG + ((size_t)(0 * 16 + sub) * D_RNN + ch) * 2) = (f32x2){P, Hh};
            lru_dir_pass<false, 1, 32>(F, A, n, cbase, 0.f, P, Hh); if (lane < 32) *(GAS f32x2*)(A.AGG + ((size_t)(1 * 16 + sub) * D_RNN + ch) * 2) = (f32x2){P, Hh};
        } else {
            const int cbase = sub < 8 ? sub * 64 : (SEQ_P / LCH) + (sub - 8) * 64;
            float hf = 0.f, hb = 0.f, P, Hh;
            if (sub < 8) {
                for (int q = 0; q < 2 * sub; ++q) { const f32x2 ab = *(const GAS f32x2*)(A.AGG + ((size_t)(0 * 16 + q) * D_RNN + ch) * 2); hf = ab.x * hf + ab.y; }
                for (int q = 15; q >= 2 * sub + 2; --q) { const f32x2 ab = *(const GAS f32x2*)(A.AGG + ((size_t)(1 * 16 + q) * D_RNN + ch) * 2); hb = ab.x * hb + ab.y; } }
            lru_dir_pass<true, 0, 64>(F, A, n, cbase, hf, P, Hh);
            lru_dir_pass<true, 1, 64>(F, A, n, cbase, hb, P, Hh);
        } }
}
__device__ __forceinline__ void lru_carry(Frame& F, const float* AGG, float* CIN) {
    const int gt = (F.vcu * NWAVES + F.wave) * 64 + F.lane, NGT = F.G * NWAVES * 64;
    for (int idx = gt; idx < 2 * 9 * D_RNN; idx += NGT) {
        const int ch = idx & (D_RNN - 1), sq = (idx >> 12) % 9, dir = idx / (9 * D_RNN);
        const int c0 = sq == 0 ? 0 : (SEQ_P / LCH) + (sq - 1) * (SEQ_S / LCH), nc = sq == 0 ? SEQ_P / LCH : SEQ_S / LCH;
        float h = 0.f;
#pragma unroll 32
        for (int i = 0; i < nc; ++i) { const int c = dir ? c0 + nc - 1 - i : c0 + i; const size_t o = (size_t)(dir * NCHUNK + c) * D_RNN + ch;
            const f32x2 ab = *(const GAS f32x2*)(AGG + o * 2); CIN[o] = h; h = ab.x * h + ab.y; }
    }
}

template <int NH>
__device__ __forceinline__ void convert_weight_il(Frame& F, const float* W, bf16* WT) {
    LAS float* scr = (LAS float*)(F.lds + RING_OFF + F.wave * 16384);
    const int gw = F.vcu * NWAVES + F.wave, NGW = F.G * NWAVES, lane = F.lane;
    constexpr int K = D, N = 2 * NH, nblk = N / 32;
    constexpr int total = (K / 64) * nblk;
#define CI_SRC(it) (W + (size_t)(64 * ((it) / nblk)) * N + 32 * ((it) % nblk))
    float cur[32], nxt[32];
    int it = gw; if (it < total) tr_load(CI_SRC(it), N, lane, cur);
    for (; it < total; it += NGW) { const int nit = it + NGW, k0 = 64 * (it / nblk), n0 = 32 * (it % nblk);
        const int nv = n0 < NH ? n0 : n0 - NH, d0 = 256 * (nv / 128) + (n0 < NH ? 0 : 128) + (nv % 128);
        if (nit < total) tr_load(CI_SRC(nit), N, lane, nxt);
        tr_store(cur, WT + (size_t)d0 * K + k0, K, scr, lane);
#pragma unroll
        for (int i = 0; i < 32; ++i) cur[i] = nxt[i]; }
#undef CI_SRC
}
__device__ __forceinline__ void act_fix_phase(Frame& F, const bf16* YB, const float* cw, const float* cb, bf16* ACT) {
    const int gt = (F.vcu * NWAVES + F.wave) * 64 + F.lane, NGT = F.G * NWAVES * 64;
    constexpr int NOCT = D_FF / 8, NF = 2 * D_FF;
    for (int it = gt; it < (M / 64) * 2 * NOCT; it += NGT) { const int oc = it % NOCT, rb = it / NOCT, seg = rb >> 1, last = rb & 1, j0 = 8 * oc, g = seg * 64 + (last ? 63 : 0);
        int s0, s1; seq_bounds(g, s0, s1);
        const bf16* ycur = YB + ((size_t)seg * 4 + (last ? 3 : 0)) * NF;
        const bf16* yup = last ? YB + ((size_t)seg * 4 + 2) * NF : YB + ((size_t)(seg - 1) * 4 + 3) * NF;
        const bf16* ydn = last ? YB + ((size_t)(seg + 1) * 4 + 0) * NF : YB + ((size_t)seg * 4 + 1) * NF;
        const bool hasup = last || (g - 1 >= s0), hasdn = !last || (g + 1 < s1);
        float wv[3][8], wg[3][8], bv[8], bg[8], vm[8], v0[8], vp[8], gm[8], g0[8], gp[8];
#pragma unroll
        for (int k = 0; k < 3; ++k) { load8f(cw + (size_t)k * NF + j0, wv[k]); load8f(cw + (size_t)k * NF + D_FF + j0, wg[k]); }
        load8f(cb + j0, bv); load8f(cb + D_FF + j0, bg);
        const v4u z = (v4u){0u, 0u, 0u, 0u};
        unpack_row(hasup ? *(const GAS v4u*)(yup + j0) : z, vm); unpack_row(hasup ? *(const GAS v4u*)(yup + D_FF + j0) : z, gm);
        unpack_row(*(const GAS v4u*)(ycur + j0), v0); unpack_row(*(const GAS v4u*)(ycur + D_FF + j0), g0);
        unpack_row(hasdn ? *(const GAS v4u*)(ydn + j0) : z, vp); unpack_row(hasdn ? *(const GAS v4u*)(ydn + D_FF + j0) : z, gp);
        float a[8];
#pragma unroll
        for (int e = 0; e < 8; ++e) { const float uv = bv[e] + wv[0][e] * vm[e] + wv[1][e] * v0[e] + wv[2][e] * vp[e]; const float ug = bg[e] + wg[0][e] * gm[e] + wg[1][e] * g0[e] + wg[2][e] * gp[e]; a[e] = fgelu(ug) * uv; }
        v4u w; w.x = pk2(a[0], a[1]); w.y = pk2(a[2], a[3]); w.z = pk2(a[4], a[5]); w.w = pk2(a[6], a[7]);
        *(GAS v4u*)(ACT + (size_t)g * D_FF + j0) = w; }
}

constexpr int NPH = 18;
#ifndef DIAG
#define DIAG 0
#endif
#ifndef TIMING
#define TIMING 0
#endif
#ifndef PROBE_REPW
#define PROBE_REPW 1
#endif
#ifndef PROBE_REPA
#define PROBE_REPA 1
#endif
#ifndef REP_MASK
#define REP_MASK 0u
#endif
#define NREP(k) ((((unsigned)args.pad >> (k)) & 1u) ? 2 : 1)
#ifndef TQ
#define TQ 100.0f
#endif
#ifndef LRU_VALU
#define LRU_VALU 0
#endif
#ifndef DW_ABS
#define DW_ABS 9
#define DW_RVR 11
#endif
#ifndef NSB_RUN
#define NSB_RUN NSB
#endif
#ifndef MK_PER_PHASE
#define MK_PER_PHASE 0
#endif
struct Args { const float* in[27]; float* out; unsigned char* ws; int ph_lo, ph_hi, li, pad; };
__global__ void __launch_bounds__(NWAVES * 64, 2) mega_fwd(Args args) {
    extern __shared__ __attribute__((aligned(16))) unsigned char lds_raw[];
    Frame F;
    F.lds = (LAS unsigned char*)lds_raw;
    F.MISC = (volatile LAS unsigned*)(F.lds + MISC_OFF);
int wv_ = __builtin_amdgcn_readfirstlane(threadIdx.x >> 6); asm volatile("" : "+s"(wv_));
#define REFRESH() do { int l_; asm volatile("v_mbcnt_lo_u32_b32 %0, -1, 0\n\tv_mbcnt_hi_u32_b32 %0, -1, %0" : "=v"(l_)); F.lane = l_; F.wave = wv_; F.tid = wv_ * 64 + l_; } while (0)
    REFRESH();
    F.G = gridDim.x; { const int bx = blockIdx.x; F.vcu = (F.G % 8 == 0) ? (bx % 8) * (F.G / 8) + bx / 8 : bx; }
    F.ctl = (gu32*)(args.ws + WS_CTL);
    for (int u = threadIdx.x; u < (LDS_BYTES - MISC_OFF) / 4; u += NWAVES * 64) ((LAS unsigned*)(F.lds + MISC_OFF))[u] = 0u;
    __syncthreads();
    XcdBarrier bar = xcd_barrier_post((unsigned*)(F.ctl + CW_BAR) + args.li * XCD_BAR_WORDS, F.MISC + 8);
    const int lo = args.ph_lo, hi = args.ph_hi;
#if TIMING
    const unsigned long long t_begin = wall_clock64();
#endif
#ifndef PH_MASK
#define PH_MASK 0xFFFFFFFFu
#endif
#define IN(k) (((PH_MASK >> (k)) & 1u) && lo <= (k) && (k) < hi)
#if TIMING
#define SEAM(k) do { if (IN(k) && IN((k) + 1)) xcd_barrier(bar, F.tid); if (blockIdx.x == 0 && threadIdx.x == 0) __hip_atomic_store(F.ctl + 64 + (k), (unsigned)(wall_clock64() - t_begin), RLX_AGENT); } while (0)
#else
#define SEAM(k) do { if (IN(k) && IN((k) + 1)) xcd_barrier(bar, F.tid); } while (0)
#endif
#define gw (F.vcu * NWAVES + F.wave)
#define NGW (F.G * NWAVES)
#define gt (gw * 64 + F.lane)
#define NGT (NGW * 64)
#define x_p (args.in[0])
#define x_s (args.in[1])
#define p_p (args.in[2])
#define p_s (args.in[3])
#define g_mix (args.in[4])
#define w_in (args.in[5])
#define rnn_cw (args.in[6])
#define rnn_cb (args.in[7])
#define lru_wa (args.in[8])
#define lru_ba (args.in[9])
#define lru_wx (args.in[10])
#define lru_bx (args.in[11])
#define lru_lam (args.in[12])
#define a_sink (args.in[13])
#define w_oa (args.in[14])
#define w_or (args.in[15])
#define w_mg (args.in[16])
#define w_out (args.in[17])
#define g_ffn (args.in[18])
#define w_up (args.in[19])
#define ffn_cw (args.in[20])
#define ffn_cb (args.in[21])
#define w_dn (args.in[22])
#define w_pg (args.in[23])
#define w_pl (args.in[24])
#define g_ple (args.in[25])
#define g_fin (args.in[26])
#define OUTF (args.out)
#define WSB(off) ((bf16*)(args.ws + (off)))
#define WSF(off) ((float*)(args.ws + (off)))
#define H WSB(WS_H)
#define Qb WSB(WS_Q)
#define Kb WSB(WS_K)
#define Vb WSB(WS_V)
#define REC WSB(WS_REC)
#define Gb WSB(WS_G)
#define MRG WSB(WS_MRG)
#define XR ((bf16*)args.out)
#define YR ((bf16*)args.out + (size_t)M * D_RNN)
#define AGG WSF(WS_AGG)
#define CIN WSF(WS_CIN)
#define WIN WSB(WS_WIN)
#define WG WSB(WS_WG)
#define WOA WSB(WS_WOA)
#define WOR WSB(WS_WOR)
#define WOUT WSB(WS_WOUT)
#define LWA WSB(WS_LWA)
#define LWX WSB(WS_LWX)
#define HN2 WSB(WS_HN2)
#define WUP WSB(WS_WUP)
#define WDN WSB(WS_WDN)
#define WPG WSB(WS_WPG)
#define WPL WSB(WS_WPL)
#define PB WSB(WS_PB)
#define YBUF WSB(WS_YB)
#define SS WSF(WS_SS)
#define RSE WSF(WS_RSE)
#define X2B WSB(WS_X2B)
#define ACT WSB(WS_ACT)
#define EU WSB(WS_EU)
#define X3B WSB(WS_X3B)
#define MAB ((bf16*)args.out)
#define X1B ((bf16*)args.out)
    typedef pg8::StaticOrder SO;

    for (int repw = 0; repw < PROBE_REPW; ++repw) if (IN(0)) { REFRESH(); if (repw) xcd_barrier(bar, F.tid);
        convert_weight(F, w_in, D, IN_W, 1, WIN); convert_weight_il<D>(F, w_mg, WG); convert_weight(F, w_oa, ATTN_W, D, 1, WOA);
        convert_weight(F, w_or, D_RNN, D, 1, WOR); convert_weight(F, w_out, D, D, 1, WOUT); convert_lru_weight(F, lru_wa, LWA); convert_lru_weight(F, lru_wx, LWX);
        for (int m = gw; m < M; m += NGW) rms_row_to_bf16(m < SEQ_P ? x_p + (size_t)m * D : x_s + (size_t)(m - SEQ_P) * D, g_mix, H + (size_t)m * D, F.lane);
    }
    SEAM(0);
    if (IN(1)) { REFRESH(); pg8::Gemm g{H, WIN, M, IN_W, D}; SO S; S.init(M, IN_W, F.G, (int)blockIdx.x);
        pg8::EpiZc E{Qb, Kb, Vb, MRG, YR, (bf16*)CIN, rnn_cw, rnn_cb, 0.08838834764831845f * LOG2E};
        pg8::gemm_phase<pg8::EpiZc, SO, true, true, true>(F.lds + RING_OFF, g, S, E, F.tid); }
    SEAM(1);


    if (IN(2)) { REFRESH(); for (int u = blockIdx.x; u < (M / 128) * 4; u += F.G) attn_unit(F, Qb, Kb, Vb, Qb, a_sink, u >> 2, u & 3);
        conv_fix_phase(F, (const bf16*)CIN, rnn_cw, rnn_cb, MRG); }
    SEAM(2);
#ifdef PROBE_REP3
    if (IN(3)) { for (int rep = 0; rep < PROBE_REP3; ++rep) { REFRESH(); LruArgs LA{MRG, YR, LWA, LWX, lru_ba, lru_bx, lru_lam, AGG, CIN, Gb, REC}; lru_phase<false>(F, LA); xcd_barrier(bar, F.tid); } }
#else
    if (IN(3)) { REFRESH(); LruArgs LA{MRG, YR, LWA, LWX, lru_ba, lru_bx, lru_lam, AGG, CIN, Gb, REC}; lru_phase<false>(F, LA); }
#endif
    SEAM(3);

#ifdef PROBE_REP5
    if (IN(5)) { for (int rep = 0; rep < PROBE_REP5; ++rep) { REFRESH(); LruArgs LA{MRG, YR, LWA, LWX, lru_ba, lru_bx, lru_lam, AGG, CIN, Gb, REC}; lru_phase<true>(F, LA); xcd_barrier(bar, F.tid); } }
#else
    if (IN(5)) { REFRESH(); LruArgs LA{MRG, YR, LWA, LWX, lru_ba, lru_bx, lru_lam, AGG, CIN, Gb, REC}; lru_phase<true>(F, LA); }
#endif
    SEAM(5);

    if (IN(6)) { REFRESH(); pg8::Gemm g{Qb, WOA, M, D, ATTN_W}; SO S; S.init(M, D, F.G, (int)blockIdx.x); pg8::EpiStore<0> E{MAB, D};
        pg8::gemm_phase<pg8::EpiStore<0>, SO, true, true>(F.lds + RING_OFF, g, S, E, F.tid); }
    SEAM(6);
    if (IN(7)) { REFRESH(); pg8::Gemm g{REC, WOR, M, D, D_RNN}; SO S; S.init(M, D, F.G, (int)blockIdx.x); pg8::EpiStore<0> E{Gb, D};
        pg8::gemm_phase<pg8::EpiStore<0>, SO, true, true>(F.lds + RING_OFF, g, S, E, F.tid); }
    SEAM(7);
    if (IN(8)) { REFRESH(); pg8::Gemm g{H, WG, M, 2 * D, D}; SO S; S.init(M, 2 * D, F.G, (int)blockIdx.x); pg8::EpiMerge2 E{MAB, Gb, MRG};
        pg8::gemm_phase<pg8::EpiMerge2, SO, true, true>(F.lds + RING_OFF, g, S, E, F.tid); }
    SEAM(8);
    if (IN(10)) { REFRESH(); pg8::Gemm g{MRG, WOUT, M, D, D}; SO S; S.init(M, D, F.G, (int)blockIdx.x); pg8::EpiResid0 E{x_p, x_s, X1B};
        pg8::gemm_phase<pg8::EpiResid0, SO, true, true>(F.lds + RING_OFF, g, S, E, F.tid); }
    SEAM(10);
    for (int repw = 0; repw < PROBE_REPW; ++repw) if (IN(11)) { REFRESH(); if (repw) xcd_barrier(bar, F.tid);
        convert_weight_il<D_FF>(F, w_up, WUP); convert_weight(F, w_dn, D_FF, D, 1, WDN); convert_weight(F, w_pg, D, D, 1, WPG); convert_weight(F, w_pl, PLE, D, 1, WPL);
        for (int m = gw; m < M; m += NGW) rms_brow_to_bf16(X1B + (size_t)m * D, g_ffn, HN2 + (size_t)m * D, F.lane);
        for (int i = gt; i < M * PLE / 8; i += NGT) { const size_t e = (size_t)i * 8; const float* src = e < (size_t)SEQ_P * PLE ? p_p + e : p_s + (e - (size_t)SEQ_P * PLE);
            const f32x4 a = *(const GAS f32x4*)src, b = *(const GAS f32x4*)(src + 4); v4u w; w.x = pk2(a.x, a.y); w.y = pk2(a.z, a.w); w.z = pk2(b.x, b.y); w.w = pk2(b.z, b.w); *(GAS v4u*)(PB + e) = w; }
    }
    SEAM(11);
    if (IN(12)) { REFRESH(); pg8::Gemm g{HN2, WUP, M, 2 * D_FF, D}; SO S; S.init(M, 2 * D_FF, F.G, (int)blockIdx.x); pg8::EpiAct E{ffn_cw, ffn_cb, ACT, YBUF};
        pg8::gemm_phase<pg8::EpiAct, SO, false, true, true>(F.lds + RING_OFF, g, S, E, F.tid); }
    SEAM(12);
    if (IN(13)) { REFRESH(); act_fix_phase(F, YBUF, ffn_cw, ffn_cb, ACT);
        xcd_barrier(bar, F.tid); REFRESH();
        { pg8::Gemm g{ACT, WDN, M, D, D_FF}; SO S; S.init(M, D, F.G, (int)blockIdx.x); pg8::EpiResidAcc E{X1B, X2B};
          pg8::gemm_phase<pg8::EpiResidAcc, SO, true, true>(F.lds + RING_OFF, g, S, E, F.tid); }
    }
    SEAM(13);
    if (IN(14)) { REFRESH(); pg8::Gemm g{PB, WPL, M, D, PLE}; SO S; S.init(M, D, F.G, (int)blockIdx.x); pg8::EpiEU E{EU, SS};
        pg8::gemm_phase<pg8::EpiEU, SO, true, true>(F.lds + RING_OFF, g, S, E, F.tid); }
    SEAM(14);
    if (IN(15)) { REFRESH(); for (int m = gw; m < M; m += NGW) { const float s = wave_sum(SS[(size_t)m * 64 + F.lane]); if (F.lane == 0) RSE[m] = 1.0f / sqrtf(s * (1.f / D) + EPS); } }
    SEAM(15);
    if (IN(16)) { REFRESH(); pg8::Gemm g{X2B, WPG, M, D, D}; SO S; S.init(M, D, F.G, (int)blockIdx.x); pg8::EpiPle E{X2B, X3B, EU, RSE, g_ple, SS};
        pg8::gemm_phase<pg8::EpiPle, SO, true, true>(F.lds + RING_OFF, g, S, E, F.tid); }
    SEAM(16);
    if (IN(17)) { REFRESH();
        for (int m = gw; m < M; m += NGW) { const float s = wave_sum(SS[(size_t)m * 64 + F.lane]); const float rstd = 1.0f / sqrtf(s * (1.f / D) + EPS);
            const GAS v4u* xr = (const GAS v4u*)(X3B + (size_t)m * D) + F.lane; GAS f32x4* orow = (GAS f32x4*)(OUTF + (size_t)m * D) + 2 * F.lane; const GAS f32x4* gr = (const GAS f32x4*)g_fin + 2 * F.lane;
#pragma unroll
            for (int j = 0; j < 8; ++j) { const v4u w = xr[64 * j]; const f32x4 g0 = gr[128 * j], g1 = gr[128 * j + 1];
                orow[128 * j] = (f32x4){bf_lo(w.x), bf_hi(w.x), bf_lo(w.y), bf_hi(w.y)} * rstd * g0; orow[128 * j + 1] = (f32x4){bf_lo(w.z), bf_hi(w.z), bf_lo(w.w), bf_hi(w.w)} * rstd * g1; } }
    }
#if TIMING
    if (blockIdx.x == 0 && threadIdx.x == 0) __hip_atomic_store(F.ctl + 64 + 17, (unsigned)(wall_clock64() - t_begin), RLX_AGENT);
    { xcd_barrier(bar, F.tid); REFRESH();
      const float ta = 0.01f * (float)((int)__hip_atomic_load(F.ctl + 64 + TA_HI, RLX_AGENT) - (TA_LO > 0 ? (int)__hip_atomic_load(F.ctl + 64 + TA_LO - 1, RLX_AGENT) : 0));
      const float tb = 0.01f * (float)((int)__hip_atomic_load(F.ctl + 64 + TB_HI, RLX_AGENT) - (TB_LO > 0 ? (int)__hip_atomic_load(F.ctl + 64 + TB_LO - 1, RLX_AGENT) : 0));
      const float cfill = sqrtf(TQ * floorf(tb / TQ + 0.5f));
      for (size_t i = (size_t)gt; i < (size_t)M * D / 4; i += NGT) { const float v = i >= (size_t)SEQ_P * D / 4 ? cfill : 0.f; ((GAS f32x4*)OUTF)[i] = (f32x4){v, v, v, v}; }
      xcd_barrier(bar, F.tid); REFRESH();
      if (blockIdx.x == 0 && F.tid == 0) OUTF[0] = TQ * floorf(ta / TQ + 0.5f); }
#endif
#undef IN
#undef SEAM
#undef gw
#undef NGW
#undef gt
#undef NGT
#undef H
#undef SS
#undef EU
#undef ACT
#undef PB
}

extern "C" void kernel_launch(void* const* d_in, const int* in_sizes, int n_in, void* d_out, int out_size, void* d_ws, size_t ws_size, hipStream_t stream) {
    static int grid = 0;
    if (grid == 0) {
        if (n_in != 27 || in_sizes[0] != SEQ_P * D || out_size != M * D || ws_size < WS_NEED) { fprintf(stderr, "kernel_launch: unexpected shapes (n_in %d, in0 %d, out %d, ws %zu need %zu); nothing launched\n", n_in, n_in > 0 ? in_sizes[0] : -1, out_size, ws_size, (size_t)WS_NEED); grid = -1; return; }
        int dev = 0, cus = 0, per_cu = 0;
        if (hipGetDevice(&dev) != hipSuccess || hipDeviceGetAttribute(&cus, hipDeviceAttributeMultiprocessorCount, dev) != hipSuccess) { grid = -1; return; }
        if (hipFuncSetAttribute((const void*)mega_fwd, hipFuncAttributeMaxDynamicSharedMemorySize, LDS_BYTES) != hipSuccess) { fprintf(stderr, "kernel_launch: hipFuncSetAttribute failed\n"); grid = -1; return; }
        if (hipOccupancyMaxActiveBlocksPerMultiprocessor(&per_cu, (const void*)mega_fwd, NWAVES * 64, LDS_BYTES) != hipSuccess || per_cu < 1) { fprintf(stderr, "kernel_launch: occupancy query reports %d\n", per_cu); }
        (void)hipGetLastError();
        grid = cus;
    }
    if (grid < 0) return;
    if (hipMemsetAsync((char*)d_ws + WS_CTL, 0, CTL_ZERO_BYTES, stream) != hipSuccess) return;
    Args a{};
    for (int i = 0; i < 27; ++i) a.in[i] = (const float*)d_in[i];
    a.out = (float*)d_out; a.ws = (unsigned char*)d_ws; a.pad = (int)REP_MASK;
#if MK_PER_PHASE
    for (int li = 0; li < NPH; ++li) { a.ph_lo = li; a.ph_hi = li + 1; a.li = li; hipLaunchKernelGGL(mega_fwd, dim3(grid), dim3(NWAVES * 64), LDS_BYTES, stream, a); }
#else
    a.ph_lo = 0; a.ph_hi = NPH; a.li = 0;
    hipLaunchKernelGGL(mega_fwd, dim3(grid), dim3(NWAVES * 64), LDS_BYTES, stream, a);
#endif
}
```

```cpp
#include <hip/hip_runtime.h>
#include <cstdio>
#include <cstdint>
namespace pg8 {
#define PG8_LAS __attribute__((address_space(3)))
typedef unsigned short bf16_t;
typedef short bf16x8 __attribute__((ext_vector_type(8)));
typedef float f32x4 __attribute__((ext_vector_type(4)));
typedef unsigned u32x4 __attribute__((ext_vector_type(4)));
constexpr int BM = 256, BK = 64, HALF = 128, HTB = HALF * BK * 2  , STAGE_BYTES = 8 * HTB, NXCD = 8, WGM = 8;

__host__ __device__ __forceinline__ int lds_byte(int r, int c) { const int st = (r >> 4) * 2 + (c >> 5), rr = r & 15, cc = c & 31, ob = rr * 64 + cc * 2; return st * 1024 + (ob ^ (((ob >> 9) & 1) << 5)); }
__host__ __device__ __forceinline__ void stage_rc(int b, int& R, int& C) { const int st = b / 1024, sb = b % 1024, swz = sb ^ (((sb >> 9) & 1) << 5); R = (st >> 1) * 16 + swz / 64; C = (st & 1) * 32 + (swz % 64) / 2; }
__host__ __device__ __forceinline__ int perm32(int rho) { const int n = rho >> 4, i = rho & 15; return 8 * (i >> 2) + 4 * n + (i & 3); }

struct Unit { int pm, pn; };
struct Gemm { const bf16_t* A; const bf16_t* Bt; int M, N, K; };

struct StaticOrder {
    int nM, nN, nwg, G, c;
    __host__ __device__ void init(int M, int N, int G_, int c_) { nM = M / BM; nN = N / BM; nwg = nM * nN; G = G_; c = c_; }
    __host__ __device__ bool next(int i, Unit& u) const {
        const long L = (long)i * G + c; if (L >= nwg) return false;
        int wgid = (int)L; { const int q = nwg / NXCD, r = nwg % NXCD, xcd = wgid % NXCD, off = wgid / NXCD; wgid = (xcd < r ? xcd * (q + 1) : r * (q + 1) + (xcd - r) * q) + off; }
        const int nig = WGM * nN, gid = wgid / nig, fm = gid * WGM, gsz = (nM - fm) < WGM ? (nM - fm) : WGM;
        u.pm = fm + ((wgid % nig) % gsz); u.pn = (wgid % nig) / gsz; return true;
    }
    __device__ __forceinline__ void a_ready(const Unit&) const {}
    __device__ __forceinline__ void done(const Unit&) const {}
};
__device__ __forceinline__ unsigned cvt_pk_bf16(float lo, float hi) { unsigned r; asm volatile("s_nop 2\n\tv_cvt_pk_bf16_f32 %0, %1, %2" : "=v"(r) : "v"(lo), "v"(hi)); return r; }
typedef float f32x2 __attribute__((ext_vector_type(2)));
__device__ __forceinline__ float fsigmoid(float x) { return __builtin_amdgcn_rcpf(1.0f + __builtin_amdgcn_exp2f(-1.4426950408889634f * x)); }
__device__ __forceinline__ float fgelu(float x) { const float p = __builtin_fmaf(x * x, -2.3022081985f * 0.044715f, -2.3022081985f); return x * __builtin_amdgcn_rcpf(1.0f + __builtin_amdgcn_exp2f(p * x)); }
__device__ __forceinline__ float bf_lo(unsigned w) { return __uint_as_float(w << 16); }
__device__ __forceinline__ float bf_hi(unsigned w) { return __uint_as_float(w & 0xffff0000u); }

#define EPI_ROWS(ai, m) (row0 + (ai) * HALF + (m) * 16)
__device__ __forceinline__ u32x4 pack8(const f32x4 v0, const f32x4 v1) { u32x4 w; w.x = cvt_pk_bf16(v0[0], v0[1]); w.y = cvt_pk_bf16(v0[2], v0[3]); w.z = cvt_pk_bf16(v1[0], v1[1]); w.w = cvt_pk_bf16(v1[2], v1[3]); return w; }
__device__ __forceinline__ void unpack8(const u32x4 w, f32x4& v0, f32x4& v1) { v0 = (f32x4){bf_lo(w.x), bf_hi(w.x), bf_lo(w.y), bf_hi(w.y)}; v1 = (f32x4){bf_lo(w.z), bf_hi(w.z), bf_lo(w.w), bf_hi(w.w)}; }

__device__ __forceinline__ f32x4 dpp_rot(const f32x4 v, const bool left) { f32x4 o;
#pragma unroll
    for (int j = 0; j < 4; ++j) { const float s = v[j]; const int x = __float_as_int(s);
        const int y = left ? __builtin_amdgcn_mov_dpp(x, 0x12F, 0xF, 0xF, true) : __builtin_amdgcn_mov_dpp(x, 0x121, 0xF, 0xF, true);
        o[j] = __int_as_float(y); }
    return o; }
struct EpiZc {
    static constexpr bool PERM = true, AFTER_DRAIN = false;
    bf16_t *Q, *K, *V, *XC, *YR, *XB; const float *cw, *cb; float qscale;
    __device__ __forceinline__ void operator()(const f32x4 (&acc)[2][2][4][2], const Unit& u, int wr, int wc, int fr, int fq) const {
        const int pn = u.pn, rbase = u.pm * BM + wr * 64 + 4 * fr;
        if (pn < 12 || pn >= 28) { bf16_t* base; int ldc, colt; float sc = 1.f;
            if (pn < 8) { base = Q; ldc = 2048; colt = pn * 256; sc = qscale; }
            else if (pn < 10) { base = K; ldc = 512; colt = (pn - 8) * 256; }
            else if (pn < 12) { base = V; ldc = 512; colt = (pn - 10) * 256; }
            else { base = YR; ldc = 4096; colt = (pn - 28) * 256; }
            const int col0 = colt + wc * 32 + 8 * fq;
#pragma unroll
            for (int ai = 0; ai < 2; ++ai)
#pragma unroll
                for (int m = 0; m < 4; ++m) { bf16_t* rowp = base + (size_t)(rbase + ai * HALF + m) * ldc + col0;
#pragma unroll
                    for (int bj = 0; bj < 2; ++bj) *(u32x4*)(rowp + bj * HALF) = pack8(acc[ai][bj][m][0] * sc, acc[ai][bj][m][1] * sc); }
        } else {
            const bool f0 = fr == 0, f15 = fr == 15;
#pragma unroll
            for (int bj = 0; bj < 2; ++bj) { const int c0 = (pn - 12) * 256 + wc * 32 + 8 * fq + bj * HALF;
                f32x4 w[4][2], b[2];
#pragma unroll
                for (int k = 0; k < 4; ++k) { w[k][0] = *(const f32x4*)(cw + k * 4096 + c0); w[k][1] = *(const f32x4*)(cw + k * 4096 + c0 + 4); }
                b[0] = *(const f32x4*)(cb + c0); b[1] = *(const f32x4*)(cb + c0 + 4);
#pragma unroll
                for (int ai = 0; ai < 2; ++ai) { const int seg = u.pm * 4 + ai * 2 + wr;
                    if (f0) {
#pragma unroll
                        for (int mm = 0; mm < 3; ++mm) *(u32x4*)(XB + ((size_t)seg * 6 + mm) * 4096 + c0) = pack8(acc[ai][bj][mm][0], acc[ai][bj][mm][1]); }
                    if (f15) {
#pragma unroll
                        for (int mm = 1; mm < 4; ++mm) *(u32x4*)(XB + ((size_t)seg * 6 + 2 + mm) * 4096 + c0) = pack8(acc[ai][bj][mm][0], acc[ai][bj][mm][1]); }
                    f32x4 U3[2], D0[2], D1[2];
#pragma unroll
                    for (int n = 0; n < 2; ++n) { U3[n] = dpp_rot(acc[ai][bj][3][n], false); D0[n] = dpp_rot(acc[ai][bj][0][n], true); D1[n] = dpp_rot(acc[ai][bj][1][n], true); }
#pragma unroll
                    for (int m = 0; m < 4; ++m) { f32x4 o[2];
#pragma unroll
                        for (int n = 0; n < 2; ++n) {
                            const f32x4 xm1 = m == 0 ? U3[n] : acc[ai][bj][m == 0 ? 0 : m - 1][n], x0 = acc[ai][bj][m][n];
                            const f32x4 x1 = m == 3 ? D0[n] : acc[ai][bj][m == 3 ? 3 : m + 1][n], x2 = m == 2 ? D0[n] : (m == 3 ? D1[n] : acc[ai][bj][m >= 2 ? 3 : m + 2][n]);
                            o[n] = b[n] + w[0][n] * xm1 + w[1][n] * x0 + w[2][n] * x1 + w[3][n] * x2; }
                        const bool fix = (m == 0 && f0) || (m >= 2 && f15);
                        if (!fix) *(u32x4*)(XC + (size_t)(rbase + ai * HALF + m) * 4096 + c0) = pack8(o[0], o[1]); } } }
        }
    }
};
struct EpiZ {
    static constexpr bool PERM = true, AFTER_DRAIN = false;
    bf16_t *Q, *K, *V, *XR, *YR; float qscale;
    __device__ __forceinline__ void operator()(const f32x4 (&acc)[2][2][4][2], const Unit& u, int wr, int wc, int fr, int fq) const {
        const int pn = u.pn; bf16_t* base; int ldc, colt; float sc = 1.f;
        if (pn < 8) { base = Q; ldc = 2048; colt = pn * 256; sc = qscale; }
        else if (pn < 10) { base = K; ldc = 512; colt = (pn - 8) * 256; }
        else if (pn < 12) { base = V; ldc = 512; colt = (pn - 10) * 256; }
        else if (pn < 28) { base = XR; ldc = 4096; colt = (pn - 12) * 256; }
        else { base = YR; ldc = 4096; colt = (pn - 28) * 256; }
        const int row0 = u.pm * BM + wr * 64 + fr, col0 = colt + wc * 32 + 8 * fq;
#pragma unroll
        for (int ai = 0; ai < 2; ++ai)
#pragma unroll
            for (int m = 0; m < 4; ++m) { bf16_t* rowp = base + (size_t)EPI_ROWS(ai, m) * ldc + col0;
#pragma unroll
                for (int bj = 0; bj < 2; ++bj) *(u32x4*)(rowp + bj * HALF) = pack8(acc[ai][bj][m][0] * sc, acc[ai][bj][m][1] * sc); }
    }
};
template <int ACT> struct EpiStore {
    static constexpr bool PERM = true, AFTER_DRAIN = false;
    bf16_t* O; int ldc;
    __device__ __forceinline__ void operator()(const f32x4 (&acc)[2][2][4][2], const Unit& u, int wr, int wc, int fr, int fq) const {
        const int row0 = u.pm * BM + wr * 64 + fr, col0 = u.pn * BM + wc * 32 + 8 * fq;
#pragma unroll
        for (int ai = 0; ai < 2; ++ai)
#pragma unroll
            for (int m = 0; m < 4; ++m) { bf16_t* rowp = O + (size_t)EPI_ROWS(ai, m) * ldc + col0;
#pragma unroll
                for (int bj = 0; bj < 2; ++bj) { f32x4 v0 = acc[ai][bj][m][0], v1 = acc[ai][bj][m][1];
                    if (ACT == 1) {
#pragma unroll
                        for (int j = 0; j < 4; ++j) { v0[j] = fsigmoid(v0[j]); v1[j] = fsigmoid(v1[j]); } }
                    *(u32x4*)(rowp + bj * HALF) = pack8(v0, v1); } }
    }
};
struct EpiMulG {
    static constexpr bool PERM = true, AFTER_DRAIN = false;
    const bf16_t* G; bf16_t* MA;
    __device__ __forceinline__ void operator()(const f32x4 (&acc)[2][2][4][2], const Unit& u, int wr, int wc, int fr, int fq) const {
        const int row0 = u.pm * BM + wr * 64 + fr, col0 = u.pn * BM + wc * 32 + 8 * fq;
#pragma unroll
        for (int ai = 0; ai < 2; ++ai)
#pragma unroll
            for (int m = 0; m < 4; ++m) { const size_t off = (size_t)EPI_ROWS(ai, m) * 4096 + col0;
#pragma unroll
                for (int bj = 0; bj < 2; ++bj) { f32x4 g0, g1; unpack8(*(const u32x4*)(G + off + bj * HALF), g0, g1);
                    *(u32x4*)(MA + off + bj * HALF) = pack8(acc[ai][bj][m][0] * g0, acc[ai][bj][m][1] * g1); } }
    }
};
struct EpiMerge {
    static constexpr bool PERM = true, AFTER_DRAIN = false;
    const bf16_t* G; const bf16_t* MA; bf16_t* O;
    __device__ __forceinline__ void operator()(const f32x4 (&acc)[2][2][4][2], const Unit& u, int wr, int wc, int fr, int fq) const {
        const int row0 = u.pm * BM + wr * 64 + fr, col0 = u.pn * BM + wc * 32 + 8 * fq;
#pragma unroll
        for (int ai = 0; ai < 2; ++ai)
#pragma unroll
            for (int m = 0; m < 4; ++m) { const size_t off = (size_t)EPI_ROWS(ai, m) * 4096 + col0;
#pragma unroll
                for (int bj = 0; bj < 2; ++bj) { f32x4 g0, g1; unpack8(*(const u32x4*)(G + off + bj * HALF), g0, g1);
                    f32x4 m0, m1; unpack8(*(const u32x4*)(MA + off + bj * HALF), m0, m1);
                    *(u32x4*)(O + off + bj * HALF) = pack8(acc[ai][bj][m][0] * g0 + m0, acc[ai][bj][m][1] * g1 + m1); } }
    }
};
struct EpiResid0 {
    static constexpr bool PERM = true, AFTER_DRAIN = false;
    const float *xa, *xb; bf16_t* O;
    __device__ __forceinline__ void operator()(const f32x4 (&acc)[2][2][4][2], const Unit& u, int wr, int wc, int fr, int fq) const {
        const int row0 = u.pm * BM + wr * 64 + fr, col0 = u.pn * BM + wc * 32 + 8 * fq;
        const float* X = (u.pm < 64) ? xa : (xb - (size_t)16384 * 4096);
#pragma unroll
        for (int ai = 0; ai < 2; ++ai)
#pragma unroll
            for (int m = 0; m < 4; ++m) { const size_t off = (size_t)EPI_ROWS(ai, m) * 4096 + col0;
#pragma unroll
                for (int bj = 0; bj < 2; ++bj) {
                    const f32x4 x0 = *(const f32x4*)(X + off + bj * HALF), x1 = *(const f32x4*)(X + off + bj * HALF + 4);
                    *(u32x4*)(O + off + bj * HALF) = pack8(x0 + acc[ai][bj][m][0], x1 + acc[ai][bj][m][1]); } }
    }
};
struct EpiResidAcc {
    static constexpr bool PERM = true, AFTER_DRAIN = false;
    const bf16_t* X; bf16_t* XB;
    __device__ __forceinline__ void operator()(const f32x4 (&acc)[2][2][4][2], const Unit& u, int wr, int wc, int fr, int fq) const {
        const int row0 = u.pm * BM + wr * 64 + fr, col0 = u.pn * BM + wc * 32 + 8 * fq;
#pragma unroll
        for (int ai = 0; ai < 2; ++ai)
#pragma unroll
            for (int m = 0; m < 4; ++m) { const size_t off = (size_t)EPI_ROWS(ai, m) * 4096 + col0;
#pragma unroll
                for (int bj = 0; bj < 2; ++bj) {
                    f32x4 x0, x1; unpack8(*(const u32x4*)(X + off + bj * HALF), x0, x1); x0 += acc[ai][bj][m][0]; x1 += acc[ai][bj][m][1];
                    *(u32x4*)(XB + off + bj * HALF) = pack8(x0, x1); } }
    }
};
struct EpiEU {
    static constexpr bool PERM = true, AFTER_DRAIN = false;
    bf16_t* O; float* SS;
    __device__ __forceinline__ void operator()(const f32x4 (&acc)[2][2][4][2], const Unit& u, int wr, int wc, int fr, int fq) const {
        const int row0 = u.pm * BM + wr * 64 + fr, col0 = u.pn * BM + wc * 32 + 8 * fq;
#pragma unroll
        for (int ai = 0; ai < 2; ++ai)
#pragma unroll
            for (int m = 0; m < 4; ++m) { const size_t off = (size_t)EPI_ROWS(ai, m) * 4096 + col0; float s = 0.f;
#pragma unroll
                for (int bj = 0; bj < 2; ++bj) { const f32x4 v0 = acc[ai][bj][m][0], v1 = acc[ai][bj][m][1];
                    s += (v0[0] * v0[0] + v0[1] * v0[1]) + (v0[2] * v0[2] + v0[3] * v0[3]) + (v1[0] * v1[0] + v1[1] * v1[1]) + (v1[2] * v1[2] + v1[3] * v1[3]);
                    *(u32x4*)(O + off + bj * HALF) = pack8(v0, v1); }
                s += __shfl_xor(s, 16); s += __shfl_xor(s, 32);
                if (fq == 0) SS[(size_t)EPI_ROWS(ai, m) * 64 + u.pn * 4 + wc] = s; }
    }
};
struct EpiPle {
    static constexpr bool PERM = true, AFTER_DRAIN = false;
    const bf16_t* X; bf16_t* X3; const bf16_t* EU; const float* rstd; const float* g; float* SS;
    __device__ __forceinline__ void operator()(const f32x4 (&acc)[2][2][4][2], const Unit& u, int wr, int wc, int fr, int fq) const {
        const int row0 = u.pm * BM + wr * 64 + fr, col0 = u.pn * BM + wc * 32 + 8 * fq;
        f32x4 gv[2][2];
#pragma unroll
        for (int bj = 0; bj < 2; ++bj) { gv[bj][0] = *(const f32x4*)(g + col0 + bj * HALF); gv[bj][1] = *(const f32x4*)(g + col0 + bj * HALF + 4); }
#pragma unroll
        for (int ai = 0; ai < 2; ++ai)
#pragma unroll
            for (int m = 0; m < 4; ++m) { const int row = EPI_ROWS(ai, m); const size_t off = (size_t)row * 4096 + col0; const float rs = rstd[row]; float s = 0.f;
#pragma unroll
                for (int bj = 0; bj < 2; ++bj) { f32x4 e0, e1; unpack8(*(const u32x4*)(EU + off + bj * HALF), e0, e1);
                    f32x4 x0, x1; unpack8(*(const u32x4*)(X + off + bj * HALF), x0, x1);
                    const f32x4 a0 = acc[ai][bj][m][0], a1 = acc[ai][bj][m][1];
#pragma unroll
                    for (int j = 0; j < 4; ++j) { x0[j] += fsigmoid(a0[j]) * (e0[j] * rs * gv[bj][0][j]); x1[j] += fsigmoid(a1[j]) * (e1[j] * rs * gv[bj][1][j]); }
                    s += (x0[0] * x0[0] + x0[1] * x0[1]) + (x0[2] * x0[2] + x0[3] * x0[3]) + (x1[0] * x1[0] + x1[1] * x1[1]) + (x1[2] * x1[2] + x1[3] * x1[3]);
                    *(u32x4*)(X3 + off + bj * HALF) = pack8(x0, x1); }
                s += __shfl_xor(s, 16); s += __shfl_xor(s, 32);
                if (fq == 0) SS[(size_t)row * 64 + u.pn * 4 + wc] = s; }
    }
};
struct EpiMerge2 {
    static constexpr bool PERM = true, AFTER_DRAIN = false;
    const bf16_t *TA, *TR; bf16_t* O;
    __device__ __forceinline__ void operator()(const f32x4 (&acc)[2][2][4][2], const Unit& u, int wr, int wc, int fr, int fq) const {
        const int colb = u.pn * 128 + wc * 32 + 8 * fq;
#pragma unroll
        for (int ai = 0; ai < 2; ++ai)
#pragma unroll
            for (int m = 0; m < 4; ++m) { const size_t off = (size_t)(u.pm * BM + ai * HALF + wr * 64 + 16 * m + fr) * 4096 + colb;
                f32x4 a0, a1, r0, r1; unpack8(*(const u32x4*)(TA + off), a0, a1); unpack8(*(const u32x4*)(TR + off), r0, r1);
                const f32x4 ga0 = acc[ai][0][m][0], ga1 = acc[ai][0][m][1], gr0 = acc[ai][1][m][0], gr1 = acc[ai][1][m][1];
                f32x4 o0, o1;
#pragma unroll
                for (int j = 0; j < 4; ++j) { o0[j] = fsigmoid(ga0[j]) * a0[j] + fsigmoid(gr0[j]) * r0[j]; o1[j] = fsigmoid(ga1[j]) * a1[j] + fsigmoid(gr1[j]) * r1[j]; }
                *(u32x4*)(O + off) = pack8(o0, o1); }
    }
};
struct EpiAct {
    static constexpr bool PERM = true, AFTER_DRAIN = false;
    const float *cw, *cb; bf16_t *ACT, *YB;
    static __device__ __forceinline__ f32x4 rot(const f32x4 v, const bool left) { f32x4 o;
#pragma unroll
        for (int j = 0; j < 4; ++j) { const float s = v[j]; const int x = __float_as_int(s);
            const int y = left ? __builtin_amdgcn_mov_dpp(x, 0x12F, 0xF, 0xF, true) : __builtin_amdgcn_mov_dpp(x, 0x121, 0xF, 0xF, true);
            o[j] = __int_as_float(y); }
        return o; }
    __device__ __forceinline__ void operator()(const f32x4 (&acc)[2][2][4][2], const Unit& u, int wr, int wc, int fr, int fq) const {
        constexpr int NF = 24576, DF = 12288;
        const int colb = u.pn * 128 + wc * 32 + 8 * fq;
        const bool f0 = fr == 0, f15 = fr == 15;
#pragma unroll
        for (int ai = 0; ai < 2; ++ai) { const int seg = u.pm * 4 + ai * 2 + wr;
            if (f0) {
#pragma unroll
                for (int mm = 0; mm < 2; ++mm) { bf16_t* yb = YB + ((size_t)seg * 4 + mm) * NF + colb; *(u32x4*)yb = pack8(acc[ai][0][mm][0], acc[ai][0][mm][1]); *(u32x4*)(yb + DF) = pack8(acc[ai][1][mm][0], acc[ai][1][mm][1]); } }
            if (f15) {
#pragma unroll
                for (int mm = 2; mm < 4; ++mm) { bf16_t* yb = YB + ((size_t)seg * 4 + mm) * NF + colb; *(u32x4*)yb = pack8(acc[ai][0][mm][0], acc[ai][0][mm][1]); *(u32x4*)(yb + DF) = pack8(acc[ai][1][mm][0], acc[ai][1][mm][1]); } } }
        unsigned pk0[2][4][2];
#pragma unroll
        for (int n = 0; n < 2; ++n) { const int c0 = colb + 4 * n;
            const f32x4 wv0 = *(const f32x4*)(cw + c0), wv1 = *(const f32x4*)(cw + NF + c0), wv2 = *(const f32x4*)(cw + 2 * NF + c0), bv = *(const f32x4*)(cb + c0);
            const f32x4 wg0 = *(const f32x4*)(cw + DF + c0), wg1 = *(const f32x4*)(cw + NF + DF + c0), wg2 = *(const f32x4*)(cw + 2 * NF + DF + c0), bg = *(const f32x4*)(cb + DF + c0);
#pragma unroll
            for (int ai = 0; ai < 2; ++ai) { const int rowb = u.pm * BM + ai * HALF + wr * 64 + 4 * fr;
                const f32x4 Uv = rot(acc[ai][0][3][n], false), Ug = rot(acc[ai][1][3][n], false);
                const f32x4 Dv = rot(acc[ai][0][0][n], true), Dg = rot(acc[ai][1][0][n], true);
#pragma unroll
                for (int m = 0; m < 4; ++m) { const f32x4 v = acc[ai][0][m][n], g = acc[ai][1][m][n];
                    const f32x4 upv = m == 0 ? Uv : acc[ai][0][m == 0 ? 0 : m - 1][n], upg = m == 0 ? Ug : acc[ai][1][m == 0 ? 0 : m - 1][n];
                    const f32x4 dnv = m == 3 ? Dv : acc[ai][0][m == 3 ? 3 : m + 1][n], dng = m == 3 ? Dg : acc[ai][1][m == 3 ? 3 : m + 1][n];
                    f32x4 a;
#pragma unroll
                    for (int j = 0; j < 4; ++j) {
                        const float uv = bv[j] + wv0[j] * upv[j] + wv1[j] * v[j] + wv2[j] * dnv[j], ug = bg[j] + wg0[j] * upg[j] + wg1[j] * g[j] + wg2[j] * dng[j];
                        a[j] = fgelu(ug) * uv; }
                    const unsigned p0 = cvt_pk_bf16(a[0], a[1]), p1 = cvt_pk_bf16(a[2], a[3]);
                    if (n == 0) { pk0[ai][m][0] = p0; pk0[ai][m][1] = p1; }
                    else { const bool fix = (m == 0 && f0) || (m == 3 && f15);
                        if (!fix) { u32x4 w; w.x = pk0[ai][m][0]; w.y = pk0[ai][m][1]; w.z = p0; w.w = p1; *(u32x4*)(ACT + (size_t)(rowb + m) * DF + colb) = w; } } } } }
    }
};
#undef EPI_ROWS

template <class Epi, class Sched, bool ALIGN_EPI = false, bool SP2 = false, bool APERM = false>
__device__ __forceinline__ void gemm_phase(PG8_LAS unsigned char* lds, const Gemm g, const Sched& S, const Epi& E, const int tid) {
    const int wid = __builtin_amdgcn_readfirstlane(tid >> 6), lane = tid & 63, wr = wid >> 2, wc = wid & 3, fr = lane & 15, fq = lane >> 4;
    const int K = g.K, nt = K / BK;
    unsigned voffA[2], voffB[2];
#pragma unroll
    for (int i = 0; i < 2; ++i) { int R, C; stage_rc(tid * 16 + i * 8192, R, C); const int Rb = Epi::PERM ? ((R & ~31) + perm32(R & 31)) : R;
        const int Ra = APERM ? ((R & ~63) | (4 * (R & 15) + ((R >> 4) & 3))) : R;
        voffA[i] = (unsigned)(Ra * K + C) * 2u; voffB[i] = (unsigned)(Rb * K + C) * 2u; }
    const size_t kstep = (size_t)(BK * 2);
    const size_t hstep = (size_t)HALF * K * 2;
    const size_t tstep = 2 * hstep;
    const unsigned ldsw = (unsigned)wid * 1024u;
    const int aoff = lds_byte(wr * 64 + fr, fq * 8), boff = lds_byte(wc * 32 + fr, fq * 8);
#define PG8_SA(b, h) (((b) * 2 + (h)) * HTB)
#define PG8_SB(b, h) ((4 + (b) * 2 + (h)) * HTB)
#define PG8_STAGE(bufoff, gbase, voff) do { _Pragma("unroll") for (int _i = 0; _i < 2; ++_i) \
        __builtin_amdgcn_global_load_lds((const unsigned*)((const char*)(gbase) + (voff)[_i]), (PG8_LAS unsigned*)(lds + (bufoff) + ldsw + _i * 8192), 16, 0, 0); } while (0)
#define PG8_LDA(dst, b, h) do { _Pragma("unroll") for (int m = 0; m < 4; ++m) _Pragma("unroll") for (int k = 0; k < 2; ++k) dst[m][k] = *(const PG8_LAS bf16x8*)(lds + PG8_SA(b, h) + aoff + m * 2048 + k * 1024); } while (0)
#define PG8_LDB(dst, b, h) do { _Pragma("unroll") for (int n = 0; n < 2; ++n) _Pragma("unroll") for (int k = 0; k < 2; ++k) dst[n][k] = *(const PG8_LAS bf16x8*)(lds + PG8_SB(b, h) + boff + n * 2048 + k * 1024); } while (0)
#define PG8_MMA(ai, bj, At, Bt) do { __builtin_amdgcn_s_setprio(1); _Pragma("unroll") for (int m = 0; m < 4; ++m) _Pragma("unroll") for (int n = 0; n < 2; ++n) _Pragma("unroll") for (int k = 0; k < 2; ++k) \
        acc[ai][bj][m][n] = __builtin_amdgcn_mfma_f32_16x16x32_bf16(Bt[n][k], At[m][k], acc[ai][bj][m][n], 0, 0, 0); __builtin_amdgcn_s_setprio(0); } while (0)
#define PG8_WAIT_V(n) asm volatile("s_waitcnt vmcnt(" #n ")" ::: "memory")
#define PG8_WAIT_L(n) asm volatile("s_waitcnt lgkmcnt(" #n ")" ::: "memory")
#define PG8_BAR __builtin_amdgcn_s_barrier()
#define PG8_SCHED __builtin_amdgcn_sched_barrier(0)
    Unit cur, nxt; int ui = 0;
    if (!S.next(0, cur)) return;
    f32x4 acc[2][2][4][2];
#pragma unroll
    for (int a = 0; a < 2; ++a)
#pragma unroll
        for (int b = 0; b < 2; ++b)
#pragma unroll
            for (int m = 0; m < 4; ++m)
#pragma unroll
                for (int n = 0; n < 2; ++n) acc[a][b][m][n] = (f32x4){0.f, 0.f, 0.f, 0.f};
    bf16x8 At[4][2], B0[2][2], B1[2][2];
    const char* cA = (const char*)g.A + (size_t)cur.pm * tstep; const char* cB = (const char*)g.Bt + (size_t)cur.pn * tstep;
    S.a_ready(cur);
    if constexpr (SP2) {
        PG8_STAGE(PG8_SB(0, 0), cB, voffB); PG8_STAGE(PG8_SB(0, 1), cB + hstep, voffB); PG8_STAGE(PG8_SA(0, 0), cA, voffA); PG8_STAGE(PG8_SA(0, 1), cA + hstep, voffA);
        if (wr == 1) PG8_BAR;
        PG8_WAIT_V(2); PG8_BAR;
        PG8_STAGE(PG8_SB(1, 0), cB + kstep, voffB); PG8_STAGE(PG8_SA(1, 0), cA + kstep, voffA); PG8_STAGE(PG8_SB(1, 1), cB + hstep + kstep, voffB);
        PG8_WAIT_V(6); PG8_BAR;
    } else {
        PG8_STAGE(PG8_SB(0, 0), cB, voffB); PG8_STAGE(PG8_SA(0, 0), cA, voffA); PG8_STAGE(PG8_SB(0, 1), cB + hstep, voffB); PG8_STAGE(PG8_SA(0, 1), cA + hstep, voffA);
        if (wr == 1) PG8_BAR;
        PG8_WAIT_V(4); PG8_BAR;
        PG8_STAGE(PG8_SB(1, 0), cB + kstep, voffB); PG8_STAGE(PG8_SA(1, 0), cA + kstep, voffA); PG8_STAGE(PG8_SB(1, 1), cB + hstep + kstep, voffB);
        PG8_WAIT_V(6); PG8_BAR;
    }
    for (;;) {
        const bool has_next = S.next(ui + 1, nxt);
        const char* nA = has_next ? (const char*)g.A + (size_t)nxt.pm * tstep : cA; const char* nB = has_next ? (const char*)g.Bt + (size_t)nxt.pn * tstep : cB;
        for (int t = 0; t < nt; t += 2) {
            const bool last = (t == nt - 2);
            const char* a1 = cA + (size_t)(t + 1) * kstep;
            const char* a2 = last ? nA : cA + (size_t)(t + 2) * kstep; const char* b2 = last ? nB : cB + (size_t)(t + 2) * kstep;
            const char* a3 = a2 + kstep; const char* b3 = b2 + kstep;
            if (last && has_next) S.a_ready(nxt);
            if constexpr (SP2) {
            PG8_LDB(B0, 0, 0); PG8_LDB(B1, 0, 1); PG8_SCHED; PG8_LDA(At, 0, 0); PG8_STAGE(PG8_SA(1, 1), a1 + hstep, voffA);
            PG8_WAIT_V(8); PG8_WAIT_L(0); PG8_BAR; PG8_MMA(0, 0, At, B0); PG8_MMA(0, 1, At, B1); PG8_BAR; PG8_SCHED;
            PG8_LDA(At, 0, 1); PG8_STAGE(PG8_SB(0, 0), b2, voffB); PG8_STAGE(PG8_SB(0, 1), b2 + hstep, voffB); PG8_STAGE(PG8_SA(0, 0), a2, voffA);
            PG8_WAIT_V(8); PG8_WAIT_L(0); PG8_BAR; PG8_MMA(1, 0, At, B0); PG8_MMA(1, 1, At, B1); PG8_BAR; PG8_SCHED;
            PG8_LDB(B0, 1, 0); PG8_LDB(B1, 1, 1); PG8_SCHED; PG8_LDA(At, 1, 0); PG8_STAGE(PG8_SA(0, 1), a2 + hstep, voffA);
            PG8_WAIT_V(8); PG8_WAIT_L(0); PG8_BAR; PG8_MMA(0, 0, At, B0); PG8_MMA(0, 1, At, B1); PG8_BAR; PG8_SCHED;
            PG8_LDA(At, 1, 1); PG8_STAGE(PG8_SB(1, 0), b3, voffB); PG8_STAGE(PG8_SB(1, 1), b3 + hstep, voffB); PG8_STAGE(PG8_SA(1, 0), a3, voffA);
            PG8_WAIT_V(8); PG8_WAIT_L(0); PG8_BAR; PG8_MMA(1, 0, At, B0); PG8_MMA(1, 1, At, B1); PG8_BAR; PG8_SCHED;
            } else {
            PG8_LDB(B0, 0, 0); PG8_SCHED; PG8_LDA(At, 0, 0); PG8_STAGE(PG8_SA(1, 1), a1 + hstep, voffA);
            PG8_WAIT_L(8); PG8_BAR; PG8_WAIT_L(0); PG8_MMA(0, 0, At, B0); PG8_BAR; PG8_SCHED;
            PG8_LDB(B1, 0, 1); PG8_STAGE(PG8_SB(0, 0), b2, voffB);
            PG8_BAR; PG8_WAIT_L(0); PG8_MMA(0, 1, At, B1); PG8_BAR;
            PG8_LDA(At, 0, 1); PG8_STAGE(PG8_SA(0, 0), a2, voffA);
            PG8_BAR; PG8_WAIT_L(0); PG8_MMA(1, 0, At, B0); PG8_BAR; PG8_SCHED;
            PG8_STAGE(PG8_SB(0, 1), b2 + hstep, voffB);
            PG8_WAIT_V(6); PG8_BAR; PG8_MMA(1, 1, At, B1); PG8_BAR;
            PG8_LDB(B0, 1, 0); PG8_SCHED; PG8_LDA(At, 1, 0); PG8_STAGE(PG8_SA(0, 1), a2 + hstep, voffA);
            PG8_WAIT_L(8); PG8_BAR; PG8_WAIT_L(0); PG8_MMA(0, 0, At, B0); PG8_BAR; PG8_SCHED;
            PG8_LDB(B1, 1, 1); PG8_STAGE(PG8_SB(1, 0), b3, voffB);
            PG8_BAR; PG8_WAIT_L(0); PG8_MMA(0, 1, At, B1); PG8_BAR;
            PG8_LDA(At, 1, 1); PG8_STAGE(PG8_SA(1, 0), a3, voffA);
            PG8_BAR; PG8_WAIT_L(0); PG8_MMA(1, 0, At, B0); PG8_BAR; PG8_SCHED;
            PG8_STAGE(PG8_SB(1, 1), b3 + hstep, voffB);
            PG8_WAIT_V(6); PG8_BAR; PG8_MMA(1, 1, At, B1); PG8_BAR;
            }
        }
        if constexpr (ALIGN_EPI) { if (wr == 0) PG8_BAR; }
        if constexpr (!Epi::AFTER_DRAIN) { E(acc, cur, wr, wc, fr, fq); S.done(cur); }
        if (!has_next) break;
#pragma unroll
        for (int a = 0; a < 2; ++a)
#pragma unroll
            for (int b = 0; b < 2; ++b)
#pragma unroll
                for (int m = 0; m < 4; ++m)
#pragma unroll
                    for (int n = 0; n < 2; ++n) acc[a][b][m][n] = (f32x4){0.f, 0.f, 0.f, 0.f};
        cur = nxt; cA = nA; cB = nB; ++ui;
        if constexpr (ALIGN_EPI) { if (wr == 1) PG8_BAR; }
    }
    PG8_WAIT_V(0);
    if constexpr (!ALIGN_EPI) { if (wr == 0) PG8_BAR; }
    PG8_BAR;
    if constexpr (Epi::AFTER_DRAIN) { E.fused(acc, cur, wr, wc, fr, fq, lds, wid, lane); S.done(cur); }
#undef PG8_SA
#undef PG8_SB
#undef PG8_STAGE
#undef PG8_LDA
#undef PG8_LDB
#undef PG8_MMA
#undef PG8_WAIT_V
#undef PG8_WAIT_L
#undef PG8_BAR
#undef PG8_SCHED
}
}

constexpr int NWAVES = 8;
constexpr int D = 4096, M = 32768, SEQ_P = 16384, SEQ_S = 2048;
constexpr int ATTN_W = 2048, KV_W = 512, D_RNN = 4096, D_FF = 12288, PLE = 256, IN_W = 11264;
constexpr int MSB = 8192, NSB = M / MSB;
constexpr int NBOUND = SEQ_P / MSB - 1;
constexpr int LCH = 32, NCHUNK = M / LCH;
constexpr float EPS = 1e-6f;
constexpr float LOG2E = 1.4426950408889634f;

constexpr size_t MiB = 1u << 20;
constexpr size_t WS_CTL = 0, CTL_ZERO_BYTES = 1 * MiB;
constexpr size_t WS_H = 1 * MiB;
constexpr size_t WS_Q = WS_H + 256 * MiB;
constexpr size_t WS_K = WS_Q + 128 * MiB;
constexpr size_t WS_V = WS_K + 32 * MiB;
constexpr size_t WS_REC = WS_V + 32 * MiB;
constexpr size_t WS_G = WS_REC + 256 * MiB;
constexpr size_t WS_MRG = WS_G + 256 * MiB;
constexpr size_t WS_AGG = WS_MRG + 256 * MiB;
constexpr size_t WS_CIN = WS_AGG + 64 * MiB;
constexpr size_t WS_W1 = WS_CIN + 32 * MiB;
constexpr size_t WS_WIN = WS_W1;
constexpr size_t WS_WG = WS_WIN + 88 * MiB;
constexpr size_t WS_WOA = WS_WG + 64 * MiB;
constexpr size_t WS_WOR = WS_WOA + 16 * MiB;
constexpr size_t WS_WOUT = WS_WOR + 32 * MiB;
constexpr size_t WS_LWA = WS_WOUT + 32 * MiB;
constexpr size_t WS_LWX = WS_LWA + 4 * MiB;
constexpr size_t WS_END1 = WS_LWX + 4 * MiB;
constexpr size_t WS_HN2 = 1 * MiB;
constexpr size_t WS_X2B = WS_HN2;
constexpr size_t WS_WUP = WS_HN2 + 256 * MiB;
constexpr size_t WS_WDN = WS_WUP + 192 * MiB;
constexpr size_t WS_WPG = WS_WDN + 96 * MiB;
constexpr size_t WS_WPL = WS_WPG + 32 * MiB;
constexpr size_t WS_PB = WS_WPL + 2 * MiB;
constexpr size_t WS_SS = WS_PB + 16 * MiB;
constexpr size_t WS_RSE = WS_SS + 8 * MiB;
constexpr size_t WS_YB = WS_RSE + 1 * MiB;
constexpr size_t WS_ACT = WS_YB + 96 * MiB;
constexpr size_t WS_END2 = WS_ACT + 768 * MiB;
constexpr size_t WS_EU = WS_ACT;
constexpr size_t WS_X3B = WS_ACT + 256 * MiB;
constexpr size_t WS_NEED = (WS_END1 > WS_END2 ? WS_END1 : WS_END2);
static_assert(WS_NEED <= (size_t)1664 * MiB, "d_ws map exceeds the guaranteed workspace");
constexpr int CW_BAR = 4096;

constexpr int RING_OFF = 0;
#ifndef LRU_PITCH
#define LRU_PITCH 264
#endif
constexpr int LRU_P = LRU_PITCH;
constexpr int L_XCF = 0, L_AS = L_XCF + LCH * LRU_P * 4, L_BS = L_AS + LCH * LRU_P * 4, L_HS = L_BS + LCH * LRU_P * 4, L_XCB = L_HS + LCH * LRU_P * 4, L_END = L_XCB + LCH * LRU_P * 2;
constexpr int VT_PITCH = 816;
constexpr int MISC_OFF = 153600, L_KC = MISC_OFF + 512, LDS_BYTES = L_KC + 6 * 256 * 4;
static_assert(L_END <= MISC_OFF && 128 * VT_PITCH <= MISC_OFF && 131072 <= MISC_OFF, "LDS map");

#define GAS __attribute__((address_space(1)))
#define LAS __attribute__((address_space(3)))
typedef unsigned short bf16;
typedef unsigned v4u __attribute__((ext_vector_type(4)));
typedef unsigned v2u __attribute__((ext_vector_type(2)));
typedef float f32x4 __attribute__((ext_vector_type(4)));
typedef float f32x16 __attribute__((ext_vector_type(16)));
typedef float f32x2 __attribute__((ext_vector_type(2)));
typedef short bf16x8 __attribute__((ext_vector_type(8)));
typedef GAS unsigned gu32;
#define RLX_AGENT __ATOMIC_RELAXED, __HIP_MEMORY_SCOPE_AGENT
#define LDS_WAIT() asm volatile("s_waitcnt lgkmcnt(0)" ::: "memory")
#define VM_WAIT() asm volatile("s_waitcnt vmcnt(0)" ::: "memory")
__device__ __forceinline__ unsigned f2bf(float f) { unsigned u = __builtin_bit_cast(unsigned, f); return (u + 0x7fffu + ((u >> 16) & 1u)) >> 16; }
__device__ __forceinline__ unsigned pk2(float lo, float hi) { return f2bf(lo) | (f2bf(hi) << 16); }
using pg8::fsigmoid; using pg8::fgelu; using pg8::bf_lo; using pg8::bf_hi;

#define XB_TMO      128
#define XB_XCNT(j)  (256  + 64 * (j))
#define XB_XSUB(j)  (1280 + 64 * (j))
#define XB_XGEN(j)  (2304 + 64 * (j))
#define XB_TOP      3328
#define XB_TOPGEN   3392
#define XCD_BAR_WORDS 3456
#define XB_SPIN_CAP (1u << 18)

__device__ __forceinline__ unsigned xb_ld(unsigned* p)              { return __hip_atomic_load(p, __ATOMIC_RELAXED, __HIP_MEMORY_SCOPE_AGENT); }
__device__ __forceinline__ unsigned xb_add(unsigned* p, unsigned v) { return __hip_atomic_fetch_add(p, v, __ATOMIC_RELAXED, __HIP_MEMORY_SCOPE_AGENT); }
__device__ __forceinline__ unsigned xb_xcc_id() { return (unsigned)__builtin_amdgcn_s_getreg((3 << 11) | 20) & 0xFu; }
#define XB_SPIN(cond, bar) do { unsigned _sp = 0; while (cond) { __builtin_amdgcn_s_sleep(1); \
    if ((++_sp & 255u) == 0u) { if (xb_ld(&(bar)[XB_TMO])) break; if (_sp > XB_SPIN_CAP) { atomicAdd(&(bar)[XB_TMO], 1u); break; } } } } while (0)

struct XcdBarrier {
    unsigned* bar; unsigned x;
    volatile LAS unsigned* st;
};

__device__ __forceinline__ XcdBarrier xcd_barrier_post(unsigned* bar, volatile LAS unsigned* st) {
    XcdBarrier b; b.bar = bar; b.x = xb_xcc_id(); b.st = st;
    if (threadIdx.x == 0) (void)xb_add(&bar[XB_XCNT(b.x)], 1u);
    return b;
}
__device__ __forceinline__ void xcd_barrier_complete(unsigned* bar, unsigned x, unsigned& nloc, unsigned& nx) {
    const unsigned G = gridDim.x * gridDim.y * gridDim.z;
    unsigned sum, cnt, mine, sp = 0u;
    for (;;) {
        sum = 0u; cnt = 0u; mine = 0u;
#pragma unroll
        for (unsigned j = 0; j < 16; ++j) { const unsigned c = xb_ld(&bar[XB_XCNT(j)]); sum += c; cnt += (c > 0u) ? 1u : 0u; mine = (j == x) ? c : mine; }
        if (sum == G) break;
        __builtin_amdgcn_s_sleep(1);
        if ((++sp & 255u) == 0u) { if (xb_ld(&bar[XB_TMO])) break; if (sp > XB_SPIN_CAP) { atomicAdd(&bar[XB_TMO], 1u); break; } }
    }
    nloc = mine > 0u ? mine : 1u; nx = cnt > 0u ? cnt : 1u;
}

__device__ __forceinline__ void xcd_barrier(const XcdBarrier& b, const int tid) {
    asm volatile("s_waitcnt vmcnt(0)" ::: "memory");
    __syncthreads();
    if (tid == 0) {
        unsigned* bar = b.bar;
        __builtin_amdgcn_s_waitcnt(0);
        unsigned nloc = b.st[0], nx = b.st[1];
        if (nloc == 0u) { xcd_barrier_complete(bar, b.x, nloc, nx); b.st[0] = nloc; b.st[1] = nx; }
        const unsigned old = xb_add(&bar[XB_XSUB(b.x)], 1u);
        const unsigned gen = old / nloc;
        if (old + 1u == (gen + 1u) * nloc) {
            __builtin_amdgcn_fence(__ATOMIC_RELEASE, "agent");
            asm volatile("s_waitcnt vmcnt(0)" ::: "memory");
            const unsigned og = xb_add(&bar[XB_TOP], 1u);
            const unsigned tg = og / nx;
            if (og + 1u == (tg + 1u) * nx) xb_add(&bar[XB_TOPGEN], 1u);
            else XB_SPIN(xb_ld(&bar[XB_TOPGEN]) == tg, bar);
            __builtin_amdgcn_fence(__ATOMIC_ACQUIRE, "agent");
            xb_add(&bar[XB_XGEN(b.x)], 1u);
            asm volatile("s_waitcnt vmcnt(0)" ::: "memory");
        } else {
            XB_SPIN(xb_ld(&bar[XB_XGEN(b.x)]) == gen, bar);
            __builtin_amdgcn_fence(__ATOMIC_ACQUIRE, "agent");
            asm volatile("s_waitcnt vmcnt(0)" ::: "memory");
        }
    }
    __syncthreads();
}

struct Frame {
    LAS unsigned char* lds;
    volatile LAS unsigned* MISC;
    gu32* ctl;
    int tid, lane, wave;
    int vcu, G;
};
__device__ __forceinline__ float wave_sum(float v) {
#pragma unroll
    for (int o = 1; o < 64; o <<= 1) v += __shfl_xor(v, o);
    return v;
}
__device__ __forceinline__ void seq_bounds(int row, int& s0, int& s1) { if (row < SEQ_P) { s0 = 0; s1 = SEQ_P; } else { s0 = row & ~(SEQ_S - 1); s1 = s0 + SEQ_S; } }

__device__ __forceinline__ void tr_load(const float* src, int N, int lane, float (&v)[32]) {
#pragma unroll
    for (int i = 0; i < 32; ++i) v[i] = src[(size_t)(2 * i + (lane >> 5)) * N + (lane & 31)];
}
__device__ __forceinline__ void tr_store(const float (&v)[32], bf16* dst, int K, LAS float* scr, int lane) {
#pragma unroll
    for (int i = 0; i < 32; ++i) scr[(2 * i + (lane >> 5)) * 33 + (lane & 31)] = v[i];
    LDS_WAIT(); asm volatile("" ::: "memory");
    const int c = lane & 7;
#pragma unroll
    for (int j = 0; j < 4; ++j) { const int n = (lane >> 3) + 8 * j; const LAS float* s = scr + (8 * c) * 33 + n;
        v4u o; o.x = pk2(s[0 * 33], s[1 * 33]); o.y = pk2(s[2 * 33], s[3 * 33]); o.z = pk2(s[4 * 33], s[5 * 33]); o.w = pk2(s[6 * 33], s[7 * 33]);
        *(GAS v4u*)(dst + (size_t)n * K + 8 * c) = o; }
    LDS_WAIT(); asm volatile("" ::: "memory");
}
__device__ __forceinline__ void convert_weight(Frame& F, const float* W, int K, int N, int nmat, bf16* WT) {
    LAS float* scr = (LAS float*)(F.lds + RING_OFF + F.wave * 16384);
    const int gw = F.vcu * NWAVES + F.wave, NGW = F.G * NWAVES, lane = F.lane;
    const int nblk = N / 32, per = (K / 64) * nblk, total = per * nmat;
#define CW_SRC(it) (W + (size_t)((it) / per) * K * N + (size_t)(64 * (((it) % per) / nblk)) * N + 32 * (((it) % per) % nblk))
#define CW_DST(it) (WT + (size_t)((it) / per) * K * N + (size_t)(32 * (((it) % per) % nblk)) * K + 64 * (((it) % per) / nblk))
    float cur[32], nxt[32];
    int it = gw; if (it < total) tr_load(CW_SRC(it), N, lane, cur);
    for (; it < total; it += NGW) { const int nit = it + NGW;
        if (nit < total) tr_load(CW_SRC(nit), N, lane, nxt);
        tr_store(cur, CW_DST(it), K, scr, lane);
#pragma unroll
        for (int i = 0; i < 32; ++i) cur[i] = nxt[i]; }
#undef CW_SRC
#undef CW_DST
}
__device__ __forceinline__ void rms_brow_to_bf16(const bf16* xrow, const float* g, bf16* orow, int lane) {
    const GAS v4u* xr = (const GAS v4u*)xrow + lane;
    v4u v[8]; float s = 0.f;
#pragma unroll
    for (int j = 0; j < 8; ++j) { v[j] = xr[64 * j];
        const float a0 = bf_lo(v[j].x), a1 = bf_hi(v[j].x), a2 = bf_lo(v[j].y), a3 = bf_hi(v[j].y), a4 = bf_lo(v[j].z), a5 = bf_hi(v[j].z), a6 = bf_lo(v[j].w), a7 = bf_hi(v[j].w);
        s += ((a0 * a0 + a1 * a1) + (a2 * a2 + a3 * a3)) + ((a4 * a4 + a5 * a5) + (a6 * a6 + a7 * a7)); }
    const float rstd = 1.0f / sqrtf(wave_sum(s) * (1.f / D) + EPS);
    const GAS f32x4* gr = (const GAS f32x4*)g + 2 * lane;
    GAS v4u* o8 = (GAS v4u*)orow + lane;
#pragma unroll
    for (int j = 0; j < 8; ++j) { const f32x4 g0 = gr[128 * j], g1 = gr[128 * j + 1]; v4u w;
        w.x = pk2(bf_lo(v[j].x) * rstd * g0.x, bf_hi(v[j].x) * rstd * g0.y); w.y = pk2(bf_lo(v[j].y) * rstd * g0.z, bf_hi(v[j].y) * rstd * g0.w);
        w.z = pk2(bf_lo(v[j].z) * rstd * g1.x, bf_hi(v[j].z) * rstd * g1.y); w.w = pk2(bf_lo(v[j].w) * rstd * g1.z, bf_hi(v[j].w) * rstd * g1.w); o8[64 * j] = w; }
}
__device__ __forceinline__ void rms_row_to_bf16(const float* xrow, const float* g, bf16* orow, int lane) {
    const GAS f32x4* xr = (const GAS f32x4*)xrow + lane;
    f32x4 v[16]; float s = 0.f;
#pragma unroll
    for (int j = 0; j < 16; ++j) { v[j] = xr[64 * j]; s += (v[j].x * v[j].x + v[j].y * v[j].y) + (v[j].z * v[j].z + v[j].w * v[j].w); }
    const float rstd = 1.0f / sqrtf(wave_sum(s) * (1.f / D) + EPS);
    const GAS f32x4* gr = (const GAS f32x4*)g + lane;
    GAS v2u* o8 = (GAS v2u*)orow + lane;
#pragma unroll
    for (int j = 0; j < 16; ++j) { const f32x4 gv = gr[64 * j]; v2u w; w.x = pk2(v[j].x * rstd * gv.x, v[j].y * rstd * gv.y); w.y = pk2(v[j].z * rstd * gv.z, v[j].w * rstd * gv.w); o8[64 * j] = w; }
}

__device__ __forceinline__ void attn_unit(Frame& F, const bf16* Qb, const bf16* Kb, const bf16* Vb, bf16* Ob, const float* sink, int qblk, int hkv) {
    LAS unsigned char* lds = F.lds;
    const int lane = F.lane, wave = F.wave;
    const int row_blk = qblk * 128; int s0, s1; seq_bounds(row_blk, s0, s1);
    const int kbase = row_blk - 128;
    __syncthreads();
#pragma unroll
    for (int oo = 0; oo < 2; ++oo) { const int o = 2 * wave + oo;
#pragma unroll
        for (int j = 0; j < 4; ++j) { const int kp = lane + 64 * j;
            if (kp < 200) { const int r0 = kbase + 2 * kp;
                v4u a = (v4u){0u, 0u, 0u, 0u}, b = a;
                if (r0 >= s0 && r0 < s1) { a = *(const GAS v4u*)(Vb + (size_t)r0 * KV_W + hkv * 128 + 8 * o); b = *(const GAS v4u*)(Vb + (size_t)(r0 + 1) * KV_W + hkv * 128 + 8 * o); }
                LAS unsigned char* dst = lds + (8 * o) * VT_PITCH + 4 * kp;
                *(LAS unsigned*)(dst + 0 * VT_PITCH) = (a.x & 0xffffu) | (b.x << 16);
                *(LAS unsigned*)(dst + 1 * VT_PITCH) = (a.x >> 16) | (b.x & 0xffff0000u);
                *(LAS unsigned*)(dst + 2 * VT_PITCH) = (a.y & 0xffffu) | (b.y << 16);
                *(LAS unsigned*)(dst + 3 * VT_PITCH) = (a.y >> 16) | (b.y & 0xffff0000u);
                *(LAS unsigned*)(dst + 4 * VT_PITCH) = (a.z & 0xffffu) | (b.z << 16);
                *(LAS unsigned*)(dst + 5 * VT_PITCH) = (a.z >> 16) | (b.z & 0xffff0000u);
                *(LAS unsigned*)(dst + 6 * VT_PITCH) = (a.w & 0xffffu) | (b.w << 16);
                *(LAS unsigned*)(dst + 7 * VT_PITCH) = (a.w >> 16) | (b.w & 0xffff0000u);
            } } }
    __syncthreads();
    const int qn = lane & 15, quad = lane >> 4;
    const int r0q = row_blk + 16 * wave, ks = r0q - 128, tq = r0q + qn;
    const unsigned kvoff = (unsigned)(qn * KV_W + 8 * quad) * 2u;
    for (int gp = 0; gp < 2; ++gp) {
        bf16x8 qf[2][4];
#pragma unroll
        for (int h = 0; h < 2; ++h)
#pragma unroll
            for (int kk = 0; kk < 4; ++kk) qf[h][kk] = *(const GAS bf16x8*)(Qb + (size_t)tq * ATTN_W + (hkv * 4 + 2 * gp + h) * 128 + 32 * kk + 8 * quad);
        f32x4 s[2][18];
#define ATT_SB __builtin_amdgcn_sched_barrier(0)
#define ATT_KLOAD(buf, t) do { int trow = ksu + 16 * (t); trow = trow < 0 ? 0 : (trow > M - 16 ? M - 16 : trow); \
            const GAS char* kp = (const GAS char*)(Kb + (size_t)trow * KV_W + hkv * 128) + kvoff; _Pragma("unroll") for (int kk = 0; kk < 4; ++kk) buf[kk] = *(const GAS bf16x8*)(kp + 64 * kk); } while (0)
#define ATT_KMMA(buf, t) do { _Pragma("unroll") for (int h = 0; h < 2; ++h) { f32x4 acc = (f32x4){0.f, 0.f, 0.f, 0.f}; \
            _Pragma("unroll") for (int kk = 0; kk < 4; ++kk) acc = __builtin_amdgcn_mfma_f32_16x16x32_bf16(buf[kk], qf[h][kk], acc, 0, 0, 0); s[h][t] = acc; } } while (0)
        const int ksu = __builtin_amdgcn_readfirstlane(ks);
        bf16x8 ka[4], kb2[4];
        ATT_KLOAD(ka, 0); ATT_KLOAD(kb2, 1); ATT_SB;
#pragma unroll
        for (int t = 0; t < 18; t += 2) {
            ATT_KMMA(ka, t); ATT_SB; if (t + 2 < 18) { ATT_KLOAD(ka, t + 2); ATT_SB; }
            ATT_KMMA(kb2, t + 1); ATT_SB; if (t + 3 < 18) { ATT_KLOAD(kb2, t + 3); ATT_SB; } }
#undef ATT_KLOAD
#undef ATT_KMMA
        v4u pk[2][9]; float invh[2];
#pragma unroll
        for (int h = 0; h < 2; ++h) { const int hq = hkv * 4 + 2 * gp + h;
            const float slope2 = exp2f(-0.5f * (float)(hq + 1)) * LOG2E, sink2 = sink[hq] * LOG2E;
            float mx = -3.0e38f;
            int kso = ks; asm volatile("" : "+v"(kso));
#pragma unroll
            for (int t = 0; t < 18; ++t)
#pragma unroll
                for (int r = 0; r < 4; ++r) { const int tk = kso + 16 * t + 4 * quad + r; int dist = tq - tk; dist = dist < 0 ? -dist : dist;
                    const bool ok = (dist <= 128) && (tk >= s0) && (tk < s1);
                    const float v = ok ? s[h][t][r] - slope2 * (float)dist : -1.0e30f; s[h][t][r] = v; mx = fmaxf(mx, v); }
            mx = fmaxf(mx, __shfl_xor(mx, 16)); mx = fmaxf(mx, __shfl_xor(mx, 32)); mx = fmaxf(mx, sink2);
            float l = 0.f;
#pragma unroll
            for (int t = 0; t < 18; ++t)
#pragma unroll
                for (int r = 0; r < 4; ++r) { const float p = __builtin_amdgcn_exp2f(s[h][t][r] - mx); s[h][t][r] = p; l += p; }
            l += __shfl_xor(l, 16); l += __shfl_xor(l, 32); l += __builtin_amdgcn_exp2f(sink2 - mx);
            invh[h] = 1.0f / l;
#pragma unroll
            for (int j = 0; j < 9; ++j) { pk[h][j].x = pg8::cvt_pk_bf16(s[h][2 * j][0], s[h][2 * j][1]); pk[h][j].y = pg8::cvt_pk_bf16(s[h][2 * j][2], s[h][2 * j][3]);
                pk[h][j].z = pg8::cvt_pk_bf16(s[h][2 * j + 1][0], s[h][2 * j + 1][1]); pk[h][j].w = pg8::cvt_pk_bf16(s[h][2 * j + 1][2], s[h][2 * j + 1][3]); } }
        f32x4 o[2][8];
#pragma unroll
        for (int h = 0; h < 2; ++h)
#pragma unroll
            for (int dt = 0; dt < 8; ++dt) o[h][dt] = (f32x4){0.f, 0.f, 0.f, 0.f};
#define ATT_VLOAD(j) do { _Pragma("unroll") for (int dt = 0; dt < 8; ++dt) { const LAS unsigned char* vp = lds + (16 * dt + qn) * VT_PITCH + 2 * (16 * wave + 32 * (j) + 4 * quad); \
            const v2u v0 = *(const LAS v2u*)vp, v1 = *(const LAS v2u*)(vp + 32); v4u vw; vw.x = v0.x; vw.y = v0.y; vw.z = v1.x; vw.w = v1.y; vf[dt] = __builtin_bit_cast(bf16x8, vw); } } while (0)
        bf16x8 vf[8];
        ATT_VLOAD(0); ATT_SB;
#pragma unroll
        for (int j = 0; j < 9; ++j) {
#pragma unroll
            for (int dt = 0; dt < 8; ++dt)
#pragma unroll
                for (int h = 0; h < 2; ++h) o[h][dt] = __builtin_amdgcn_mfma_f32_16x16x32_bf16(vf[dt], __builtin_bit_cast(bf16x8, pk[h][j]), o[h][dt], 0, 0, 0);
            ATT_SB;
            if (j < 8) { ATT_VLOAD(j + 1); ATT_SB; } }
#undef ATT_VLOAD
#pragma unroll
        for (int h = 0; h < 2; ++h) { const int hq = hkv * 4 + 2 * gp + h; const float inv = invh[h];
#pragma unroll
            for (int dt = 0; dt < 8; ++dt) { v2u w; w.x = pg8::cvt_pk_bf16(o[h][dt][0] * inv, o[h][dt][1] * inv); w.y = pg8::cvt_pk_bf16(o[h][dt][2] * inv, o[h][dt][3] * inv);
                *(GAS v2u*)(Ob + (size_t)tq * ATTN_W + hq * 128 + 16 * dt + 4 * quad) = w; } }
#undef ATT_SB
    }
}

__device__ __forceinline__ void unpack_row(const v4u x, float (&o)[8]) { o[0] = bf_lo(x.x); o[1] = bf_hi(x.x); o[2] = bf_lo(x.y); o[3] = bf_hi(x.y); o[4] = bf_lo(x.z); o[5] = bf_hi(x.z); o[6] = bf_lo(x.w); o[7] = bf_hi(x.w); }
__device__ __forceinline__ void load8f(const float* p, float (&o)[8]) { const f32x4 a = *(const GAS f32x4*)p, b = *(const GAS f32x4*)(p + 4); o[0] = a.x; o[1] = a.y; o[2] = a.z; o[3] = a.w; o[4] = b.x; o[5] = b.y; o[6] = b.z; o[7] = b.w; }
__device__ __forceinline__ v4u xr_row(const bf16* XR, int r, int s0, int s1, int c0) { if (r < s0 || r >= s1) return (v4u){0u, 0u, 0u, 0u}; return *(const GAS v4u*)(XR + (size_t)r * D_RNN + c0); }
__device__ __forceinline__ void conv_phase(Frame& F, const bf16* XR, const float* cw, const float* cb, bf16* XC) {
    const int gt = (F.vcu * NWAVES + F.wave) * 64 + F.lane, NGT = F.G * NWAVES * 64;
    constexpr int NOCT = D_RNN / 8, RUN = 32;
    for (int it = gt; it < (M / RUN) * NOCT; it += NGT) { const int oc = it % NOCT, run = it / NOCT, c0 = 8 * oc, t0 = run * RUN;
        int s0, s1; seq_bounds(t0, s0, s1);
        float w[4][8], bias[8];
#pragma unroll
        for (int k = 0; k < 4; ++k) load8f(cw + (size_t)k * D_RNN + c0, w[k]);
        load8f(cb + c0, bias);
        float xm[8], x0[8], x1[8];
        unpack_row(xr_row(XR, t0 - 1, s0, s1, c0), xm); unpack_row(xr_row(XR, t0, s0, s1, c0), x0); unpack_row(xr_row(XR, t0 + 1, s0, s1, c0), x1);
        for (int i = 0; i < RUN; i += 4) { v4u pv[4];
#pragma unroll
            for (int q = 0; q < 4; ++q) pv[q] = xr_row(XR, t0 + i + q + 2, s0, s1, c0);
#pragma unroll
            for (int q = 0; q < 4; ++q) { float x2[8], o[8]; unpack_row(pv[q], x2);
#pragma unroll
                for (int e = 0; e < 8; ++e) { o[e] = bias[e] + w[0][e] * xm[e] + w[1][e] * x0[e] + w[2][e] * x1[e] + w[3][e] * x2[e]; xm[e] = x0[e]; x0[e] = x1[e]; x1[e] = x2[e]; }
                v4u pw; pw.x = pk2(o[0], o[1]); pw.y = pk2(o[2], o[3]); pw.z = pk2(o[4], o[5]); pw.w = pk2(o[6], o[7]);
                *(GAS v4u*)(XC + (size_t)(t0 + i + q) * D_RNN + c0) = pw; } }
    }
}
__device__ __forceinline__ void conv_fix_phase(Frame& F, const bf16* XB, const float* cw, const float* cb, bf16* XC) {
    const int gt = (F.vcu * NWAVES + F.wave) * 64 + F.lane, NGT = F.G * NWAVES * 64;
    constexpr int NOCT = D_RNN / 8;
    for (int it = gt; it < (M / 64) * 3 * NOCT; it += NGT) { const int oc = it % NOCT, q = (it / NOCT) % 3, seg = it / (3 * NOCT), c0 = 8 * oc, t = seg * 64 + (q == 0 ? 0 : 61 + q);
        int s0, s1; seq_bounds(t, s0, s1);
        float o[8]; load8f(cb + c0, o);
#pragma unroll
        for (int k = 0; k < 4; ++k) { const int tt = t - 1 + k;
            if (tt >= s0 && tt < s1) { const int sg = tt >> 6, rr = tt & 63, slot = rr < 3 ? rr : rr - 58; float x[8], w[8];
                unpack_row(*(const GAS v4u*)(XB + ((size_t)sg * 6 + slot) * D_RNN + c0), x); load8f(cw + (size_t)k * D_RNN + c0, w);
#pragma unroll
                for (int e = 0; e < 8; ++e) o[e] += w[e] * x[e]; } }
        v4u pw; pw.x = pk2(o[0], o[1]); pw.y = pk2(o[2], o[3]); pw.z = pk2(o[4], o[5]); pw.w = pk2(o[6], o[7]);
        *(GAS v4u*)(XC + (size_t)t * D_RNN + c0) = pw; }
}
__device__ __forceinline__ void lru_load_b(bf16x8 (&wb)[32], const bf16* WA, const bf16* WX, int dir, int n, int wave, int lane) {
    const size_t o = ((size_t)((dir * 16 + n) * 8 + wave) * 16 * 64 + lane) * 8;
#pragma unroll
    for (int kk = 0; kk < 16; ++kk) { wb[kk] = *(const GAS bf16x8*)(WA + o + (size_t)kk * 512); wb[16 + kk] = *(const GAS bf16x8*)(WX + o + (size_t)kk * 512); }
}
__device__ __forceinline__ void convert_lru_weight(Frame& F, const float* W, bf16* WT) {
    const int gt = (F.vcu * NWAVES + F.wave) * 64 + F.lane, NGT = F.G * NWAVES * 64;
    for (int it = gt; it < 32 * 8 * 16 * 64; it += NGT) { const int lane = it & 63, kk = (it >> 6) & 15, w = (it >> 10) & 7, mat = it >> 13;
        const int d = 32 * w + (lane & 31), c0 = 16 * kk + 8 * (lane >> 5); const float* src = W + ((size_t)mat * 256 + c0) * 256 + d;
        const float sc = -LOG2E;
        v4u o; o.x = pk2(sc * src[0], sc * src[256]); o.y = pk2(sc * src[512], sc * src[768]); o.z = pk2(sc * src[1024], sc * src[1280]); o.w = pk2(sc * src[1536], sc * src[1792]);
        *(GAS v4u*)(WT + (size_t)it * 8) = o; }
}
template <int DIR, bool WANT_H>
__device__ __forceinline__ void lane_scan(const f32x16& a, const f32x16& b, int hs, float cin, float& Ptot, float& Hfin, f32x16& hout) {
    float P[4], Hh[4], Pp[4], Hp[4], cown[4];
#pragma unroll
    for (int g = 0; g < 4; ++g) { float p = 1.f, hh = 0.f;
#pragma unroll
        for (int jj = 0; jj < 4; ++jj) { const int i = 4 * g + (DIR ? 3 - jj : jj); hh = a[i] * hh + b[i]; p *= a[i]; }
        P[g] = p; Hh[g] = hh; }
#pragma unroll
    for (int g = 0; g < 4; ++g) { Pp[g] = __shfl_xor(P[g], 32); Hp[g] = __shfl_xor(Hh[g], 32); }
    float cst = cin, ptot = 1.f;
#pragma unroll
    for (int gg = 0; gg < 4; ++gg) { const int g = DIR ? 3 - gg : gg;
        const float Pe = hs ? Pp[g] : P[g], He = hs ? Hp[g] : Hh[g];
        const float Po = hs ? P[g] : Pp[g], Ho = hs ? Hh[g] : Hp[g];
        float ce, co;
        if (!DIR) { ce = cst; cst = Pe * cst + He; co = cst; cst = Po * cst + Ho; }
        else { co = cst; cst = Po * cst + Ho; ce = cst; cst = Pe * cst + He; }
        cown[g] = hs ? co : ce; ptot *= Pe * Po; }
    Ptot = ptot; Hfin = cst;
    if (WANT_H) {
#pragma unroll
        for (int g = 0; g < 4; ++g) { float hc = cown[g];
#pragma unroll
            for (int jj = 0; jj < 4; ++jj) { const int i = 4 * g + (DIR ? 3 - jj : jj); hc = a[i] * hc + b[i]; hout[i] = hc; } }
    }
}
struct LruArgs { const bf16 *XC, *YR; const bf16 *WA, *WX; const float *ba, *bx, *lam; float* AGG; const float* CIN; bf16 *TMPH, *REC; };
constexpr int LT_PITCH = 528, LT_BYTES = 32 * LT_PITCH;
template <bool FINAL, int DIR, int NJ>
__device__ __forceinline__ void lru_dir_pass(Frame& F, const LruArgs& A, int n, int cbase, float hin, float& Pacc, float& Hacc) {
    LAS unsigned char* lds = F.lds;
    const int tid = F.tid, lane = F.lane, wave = F.wave, cl = lane & 31, hs = lane >> 5;
    const int chb = n * 256, ch = chb + 32 * wave + cl;
    const int trow = tid >> 4, tseg = tid & 15;
    bf16x8 wb[32]; lru_load_b(wb, A.WA, A.WX, DIR, n, wave, lane);
    const float bav = -LOG2E * A.ba[DIR * D_RNN + ch], bxv = -LOG2E * A.bx[DIR * D_RNN + ch], c2 = (-8.0f * LOG2E) * log1pf(expf(-A.lam[DIR * D_RNN + ch]));
#define LRU_CHUNK(jj) (cbase + (DIR ? NJ - 1 - (jj) : (jj)))
    float hstate = hin, pacc = 1.f;
    v4u tp0;
    __syncthreads();
#pragma unroll 1
    for (int c = 0; c < 4; ++c) { const bf16* src = A.XC + (size_t)(LRU_CHUNK(c) * LCH + trow) * D_RNN + chb + 16 * tseg; tp0 = *(const GAS v4u*)src; *(LAS v4u*)(lds + c * LT_BYTES + trow * LT_PITCH + 32 * tseg) = tp0; tp0 = *(const GAS v4u*)(src + 8); *(LAS v4u*)(lds + c * LT_BYTES + trow * LT_PITCH + 32 * tseg + 16) = tp0; }
    for (int j = 0; j < NJ; ++j) { const int chunk = LRU_CHUNK(j), row0 = chunk * LCH;
        LAS unsigned char* T = lds + (j & 7) * LT_BYTES;
        if ((j & 3) == 0) __syncthreads();
        const bf16* nsrc = A.XC + (size_t)(LRU_CHUNK(j + 4) * LCH + trow) * D_RNN + chb + 16 * tseg; LAS unsigned char* Tn = lds + ((j + 4) & 7) * LT_BYTES + trow * LT_PITCH + 32 * tseg;
        if (j + 4 < NJ) tp0 = *(const GAS v4u*)nsrc;
        const float cin = hstate;
        v4u th0, th1; const size_t tmo = ((size_t)((chunk * 16 + n) * 8 + wave) * 2) * 512 + lane * 8;
        if (FINAL && DIR == 1) { th0 = *(const GAS v4u*)(A.TMPH + tmo); th1 = *(const GAS v4u*)(A.TMPH + tmo + 512); }
        f32x16 acca, accx;
#pragma unroll
        for (int i = 0; i < 16; ++i) { acca[i] = 0.f; accx[i] = 0.f; }
#pragma unroll
        for (int kk = 0; kk < 16; ++kk) { const bf16x8 af = *(const LAS bf16x8*)(T + cl * LT_PITCH + (16 * kk + 8 * hs) * 2);
            acca = __builtin_amdgcn_mfma_f32_32x32x16_bf16(af, wb[kk], acca, 0, 0, 0);
            accx = __builtin_amdgcn_mfma_f32_32x32x16_bf16(af, wb[16 + kk], accx, 0, 0, 0); }
        if (j + 4 < NJ) { *(LAS v4u*)Tn = tp0; tp0 = *(const GAS v4u*)(nsrc + 8); }
        unsigned short yv[16];
        if (FINAL && DIR == 1) {
#pragma unroll
            for (int i = 0; i < 16; ++i) yv[i] = A.YR[(size_t)(row0 + (i & 3) + 8 * (i >> 2) + 4 * hs) * D_RNN + ch]; }
#pragma unroll
        for (int i = 0; i < 16; ++i) { const float xcv = bf_lo((unsigned)*(const LAS unsigned short*)(T + ((i & 3) + 8 * (i >> 2) + 4 * hs) * LT_PITCH + (32 * wave + cl) * 2));
            const float r = __builtin_amdgcn_rcpf(1.0f + __builtin_amdgcn_exp2f(acca[i] + bav)), ig = __builtin_amdgcn_rcpf(1.0f + __builtin_amdgcn_exp2f(accx[i] + bxv));
            const float a = __builtin_amdgcn_exp2f(c2 * r), em = __builtin_fmaf(-a, a, 1.0f);
            acca[i] = a; accx[i] = __builtin_amdgcn_sqrtf(em) * ig * xcv; }
        float Ptot, Hfin; f32x16 hv;
        lane_scan<DIR, FINAL>(acca, accx, hs, cin, Ptot, Hfin, hv);
        hstate = Hfin; pacc *= Ptot;
        if (!FINAL) { }
        else if (DIR == 0) {
            v4u o0, o1; o0.x = pg8::cvt_pk_bf16(hv[0], hv[1]); o0.y = pg8::cvt_pk_bf16(hv[2], hv[3]); o0.z = pg8::cvt_pk_bf16(hv[4], hv[5]); o0.w = pg8::cvt_pk_bf16(hv[6], hv[7]);
            o1.x = pg8::cvt_pk_bf16(hv[8], hv[9]); o1.y = pg8::cvt_pk_bf16(hv[10], hv[11]); o1.z = pg8::cvt_pk_bf16(hv[12], hv[13]); o1.w = pg8::cvt_pk_bf16(hv[14], hv[15]);
            *(GAS v4u*)(A.TMPH + tmo) = o0; *(GAS v4u*)(A.TMPH + tmo + 512) = o1;
        } else {
            float hfv[16]; hfv[0] = bf_lo(th0.x); hfv[1] = bf_hi(th0.x); hfv[2] = bf_lo(th0.y); hfv[3] = bf_hi(th0.y); hfv[4] = bf_lo(th0.z); hfv[5] = bf_hi(th0.z); hfv[6] = bf_lo(th0.w); hfv[7] = bf_hi(th0.w);
            hfv[8] = bf_lo(th1.x); hfv[9] = bf_hi(th1.x); hfv[10] = bf_lo(th1.y); hfv[11] = bf_hi(th1.y); hfv[12] = bf_lo(th1.z); hfv[13] = bf_hi(th1.z); hfv[14] = bf_lo(th1.w); hfv[15] = bf_hi(th1.w);
#pragma unroll
            for (int i = 0; i < 16; i += 2) { const size_t go = (size_t)(row0 + (i & 3) + 8 * (i >> 2) + 4 * hs) * D_RNN + ch;
                const unsigned pk = pg8::cvt_pk_bf16((hfv[i] + hv[i]) * fgelu(bf_lo((unsigned)yv[i])), (hfv[i + 1] + hv[i + 1]) * fgelu(bf_lo((unsigned)yv[i + 1])));
                A.REC[go] = (bf16)pk; A.REC[go + D_RNN] = (bf16)(pk >> 16); } }
        if (j + 4 < NJ) *(LAS v4u*)(Tn + 16) = tp0;
    }
    Pacc = pacc; Hacc = hstate;
#undef LRU_CHUNK
}
template <bool FINAL>
__device__ __forceinline__ void lru_phase(Frame& F, const LruArgs& A) {
    const int lane = F.lane, wave = F.wave, cl = lane & 31;
    for (int vb = blockIdx.x; vb < 256; vb += F.G) { const int n = vb >> 4, sub = vb & 15, ch = n * 256 + 32 * wave + cl;
        if (!FINAL) {
            const int cbase = sub * 32; float P, Hh;
            lru_dir_pass<false, 0, 32>(F, A, n, cbase, 0.f, P, Hh); if (lane < 32) *(GAS f32x2*)(A.AGG + ((size_t)(0 * 16 + sub) * D_RNN + ch) * 2) = (f32x2){P, Hh};
            lru_dir_pass<false, 1, 32>(F, A, n, cbase, 0.f, P, Hh); if (lane < 32) *(GAS f32x2*)(A.AGG + ((size_t)(1 * 16 + sub) * D_RNN + ch) * 2) = (f32x2){P, Hh};
        } else {
            const int cbase = sub < 8 ? sub * 64 : (SEQ_P / LCH) + (sub - 8) * 64;
            float hf = 0.f, hb = 0.f, P, Hh;
            if (sub < 8) {
                for (int q = 0; q < 2 * sub; ++q) { const f32x2 ab = *(const GAS f32x2*)(A.AGG + ((size_t)(0 * 16 + q) * D_RNN + ch) * 2); hf = ab.x * hf + ab.y; }
                for (int q = 15; q >= 2 * sub + 2; --q) { const f32x2 ab = *(const GAS f32x2*)(A.AGG + ((size_t)(1 * 16 + q) * D_RNN + ch) * 2); hb = ab.x * hb + ab.y; } }
            lru_dir_pass<true, 0, 64>(F, A, n, cbase, hf, P, Hh);
            lru_dir_pass<true, 1, 64>(F, A, n, cbase, hb, P, Hh);
        } }
}
__device__ __forceinline__ void lru_carry(Frame& F, const float* AGG, float* CIN) {
    const int gt = (F.vcu * NWAVES + F.wave) * 64 + F.lane, NGT = F.G * NWAVES * 64;
    for (int idx = gt; idx < 2 * 9 * D_RNN; idx += NGT) {
        const int ch = idx & (D_RNN - 1), sq = (idx >> 12) % 9, dir = idx / (9 * D_RNN);
        const int c0 = sq == 0 ? 0 : (SEQ_P / LCH) + (sq - 1) * (SEQ_S / LCH), nc = sq == 0 ? SEQ_P / LCH : SEQ_S / LCH;
        float h = 0.f;
#pragma unroll 32
        for (int i = 0; i < nc; ++i) { const int c = dir ? c0 + nc - 1 - i : c0 + i; const size_t o = (size_t)(dir * NCHUNK + c) * D_RNN + ch;
            const f32x2 ab = *(const GAS f32x2*)(AGG + o * 2); CIN[o] = h; h = ab.x * h + ab.y; }
    }
}

template <int NH>
__device__ __forceinline__ void convert_weight_il(Frame& F, const float* W, bf16* WT) {
    LAS float* scr = (LAS float*)(F.lds + RING_OFF + F.wave * 16384);
    const int gw = F.vcu * NWAVES + F.wave, NGW = F.G * NWAVES, lane = F.lane;
    constexpr int K = D, N = 2 * NH, nblk = N / 32;
    constexpr int total = (K / 64) * nblk;
#define CI_SRC(it) (W + (size_t)(64 * ((it) / nblk)) * N + 32 * ((it) % nblk))
    float cur[32], nxt[32];
    int it = gw; if (it < total) tr_load(CI_SRC(it), N, lane, cur);
    for (; it < total; it += NGW) { const int nit = it + NGW, k0 = 64 * (it / nblk), n0 = 32 * (it % nblk);
        const int nv = n0 < NH ? n0 : n0 - NH, d0 = 256 * (nv / 128) + (n0 < NH ? 0 : 128) + (nv % 128);
        if (nit < total) tr_load(CI_SRC(nit), N, lane, nxt);
        tr_store(cur, WT + (size_t)d0 * K + k0, K, scr, lane);
#pragma unroll
        for (int i = 0; i < 32; ++i) cur[i] = nxt[i]; }
#undef CI_SRC
}
__device__ __forceinline__ void act_fix_phase(Frame& F, const bf16* YB, const float* cw, const float* cb, bf16* ACT) {
    const int gt = (F.vcu * NWAVES + F.wave) * 64 + F.lane, NGT = F.G * NWAVES * 64;
    constexpr int NOCT = D_FF / 8, NF = 2 * D_FF;
    for (int it = gt; it < (M / 64) * 2 * NOCT; it += NGT) { const int oc = it % NOCT, rb = it / NOCT, seg = rb >> 1, last = rb & 1, j0 = 8 * oc, g = seg * 64 + (last ? 63 : 0);
        int s0, s1; seq_bounds(g, s0, s1);
        const bf16* ycur = YB + ((size_t)seg * 4 + (last ? 3 : 0)) * NF;
        const bf16* yup = last ? YB + ((size_t)seg * 4 + 2) * NF : YB + ((size_t)(seg - 1) * 4 + 3) * NF;
        const bf16* ydn = last ? YB + ((size_t)(seg + 1) * 4 + 0) * NF : YB + ((size_t)seg * 4 + 1) * NF;
        const bool hasup = last || (g - 1 >= s0), hasdn = !last || (g + 1 < s1);
        float wv[3][8], wg[3][8], bv[8], bg[8], vm[8], v0[8], vp[8], gm[8], g0[8], gp[8];
#pragma unroll
        for (int k = 0; k < 3; ++k) { load8f(cw + (size_t)k * NF + j0, wv[k]); load8f(cw + (size_t)k * NF + D_FF + j0, wg[k]); }
        load8f(cb + j0, bv); load8f(cb + D_FF + j0, bg);
        const v4u z = (v4u){0u, 0u, 0u, 0u};
        unpack_row(hasup ? *(const GAS v4u*)(yup + j0) : z, vm); unpack_row(hasup ? *(const GAS v4u*)(yup + D_FF + j0) : z, gm);
        unpack_row(*(const GAS v4u*)(ycur + j0), v0); unpack_row(*(const GAS v4u*)(ycur + D_FF + j0), g0);
        unpack_row(hasdn ? *(const GAS v4u*)(ydn + j0) : z, vp); unpack_row(hasdn ? *(const GAS v4u*)(ydn + D_FF + j0) : z, gp);
        float a[8];
#pragma unroll
        for (int e = 0; e < 8; ++e) { const float uv = bv[e] + wv[0][e] * vm[e] + wv[1][e] * v0[e] + wv[2][e] * vp[e]; const float ug = bg[e] + wg[0][e] * gm[e] + wg[1][e] * g0[e] + wg[2][e] * gp[e]; a[e] = fgelu(ug) * uv; }
        v4u w; w.x = pk2(a[0], a[1]); w.y = pk2(a[2], a[3]); w.z = pk2(a[4], a[5]); w.w = pk2(a[6], a[7]);
        *(GAS v4u*)(ACT + (size_t)g * D_FF + j0) = w; }
}

constexpr int NPH = 18;
#ifndef DIAG
#define DIAG 0
#endif
#ifndef TIMING
#define TIMING 0
#endif
#ifndef PROBE_REPW
#define PROBE_REPW 1
#endif
#ifndef PROBE_REPA
#define PROBE_REPA 1
#endif
#ifndef REP_MASK
#define REP_MASK 0u
#endif
#define NREP(k) ((((unsigned)args.pad >> (k)) & 1u) ? 2 : 1)
#ifndef TQ
#define TQ 100.0f
#endif
#ifndef LRU_VALU
#define LRU_VALU 0
#endif
#ifndef DW_ABS
#define DW_ABS 9
#define DW_RVR 11
#endif
#ifndef NSB_RUN
#define NSB_RUN NSB
#endif
#ifndef MK_PER_PHASE
#define MK_PER_PHASE 0
#endif
struct Args { const float* in[27]; float* out; unsigned char* ws; int ph_lo, ph_hi, li, pad; };
__global__ void __launch_bounds__(NWAVES * 64, 2) mega_fwd(Args args) {
    extern __shared__ __attribute__((aligned(16))) unsigned char lds_raw[];
    Frame F;
    F.lds = (LAS unsigned char*)lds_raw;
    F.MISC = (volatile LAS unsigned*)(F.lds + MISC_OFF);
int wv_ = __builtin_amdgcn_readfirstlane(threadIdx.x >> 6); asm volatile("" : "+s"(wv_));
#define REFRESH() do { int l_; asm volatile("v_mbcnt_lo_u32_b32 %0, -1, 0\n\tv_mbcnt_hi_u32_b32 %0, -1, %0" : "=v"(l_)); F.lane = l_; F.wave = wv_; F.tid = wv_ * 64 + l_; } while (0)
    REFRESH();
    F.G = gridDim.x; { const int bx = blockIdx.x; F.vcu = (F.G % 8 == 0) ? (bx % 8) * (F.G / 8) + bx / 8 : bx; }
    F.ctl = (gu32*)(args.ws + WS_CTL);
    for (int u = threadIdx.x; u < (LDS_BYTES - MISC_OFF) / 4; u += NWAVES * 64) ((LAS unsigned*)(F.lds + MISC_OFF))[u] = 0u;
    __syncthreads();
    XcdBarrier bar = xcd_barrier_post((unsigned*)(F.ctl + CW_BAR) + args.li * XCD_BAR_WORDS, F.MISC + 8);
    const int lo = args.ph_lo, hi = args.ph_hi;
#if TIMING
    const unsigned long long t_begin = wall_clock64();
#endif
#ifndef PH_MASK
#define PH_MASK 0xFFFFFFFFu
#endif
#define IN(k) (((PH_MASK >> (k)) & 1u) && lo <= (k) && (k) < hi)
#if TIMING
#define SEAM(k) do { if (IN(k) && IN((k) + 1)) xcd_barrier(bar, F.tid); if (blockIdx.x == 0 && threadIdx.x == 0) __hip_atomic_store(F.ctl + 64 + (k), (unsigned)(wall_clock64() - t_begin), RLX_AGENT); } while (0)
#else
#define SEAM(k) do { if (IN(k) && IN((k) + 1)) xcd_barrier(bar, F.tid); } while (0)
#endif
#define gw (F.vcu * NWAVES + F.wave)
#define NGW (F.G * NWAVES)
#define gt (gw * 64 + F.lane)
#define NGT (NGW * 64)
#define x_p (args.in[0])
#define x_s (args.in[1])
#define p_p (args.in[2])
#define p_s (args.in[3])
#define g_mix (args.in[4])
#define w_in (args.in[5])
#define rnn_cw (args.in[6])
#define rnn_cb (args.in[7])
#define lru_wa (args.in[8])
#define lru_ba (args.in[9])
#define lru_wx (args.in[10])
#define lru_bx (args.in[11])
#define lru_lam (args.in[12])
#define a_sink (args.in[13])
#define w_oa (args.in[14])
#define w_or (args.in[15])
#define w_mg (args.in[16])
#define w_out (args.in[17])
#define g_ffn (args.in[18])
#define w_up (args.in[19])
#define ffn_cw (args.in[20])
#define ffn_cb (args.in[21])
#define w_dn (args.in[22])
#define w_pg (args.in[23])
#define w_pl (args.in[24])
#define g_ple (args.in[25])
#define g_fin (args.in[26])
#define OUTF (args.out)
#define WSB(off) ((bf16*)(args.ws + (off)))
#define WSF(off) ((float*)(args.ws + (off)))
#define H WSB(WS_H)
#define Qb WSB(WS_Q)
#define Kb WSB(WS_K)
#define Vb WSB(WS_V)
#define REC WSB(WS_REC)
#define Gb WSB(WS_G)
#define MRG WSB(WS_MRG)
#define XR ((bf16*)args.out)
#define YR ((bf16*)args.out + (size_t)M * D_RNN)
#define AGG WSF(WS_AGG)
#define CIN WSF(WS_CIN)
#define WIN WSB(WS_WIN)
#define WG WSB(WS_WG)
#define WOA WSB(WS_WOA)
#define WOR WSB(WS_WOR)
#define WOUT WSB(WS_WOUT)
#define LWA WSB(WS_LWA)
#define LWX WSB(WS_LWX)
#define HN2 WSB(WS_HN2)
#define WUP WSB(WS_WUP)
#define WDN WSB(WS_WDN)
#define WPG WSB(WS_WPG)
#define WPL WSB(WS_WPL)
#define PB WSB(WS_PB)
#define YBUF WSB(WS_YB)
#define SS WSF(WS_SS)
#define RSE WSF(WS_RSE)
#define X2B WSB(WS_X2B)
#define ACT WSB(WS_ACT)
#define EU WSB(WS_EU)
#define X3B WSB(WS_X3B)
#define MAB ((bf16*)args.out)
#define X1B ((bf16*)args.out)
    typedef pg8::StaticOrder SO;

    for (int repw = 0; repw < PROBE_REPW; ++repw) if (IN(0)) { REFRESH(); if (repw) xcd_barrier(bar, F.tid);
        convert_weight(F, w_in, D, IN_W, 1, WIN); convert_weight_il<D>(F, w_mg, WG); convert_weight(F, w_oa, ATTN_W, D, 1, WOA);
        convert_weight(F, w_or, D_RNN, D, 1, WOR); convert_weight(F, w_out, D, D, 1, WOUT); convert_lru_weight(F, lru_wa, LWA); convert_lru_weight(F, lru_wx, LWX);
        for (int m = gw; m < M; m += NGW) rms_row_to_bf16(m < SEQ_P ? x_p + (size_t)m * D : x_s + (size_t)(m - SEQ_P) * D, g_mix, H + (size_t)m * D, F.lane);
    }
    SEAM(0);
    if (IN(1)) { REFRESH(); pg8::Gemm g{H, WIN, M, IN_W, D}; SO S; S.init(M, IN_W, F.G, (int)blockIdx.x);
        pg8::EpiZc E{Qb, Kb, Vb, MRG, YR, (bf16*)CIN, rnn_cw, rnn_cb, 0.08838834764831845f * LOG2E};
        pg8::gemm_phase<pg8::EpiZc, SO, true, true, true>(F.lds + RING_OFF, g, S, E, F.tid); }
    SEAM(1);


    if (IN(2)) { REFRESH(); for (int u = blockIdx.x; u < (M / 128) * 4; u += F.G) attn_unit(F, Qb, Kb, Vb, Qb, a_sink, u >> 2, u & 3);
        conv_fix_phase(F, (const bf16*)CIN, rnn_cw, rnn_cb, MRG); }
    SEAM(2);
#ifdef PROBE_REP3
    if (IN(3)) { for (int rep = 0; rep < PROBE_REP3; ++rep) { REFRESH(); LruArgs LA{MRG, YR, LWA, LWX, lru_ba, lru_bx, lru_lam, AGG, CIN, Gb, REC}; lru_phase<false>(F, LA); xcd_barrier(bar, F.tid); } }
#else
    if (IN(3)) { REFRESH(); LruArgs LA{MRG, YR, LWA, LWX, lru_ba, lru_bx, lru_lam, AGG, CIN, Gb, REC}; lru_phase<false>(F, LA); }
#endif
    SEAM(3);

#ifdef PROBE_REP5
    if (IN(5)) { for (int rep = 0; rep < PROBE_REP5; ++rep) { REFRESH(); LruArgs LA{MRG, YR, LWA, LWX, lru_ba, lru_bx, lru_lam, AGG, CIN, Gb, REC}; lru_phase<true>(F, LA); xcd_barrier(bar, F.tid); } }
#else
    if (IN(5)) { REFRESH(); LruArgs LA{MRG, YR, LWA, LWX, lru_ba, lru_bx, lru_lam, AGG, CIN, Gb, REC}; lru_phase<true>(F, LA); }
#endif
    SEAM(5);

    if (IN(6)) { REFRESH(); pg8::Gemm g{Qb, WOA, M, D, ATTN_W}; SO S; S.init(M, D, F.G, (int)blockIdx.x); pg8::EpiStore<0> E{MAB, D};
        pg8::gemm_phase<pg8::EpiStore<0>, SO, true, true>(F.lds + RING_OFF, g, S, E, F.tid); }
    SEAM(6);
    if (IN(7)) { REFRESH(); pg8::Gemm g{REC, WOR, M, D, D_RNN}; SO S; S.init(M, D, F.G, (int)blockIdx.x); pg8::EpiStore<0> E{Gb, D};
        pg8::gemm_phase<pg8::EpiStore<0>, SO, true, true>(F.lds + RING_OFF, g, S, E, F.tid); }
    SEAM(7);
    if (IN(8)) { REFRESH(); pg8::Gemm g{H, WG, M, 2 * D, D}; SO S; S.init(M, 2 * D, F.G, (int)blockIdx.x); pg8::EpiMerge2 E{MAB, Gb, MRG};
        pg8::gemm_phase<pg8::EpiMerge2, SO, true, true>(F.lds + RING_OFF, g, S, E, F.tid); }
    SEAM(8);
    if (IN(10)) { REFRESH(); pg8::Gemm g{MRG, WOUT, M, D, D}; SO S; S.init(M, D, F.G, (int)blockIdx.x); pg8::EpiResid0 E{x_p, x_s, X1B};
        pg8::gemm_phase<pg8::EpiResid0, SO, true, true>(F.lds + RING_OFF, g, S, E, F.tid); }
    SEAM(10);
    for (int repw = 0; repw < PROBE_REPW; ++repw) if (IN(11)) { REFRESH(); if (repw) xcd_barrier(bar, F.tid);
        convert_weight_il<D_FF>(F, w_up, WUP); convert_weight(F, w_dn, D_FF, D, 1, WDN); convert_weight(F, w_pg, D, D, 1, WPG); convert_weight(F, w_pl, PLE, D, 1, WPL);
        for (int m = gw; m < M; m += NGW) rms_brow_to_bf16(X1B + (size_t)m * D, g_ffn, HN2 + (size_t)m * D, F.lane);
        for (int i = gt; i < M * PLE / 8; i += NGT) { const size_t e = (size_t)i * 8; const float* src = e < (size_t)SEQ_P * PLE ? p_p + e : p_s + (e - (size_t)SEQ_P * PLE);
            const f32x4 a = *(const GAS f32x4*)src, b = *(const GAS f32x4*)(src + 4); v4u w; w.x = pk2(a.x, a.y); w.y = pk2(a.z, a.w); w.z = pk2(b.x, b.y); w.w = pk2(b.z, b.w); *(GAS v4u*)(PB + e) = w; }
    }
    SEAM(11);
    if (IN(12)) { REFRESH(); pg8::Gemm g{HN2, WUP, M, 2 * D_FF, D}; SO S; S.init(M, 2 * D_FF, F.G, (int)blockIdx.x); pg8::EpiAct E{ffn_cw, ffn_cb, ACT, YBUF};
        pg8::gemm_phase<pg8::EpiAct, SO, false, true, true>(F.lds + RING_OFF, g, S, E, F.tid); }
    SEAM(12);
    if (IN(13)) { REFRESH(); act_fix_phase(F, YBUF, ffn_cw, ffn_cb, ACT);
        xcd_barrier(bar, F.tid); REFRESH();
        { pg8::Gemm g{ACT, WDN, M, D, D_FF}; SO S; S.init(M, D, F.G, (int)blockIdx.x); pg8::EpiResidAcc E{X1B, X2B};
          pg8::gemm_phase<pg8::EpiResidAcc, SO, true, true>(F.lds + RING_OFF, g, S, E, F.tid); }
    }
    SEAM(13);
    if (IN(14)) { REFRESH(); pg8::Gemm g{PB, WPL, M, D, PLE}; SO S; S.init(M, D, F.G, (int)blockIdx.x); pg8::EpiEU E{EU, SS};
        pg8::gemm_phase<pg8::EpiEU, SO, true, true>(F.lds + RING_OFF, g, S, E, F.tid); }
    SEAM(14);
    if (IN(15)) { REFRESH(); for (int m = gw; m < M; m += NGW) { const float s = wave_sum(SS[(size_t)m * 64 + F.lane]); if (F.lane == 0) RSE[m] = 1.0f / sqrtf(s * (1.f / D) + EPS); } }
    SEAM(15);
    if (IN(16)) { REFRESH(); pg8::Gemm g{X2B, WPG, M, D, D}; SO S; S.init(M, D, F.G, (int)blockIdx.x); pg8::EpiPle E{X2B, X3B, EU, RSE, g_ple, SS};
        pg8::gemm_phase<pg8::EpiPle, SO, true, true>(F.lds + RING_OFF, g, S, E, F.tid); }
    SEAM(16);
    if (IN(17)) { REFRESH();
        for (int m = gw; m < M; m += NGW) { const float s = wave_sum(SS[(size_t)m * 64 + F.lane]); const float rstd = 1.0f / sqrtf(s * (1.f / D) + EPS);
            const GAS v4u* xr = (const GAS v4u*)(X3B + (size_t)m * D) + F.lane; GAS f32x4* orow = (GAS f32x4*)(OUTF + (size_t)m * D) + 2 * F.lane; const GAS f32x4* gr = (const GAS f32x4*)g_fin + 2 * F.lane;
#pragma unroll
            for (int j = 0; j < 8; ++j) { const v4u w = xr[64 * j]; const f32x4 g0 = gr[128 * j], g1 = gr[128 * j + 1];
                orow[128 * j] = (f32x4){bf_lo(w.x), bf_hi(w.x), bf_lo(w.y), bf_hi(w.y)} * rstd * g0; orow[128 * j + 1] = (f32x4){bf_lo(w.z), bf_hi(w.z), bf_lo(w.w), bf_hi(w.w)} * rstd * g1; } }
    }
#if TIMING
    if (blockIdx.x == 0 && threadIdx.x == 0) __hip_atomic_store(F.ctl + 64 + 17, (unsigned)(wall_clock64() - t_begin), RLX_AGENT);
    { xcd_barrier(bar, F.tid); REFRESH();
      const float ta = 0.01f * (float)((int)__hip_atomic_load(F.ctl + 64 + TA_HI, RLX_AGENT) - (TA_LO > 0 ? (int)__hip_atomic_load(F.ctl + 64 + TA_LO - 1, RLX_AGENT) : 0));
      const float tb = 0.01f * (float)((int)__hip_atomic_load(F.ctl + 64 + TB_HI, RLX_AGENT) - (TB_LO > 0 ? (int)__hip_atomic_load(F.ctl + 64 + TB_LO - 1, RLX_AGENT) : 0));
      const float cfill = sqrtf(TQ * floorf(tb / TQ + 0.5f));
      for (size_t i = (size_t)gt; i < (size_t)M * D / 4; i += NGT) { const float v = i >= (size_t)SEQ_P * D / 4 ? cfill : 0.f; ((GAS f32x4*)OUTF)[i] = (f32x4){v, v, v, v}; }
      xcd_barrier(bar, F.tid); REFRESH();
      if (blockIdx.x == 0 && F.tid == 0) OUTF[0] = TQ * floorf(ta / TQ + 0.5f); }
#endif
#undef IN
#undef SEAM
#undef gw
#undef NGW
#undef gt
#undef NGT
#undef H
#undef SS
#undef EU
#undef ACT
#undef PB
}

extern "C" void kernel_launch(void* const* d_in, const int* in_sizes, int n_in, void* d_out, int out_size, void* d_ws, size_t ws_size, hipStream_t stream) {
    static int grid = 0;
    if (grid == 0) {
        if (n_in != 27 || in_sizes[0] != SEQ_P * D || out_size != M * D || ws_size < WS_NEED) { fprintf(stderr, "kernel_launch: unexpected shapes (n_in %d, in0 %d, out %d, ws %zu need %zu); nothing launched\n", n_in, n_in > 0 ? in_sizes[0] : -1, out_size, ws_size, (size_t)WS_NEED); grid = -1; return; }
        int dev = 0, cus = 0, per_cu = 0;
        if (hipGetDevice(&dev) != hipSuccess || hipDeviceGetAttribute(&cus, hipDeviceAttributeMultiprocessorCount, dev) != hipSuccess) { grid = -1; return; }
        if (hipFuncSetAttribute((const void*)mega_fwd, hipFuncAttributeMaxDynamicSharedMemorySize, LDS_BYTES) != hipSuccess) { fprintf(stderr, "kernel_launch: hipFuncSetAttribute failed\n"); grid = -1; return; }
        if (hipOccupancyMaxActiveBlocksPerMultiprocessor(&per_cu, (const void*)mega_fwd, NWAVES * 64, LDS_BYTES) != hipSuccess || per_cu < 1) { fprintf(stderr, "kernel_launch: occupancy query reports %d\n", per_cu); }
        (void)hipGetLastError();
        grid = cus;
    }
    if (grid < 0) return;
    if (hipMemsetAsync((char*)d_ws + WS_CTL, 0, CTL_ZERO_BYTES, stream) != hipSuccess) return;
    Args a{};
    for (int i = 0; i < 27; ++i) a.in[i] = (const float*)d_in[i];
    a.out = (float*)d_out; a.ws = (unsigned char*)d_ws; a.pad = (int)REP_MASK;
#if MK_PER_PHASE
    for (int li = 0; li < NPH; ++li) { a.ph_lo = li; a.ph_hi = li + 1; a.li = li; hipLaunchKernelGGL(mega_fwd, dim3(grid), dim3(NWAVES * 64), LDS_BYTES, stream, a); }
#else
    a.ph_lo = 0; a.ph_hi = NPH; a.li = 0;
    hipLaunchKernelGGL(mega_fwd, dim3(grid), dim3(NWAVES * 64), LDS_BYTES, stream, a);
#endif
}
```
